# Optimizing an MI355X kernel written in HIP

```python
import math
import jax
import jax.numpy as jnp
from jax import lax
import numpy as np

D_MODEL = 2048
BATCH = 32
SEQ = 256
DEPTH = 2
DEC_BATCH = 8
DEC_SEQ = 2048
PAST_LEN = 512

GRID_W = 64
QBLOCK = 128
ROPE_BASE = 10000.0
EPS = 1e-6
NEG_INF = -1e30
N_BRANCH = 4
BRANCH_W = 512
MLA_V = 64
MLA_HEADS = BRANCH_W // MLA_V
MLA_NOPE = 64
MLA_ROPE = 32
MLA_KV_RANK = 256
DIFF_QK = 64
DIFF_V = 2 * DIFF_QK
DIFF_HEADS = BRANCH_W // DIFF_V
NA_DIM = 64
NA_HEADS = BRANCH_W // NA_DIM
NA_ROWS = 8
NA_COLS = 16
RET_V = 128
RET_HEADS = BRANCH_W // RET_V
RET_QK = 64
RET_CHUNK = 128
D_FF = 5632
CONV_W = 3
IN_SIZES = (MLA_HEADS * (MLA_NOPE + MLA_ROPE), MLA_KV_RANK, MLA_ROPE,
            DIFF_HEADS * 2 * DIFF_QK, DIFF_HEADS * 2 * DIFF_QK, DIFF_HEADS * DIFF_V,
            NA_HEADS * NA_DIM, NA_HEADS * NA_DIM, NA_HEADS * NA_DIM,
            RET_HEADS * RET_QK, RET_HEADS * RET_QK, RET_HEADS * RET_V, BRANCH_W,
            N_BRANCH * D_MODEL)
IN_WIDTH = sum(IN_SIZES)

kernel_name = 'hybrid_diffusion_prefix_trunk_step'


def rmsnorm(x, g):
    xf = x.astype(jnp.float32)
    y = xf * lax.rsqrt(jnp.mean(xf * xf, axis=-1, keepdims=True) + EPS)
    return (y * g.astype(jnp.float32)).astype(x.dtype)


def head_groupnorm(y, g):
    H, d = y.shape[-2:]
    mu = jnp.mean(y, axis=-1, keepdims=True)
    yc = y - mu
    var = jnp.mean(yc * yc, axis=-1, keepdims=True)
    return yc * lax.rsqrt(var + EPS) * g.astype(jnp.float32).reshape(H, d)


def split_cols(p):
    parts, start = [], 0
    for n in IN_SIZES:
        parts.append(p[..., start:start + n])
        start += n
    return parts


def ada_mod(cond, w, b):
    m = jax.nn.silu(cond) @ w + b
    m = m.reshape((-1, 1, 6, D_MODEL))
    return [m[:, :, i] for i in range(6)]


def modulate(x, g, shift, scale):
    return rmsnorm(x, g) * (1 + scale) + shift


def axial_rope(x):
    T, dr = x.shape[1], x.shape[-1]
    nf = dr // 4
    t = jnp.arange(T)
    pos = jnp.stack([t // GRID_W, t % GRID_W], axis=-1).astype(jnp.float32)
    inv = ROPE_BASE ** (-jnp.arange(nf, dtype=jnp.float32) / nf)
    ang = pos[:, None, :, None] * inv
    cos = jnp.cos(ang).astype(x.dtype)
    sin = jnp.sin(ang).astype(x.dtype)
    xr = x.reshape(x.shape[:-1] + (2, 2, nf))
    x1, x2 = xr[..., 0, :], xr[..., 1, :]
    out = jnp.stack([x1 * cos - x2 * sin, x2 * cos + x1 * sin], axis=-2)
    return out.reshape(x.shape)


def map_query_blocks(fn, q):
    B, T = q.shape[:2]
    nb = T // QBLOCK
    qb = jnp.moveaxis(q.reshape((B, nb, QBLOCK) + q.shape[2:]), 1, 0)
    out = jnp.moveaxis(lax.map(fn, qb), 0, 1)
    return out.reshape((B, T) + out.shape[3:])


def attend(q, k, v):
    scale = q.shape[-1] ** -0.5

    def blk(qb):
        s = jnp.einsum('bqhd,bkhd->bhqk', qb, k).astype(jnp.float32) * scale
        p = jax.nn.softmax(s, axis=-1).astype(v.dtype)
        return jnp.einsum('bhqk,bkhe->bqhe', p, v)

    return map_query_blocks(blk, q)


def diff_attend(q, k, v, lam):
    scale = q.shape[-1] ** -0.5

    def blk(qb):
        s = jnp.einsum('bqhcd,bkhcd->bhcqk', qb, k).astype(jnp.float32) * scale
        p = jax.nn.softmax(s, axis=-1)
        a = (p[:, :, 0] - lam * p[:, :, 1]).astype(v.dtype)
        return jnp.einsum('bhqk,bkhe->bqhe', a, v)

    return map_query_blocks(blk, q)


def na_latent(q, k, v, k_ctx, v_ctx, rel_bias):
    B, T, H, d = q.shape
    rows = T // GRID_W
    kh = min(NA_ROWS, rows)
    n_loc = kh * GRID_W
    scale = d ** -0.5
    qg = q.reshape(B, rows, GRID_W, H, d)
    kg = k.reshape(B, rows, GRID_W, H, d)
    vg = v.reshape(B, rows, GRID_W, H, d)
    r_idx = jnp.arange(rows)
    r_start = jnp.clip(r_idx - kh // 2, 0, rows - kh)
    cols = jnp.arange(GRID_W)
    c_start = jnp.clip(cols - NA_COLS // 2, 0, GRID_W - NA_COLS)
    col_ok = (cols[None, :] >= c_start[:, None]) & (cols[None, :] < c_start[:, None] + NA_COLS)
    col_idx = jnp.clip(cols[None, :] - cols[:, None], 1 - NA_COLS, NA_COLS - 1) + NA_COLS - 1

    def row_block(args):
        q_r, r, s = args
        k_loc = lax.dynamic_slice_in_dim(kg, s, kh, axis=1).reshape(B, n_loc, H, d)
        v_loc = lax.dynamic_slice_in_dim(vg, s, kh, axis=1).reshape(B, n_loc, H, d)
        row_idx = s + jnp.arange(kh) - r + NA_ROWS - 1
        bias = rel_bias[:, row_idx[None, :, None], col_idx[:, None, :]].astype(jnp.float32)
        s_loc = jnp.einsum('bqhd,bkhd->bhqk', q_r, k_loc).astype(jnp.float32)
        s_loc = s_loc.reshape(B, H, GRID_W, kh, GRID_W) * scale + bias
        s_loc = jnp.where(col_ok[:, None, :], s_loc, NEG_INF).reshape(B, H, GRID_W, n_loc)
        s_ctx = jnp.einsum('bqhd,bkhd->bhqk', q_r, k_ctx).astype(jnp.float32) * scale
        p = jax.nn.softmax(jnp.concatenate([s_loc, s_ctx], axis=-1), axis=-1).astype(v.dtype)
        return (jnp.einsum('bhqk,bkhe->bqhe', p[..., :n_loc], v_loc)
                + jnp.einsum('bhqk,bkhe->bqhe', p[..., n_loc:], v_ctx))

    out = lax.map(row_block, (jnp.moveaxis(qg, 1, 0), r_idx, r_start))
    return jnp.moveaxis(out, 0, 1).reshape(B, T, H * d)


def retention_scan(q, k, v, log_g, s0, strict):
    B, T, H, dk = q.shape
    C = RET_CHUNK
    n = T // C
    qc = q.reshape(B, n, C, H, dk)
    kc = k.reshape(B, n, C, H, dk)
    vc = v.reshape(B, n, C, H, -1)
    i = jnp.arange(C, dtype=jnp.float32)
    diff = i[:, None] - i[None, :]
    valid = (diff > 0) if strict else (diff >= 0)
    dmat = jnp.where(valid, jnp.exp(jnp.maximum(diff, 0.0)[None] * log_g[:, None, None]), 0.0)
    s = jnp.einsum('bnihd,bnjhd->bnhij', qc, kc) * dmat
    intra = jnp.einsum('bnhij,bnjhe->bnihe', s, vc)
    kdec = jnp.exp((C - 1 - i)[None, :] * log_g[:, None])
    kv = jnp.einsum('bnjhd,bnjhe,hj->nbhde', kc, vc, kdec)
    g_chunk = jnp.exp(C * log_g)[:, None, None]

    def step(S, kv_c):
        return g_chunk * S + kv_c, S

    s_fin, s_prev = lax.scan(step, s0, kv)
    qdec = jnp.exp((i + 1)[:, None] * log_g[None, :])
    cross = jnp.einsum('bnihd,nbhde->bnihe', qc, s_prev) * qdec[:, :, None]
    return (intra + cross).reshape(B, T, H, -1), s_fin


def retention(rq, rk, rv, rg, prm, s0_f, s0_b):
    B, T, _ = rq.shape
    q = rq.reshape(B, T, RET_HEADS, RET_QK).astype(jnp.float32)
    k = rk.reshape(B, T, RET_HEADS, RET_QK).astype(jnp.float32) * RET_QK ** -0.5
    v = rv.reshape(B, T, RET_HEADS, RET_V).astype(jnp.float32)
    log_g = jax.nn.log_sigmoid(prm['ret_decay'].astype(jnp.float32))
    y_f, s_f = retention_scan(q, k, v, log_g[0], s0_f, False)
    y_b, s_b = retention_scan(jnp.flip(q, 1), jnp.flip(k, 1), jnp.flip(v, 1), log_g[1], s0_b, True)
    y = head_groupnorm(y_f + jnp.flip(y_b, 1), prm['ret_norm']).astype(rv.dtype)
    return jax.nn.silu(rg) * y.reshape(B, T, -1), s_f, s_b


def mla_keys(ckv, krope, w_ukv):
    kv = jnp.einsum('btr,rhe->bthe', ckv, w_ukv.reshape(MLA_KV_RANK, MLA_HEADS, MLA_NOPE + MLA_V))
    k_nope, v = kv[..., :MLA_NOPE], kv[..., MLA_NOPE:]
    k_rope = jnp.broadcast_to(krope[:, :, None, :], k_nope.shape[:-1] + (MLA_ROPE,))
    return jnp.concatenate([k_nope, k_rope], axis=-1), v


def diff_branch(dq, dk, dv, prm, lam_init):
    lp = prm['diff_lambda'].astype(jnp.float32)
    lam = jnp.exp(jnp.sum(lp[0] * lp[1])) - jnp.exp(jnp.sum(lp[2] * lp[3])) + lam_init
    o = diff_attend(dq, dk, dv, lam)
    o = rmsnorm(o, prm['diff_norm'].reshape(DIFF_HEADS, DIFF_V)) * (1.0 - lam_init)
    return o.reshape(o.shape[:2] + (-1,))


def merge_branches(ys, gates, prm):
    B, T, _ = gates.shape
    gs = jax.nn.sigmoid(gates.astype(jnp.float32)).astype(ys[0].dtype).reshape(B, T, N_BRANCH, D_MODEL)
    m = gs[:, :, 0] * (ys[0] @ prm['w_branch'][0])
    for i in range(1, N_BRANCH):
        m = m + gs[:, :, i] * (ys[i] @ prm['w_branch'][i])
    return m @ prm['w_o']


def conv_ffn(h, prm):
    T = h.shape[1]
    u = h @ prm['w_up']
    up = jnp.pad(u, ((0, 0), (CONV_W // 2, CONV_W // 2), (0, 0)))
    cw = prm['conv_w']
    u = up[:, 0:T] * cw[0]
    for j in range(1, CONV_W):
        u = u + up[:, j:j + T] * cw[j]
    u = u + prm['conv_b']
    a, b = jnp.split(u, 2, axis=-1)
    return (jax.nn.silu(a) * b) @ prm['w_down']


def context_mixers(h, prm, lam_init):
    B, T, _ = h.shape
    (mq, mckv, mkr, dq, dk, dv, nq, nk, nv, rq, rk, rv, rg, gates) = split_cols(h @ prm['w_in'])
    ckv = rmsnorm(mckv, prm['mla_kv_norm'])
    k_a, v_a = mla_keys(ckv, mkr, prm['w_mla_ukv'])
    y_a = attend(mq.reshape(B, T, MLA_HEADS, MLA_NOPE + MLA_ROPE), k_a, v_a).reshape(B, T, -1)
    dq = dq.reshape(B, T, DIFF_HEADS, 2, DIFF_QK)
    dk = dk.reshape(B, T, DIFF_HEADS, 2, DIFF_QK)
    dv = dv.reshape(B, T, DIFF_HEADS, DIFF_V)
    y_b = diff_branch(dq, dk, dv, prm, lam_init)
    nq, nk, nv = [t.reshape(B, T, NA_HEADS, NA_DIM) for t in (nq, nk, nv)]
    y_c = attend(nq, nk, nv).reshape(B, T, -1)
    s0 = jnp.zeros((B, RET_HEADS, RET_QK, RET_V), jnp.float32)
    y_d, s_f, s_b = retention(rq, rk, rv, rg, prm, s0, s0)
    y = merge_branches((y_a, y_b, y_c, y_d), gates, prm)
    return y, (ckv, mkr, dk, dv, nk, nv, jnp.stack([s_f, s_b], axis=1))


def latent_mixers(h, prm, lam_init, cache):
    B, T, _ = h.shape
    ckv_c, kr_c, dk_c, dv_c, nk_c, nv_c, st = cache
    (mq, mckv, mkr, dq, dk, dv, nq, nk, nv, rq, rk, rv, rg, gates) = split_cols(h @ prm['w_in'])
    ckv = rmsnorm(mckv, prm['mla_kv_norm'])
    kr = axial_rope(mkr[:, :, None, :])[:, :, 0]
    k_lat, v_lat = mla_keys(ckv, kr, prm['w_mla_ukv'])
    k_ctx, v_ctx = mla_keys(ckv_c, kr_c, prm['w_mla_ukv'])
    q = mq.reshape(B, T, MLA_HEADS, MLA_NOPE + MLA_ROPE)
    q = jnp.concatenate([q[..., :MLA_NOPE], axial_rope(q[..., MLA_NOPE:])], axis=-1)
    y_a = attend(q, jnp.concatenate([k_lat, k_ctx], axis=1),
                 jnp.concatenate([v_lat, v_ctx], axis=1)).reshape(B, T, -1)
    dq = axial_rope(dq.reshape(B, T, 2 * DIFF_HEADS, DIFF_QK)).reshape(B, T, DIFF_HEADS, 2, DIFF_QK)
    dk = axial_rope(dk.reshape(B, T, 2 * DIFF_HEADS, DIFF_QK)).reshape(B, T, DIFF_HEADS, 2, DIFF_QK)
    dv = dv.reshape(B, T, DIFF_HEADS, DIFF_V)
    y_b = diff_branch(dq, jnp.concatenate([dk, dk_c], axis=1),
                      jnp.concatenate([dv, dv_c], axis=1), prm, lam_init)
    nq, nk, nv = [t.reshape(B, T, NA_HEADS, NA_DIM) for t in (nq, nk, nv)]
    y_c = na_latent(nq, nk, nv, nk_c, nv_c, prm['na_rel_bias'])
    st = st.astype(jnp.float32)
    y_d, _, _ = retention(rq, rk, rv, rg, prm, st[:, 0], st[:, 1])
    return merge_branches((y_a, y_b, y_c, y_d), gates, prm)


def setup_inputs(seed: int = 0) -> dict:
    key = jax.random.key(seed)
    ks = iter(jax.random.split(key, 40))
    f32 = jnp.float32

    def nrm(shape, scale=1.0):
        return jax.random.normal(next(ks), shape, f32) * scale

    ret_base = jnp.log(2.0 ** (5.0 + jnp.arange(RET_HEADS, dtype=f32)) - 1.0)
    return {
        'x_prompt': nrm((BATCH, SEQ, D_MODEL)),
        'x_sample': nrm((DEC_BATCH, DEC_SEQ, D_MODEL)),
        'cache_mla_ckv': nrm((DEC_BATCH, DEPTH, PAST_LEN, MLA_KV_RANK)),
        'cache_mla_krope': nrm((DEC_BATCH, DEPTH, PAST_LEN, MLA_ROPE)),
        'cache_diff_k': nrm((DEC_BATCH, DEPTH, PAST_LEN, DIFF_HEADS, 2, DIFF_QK)),
        'cache_diff_v': nrm((DEC_BATCH, DEPTH, PAST_LEN, DIFF_HEADS, DIFF_V)),
        'cache_na_k': nrm((DEC_BATCH, DEPTH, PAST_LEN, NA_HEADS, NA_DIM)),
        'cache_na_v': nrm((DEC_BATCH, DEPTH, PAST_LEN, NA_HEADS, NA_DIM)),
        'state_ret': nrm((DEC_BATCH, DEPTH, 2, RET_HEADS, RET_QK, RET_V), 0.5),
        'c': nrm((DEC_BATCH, D_MODEL)),
        'c_ctx': nrm((D_MODEL,)),
        'w_ada': nrm((DEPTH, D_MODEL, 6 * D_MODEL), 0.5 * D_MODEL ** -0.5),
        'b_ada': nrm((DEPTH, 6 * D_MODEL), 0.02),
        'g_attn': 1.0 + nrm((DEPTH, D_MODEL), 0.02),
        'g_ffn': 1.0 + nrm((DEPTH, D_MODEL), 0.02),
        'w_in': nrm((DEPTH, D_MODEL, IN_WIDTH), D_MODEL ** -0.5),
        'mla_kv_norm': 1.0 + nrm((DEPTH, MLA_KV_RANK), 0.02),
        'w_mla_ukv': nrm((DEPTH, MLA_KV_RANK, MLA_HEADS * (MLA_NOPE + MLA_V)), MLA_KV_RANK ** -0.5),
        'diff_lambda': nrm((DEPTH, 4, DIFF_QK), 0.1),
        'diff_norm': 1.0 + nrm((DEPTH, DIFF_HEADS * DIFF_V), 0.02),
        'na_rel_bias': nrm((DEPTH, NA_HEADS, 2 * NA_ROWS - 1, 2 * NA_COLS - 1), 0.1),
        'ret_decay': ret_base + nrm((DEPTH, 2, RET_HEADS), 0.1),
        'ret_norm': 1.0 + nrm((DEPTH, RET_HEADS * RET_V), 0.02),
        'w_branch': nrm((DEPTH, N_BRANCH, BRANCH_W, D_MODEL), BRANCH_W ** -0.5),
        'w_o': nrm((DEPTH, D_MODEL, D_MODEL), D_MODEL ** -0.5),
        'w_up': nrm((DEPTH, D_MODEL, 2 * D_FF), D_MODEL ** -0.5),
        'conv_w': nrm((DEPTH, CONV_W, 2 * D_FF), CONV_W ** -0.5),
        'conv_b': nrm((DEPTH, 2 * D_FF), 0.02),
        'w_down': nrm((DEPTH, D_FF, D_MODEL), D_FF ** -0.5),
        'g_final': 1.0 + nrm((D_MODEL,), 0.02),
    }


def reference(x_prompt, x_sample, cache_mla_ckv, cache_mla_krope, cache_diff_k, cache_diff_v,
              cache_na_k, cache_na_v, state_ret, c, c_ctx, w_ada, b_ada, g_attn, g_ffn, w_in,
              mla_kv_norm, w_mla_ukv, diff_lambda, diff_norm, na_rel_bias, ret_decay, ret_norm,
              w_branch, w_o, w_up, conv_w, conv_b, w_down, g_final):
    xc, xl = x_prompt, x_sample
    ctx_tensors = []
    for l in range(DEPTH):
        prm = {'w_in': w_in[l], 'mla_kv_norm': mla_kv_norm[l], 'w_mla_ukv': w_mla_ukv[l],
               'diff_lambda': diff_lambda[l], 'diff_norm': diff_norm[l], 'na_rel_bias': na_rel_bias[l],
               'ret_decay': ret_decay[l], 'ret_norm': ret_norm[l], 'w_branch': w_branch[l], 'w_o': w_o[l],
               'w_up': w_up[l], 'conv_w': conv_w[l], 'conv_b': conv_b[l], 'w_down': w_down[l]}
        lam_init = 0.8 - 0.6 * math.exp(-0.3 * l)
        sh1, sc1, ga1, sh2, sc2, ga2 = ada_mod(c_ctx, w_ada[l], b_ada[l])
        y, ctx_l = context_mixers(modulate(xc, g_attn[l], sh1, sc1), prm, lam_init)
        xc = xc + ga1 * y
        xc = xc + ga2 * conv_ffn(modulate(xc, g_ffn[l], sh2, sc2), prm)
        ctx_tensors.append(ctx_l)
        cache_l = (cache_mla_ckv[:, l], cache_mla_krope[:, l], cache_diff_k[:, l], cache_diff_v[:, l],
                   cache_na_k[:, l], cache_na_v[:, l], state_ret[:, l])
        sh1, sc1, ga1, sh2, sc2, ga2 = ada_mod(c, w_ada[l], b_ada[l])
        y = latent_mixers(modulate(xl, g_attn[l], sh1, sc1), prm, lam_init, cache_l)
        xl = xl + ga1 * y
        xl = xl + ga2 * conv_ffn(modulate(xl, g_ffn[l], sh2, sc2), prm)
    y_prompt = rmsnorm(xc, g_final)
    y_sample = rmsnorm(xl, g_final)
    (state_mla_ckv, state_mla_krope, state_diff_k, state_diff_v, state_na_k, state_na_v,
     new_state_ret) = [jnp.stack([t[i] for t in ctx_tensors], axis=1) for i in range(7)]
    return (y_prompt, y_sample, state_mla_ckv, state_mla_krope, state_diff_k, state_diff_v,
            state_na_k, state_na_v, new_state_ret)
```

```cpp
#include <hip/hip_runtime.h>
#include <hip/hip_cooperative_groups.h>
#include <cstdio>
namespace cg = cooperative_groups;

typedef unsigned short bf16_t;
typedef short bf16x8 __attribute__((ext_vector_type(8)));
typedef float f32x4 __attribute__((ext_vector_type(4)));
typedef float f32x16 __attribute__((ext_vector_type(16)));
typedef unsigned u32x4 __attribute__((ext_vector_type(4)));
typedef unsigned u32x2 __attribute__((ext_vector_type(2)));
#define DI __device__ __forceinline__
#ifndef MULTI
#define MULTI 0
#endif

constexpr int NTHR = 256;
constexpr int RTHR = 512;
constexpr int GRP_LDS = 73728;
constexpr int LDS_BYTES = 2 * GRP_LDS;
constexpr int DM = 2048, NTOK = 24576, NCTX = 8192, SLAT = 2560;
constexpr int NPROJ = 5888, NIN = 14080, FF = 5632, PQW = 3328;
constexpr float EPSV = 1e-6f, LOG2E = 1.4426950408889634f;

constexpr size_t SZ_WIN = (size_t)NIN * 2048 * 2, SZ_WBR = (size_t)4 * 2048 * 512 * 2, SZ_WO = (size_t)2048 * 2048 * 2,
                 SZ_WUP = (size_t)11264 * 2048 * 2, SZ_WDN = (size_t)2048 * 5632 * 2, SZ_WUKV = (size_t)1024 * 256 * 2;
constexpr size_t WO_IN = 0, WO_BR = WO_IN + SZ_WIN, WO_O = WO_BR + SZ_WBR, WO_UP = WO_O + SZ_WO, WO_DN = WO_UP + SZ_WUP, WO_UKV = WO_DN + SZ_WDN,
                 SZ_WL = WO_UKV + SZ_WUKV;
constexpr size_t OFF_MODP = 2 * SZ_WL, SZ_MODP = (size_t)16 * 2 * 9 * 12288 * 4;
constexpr size_t OFF_MOD = OFF_MODP + SZ_MODP, SZ_MOD = (size_t)2 * 9 * 12288 * 4;
constexpr size_t OFF_H = OFF_MOD + SZ_MOD, SZ_H = (size_t)NTOK * 2048 * 2;
constexpr size_t OFF_AR = OFF_H + SZ_H;
constexpr size_t OFF_Y = OFF_AR;
constexpr size_t OFF_PQ = OFF_Y + SZ_H, SZ_PQ = (size_t)NTOK * PQW * 2;
constexpr size_t OFF_MCKV = OFF_PQ + SZ_PQ, SZ_MCKV = (size_t)NTOK * 256 * 4;
constexpr size_t OFF_CKVA = OFF_MCKV + SZ_MCKV, SZ_CKVA = (size_t)28672 * 256 * 2;
constexpr size_t OFF_KV = OFF_CKVA + SZ_CKVA;
constexpr size_t NLROW = 8 * SLAT;
constexpr size_t OFF_KMC = OFF_KV, OFF_VMC = OFF_KMC + (size_t)NCTX * 768 * 2, OFF_KML = OFF_VMC + (size_t)NCTX * 512 * 2,
                 OFF_VML = OFF_KML + NLROW * 768 * 2, OFF_KDC = OFF_VML + NLROW * 512 * 2, OFF_VDC = OFF_KDC + (size_t)NCTX * 512 * 2,
                 OFF_KDL = OFF_VDC + (size_t)NCTX * 512 * 2, OFF_VDL = OFF_KDL + NLROW * 512 * 2, OFF_KNC = OFF_VDL + NLROW * 512 * 2,
                 OFF_VNC = OFF_KNC + (size_t)NCTX * 512 * 2, OFF_KNL = OFF_VNC + (size_t)NCTX * 512 * 2, OFF_VNL = OFF_KNL + NLROW * 512 * 2,
                 OFF_KVEND = OFF_VNL + NLROW * 512 * 2;
constexpr size_t OFF_M = OFF_KV;
static_assert(OFF_KVEND - OFF_KV >= SZ_H, "m alias");
constexpr size_t OFF_ACT = OFF_AR, SZ_ACT = (size_t)NTOK * FF * 2;
constexpr size_t OFF_U = OFF_ACT + SZ_ACT, SZ_U = (size_t)NTOK * 4352 * 2;
static_assert(OFF_U + SZ_U <= OFF_KVEND, "ffn alias");
constexpr size_t OFF_BAR = OFF_KVEND;
constexpr size_t WS_NEED = OFF_BAR + 16384;

constexpr size_t OO_Y = 0, OO_CKV = (size_t)NTOK * 2048, OO_KR = OO_CKV + 4194304, OO_DK = OO_KR + 524288, OO_DV = OO_DK + 8388608,
                 OO_NK = OO_DV + 8388608, OO_NV = OO_NK + 8388608, OO_RET = OO_NV + 8388608;

struct Params {
  const float *x_prompt, *x_sample, *c_ckv, *c_kr, *c_dk, *c_dv, *c_nk, *c_nv, *st_ret, *c, *c_ctx, *w_ada, *b_ada, *g_attn, *g_ffn, *w_in,
      *kv_norm, *w_ukv, *diff_lambda, *diff_norm, *na_bias, *ret_decay, *ret_norm, *w_branch, *w_o, *w_up, *conv_w, *conv_b, *w_down, *g_final;
  float* out;
  char* ws;
  int step_lo, step_hi;
};

typedef __attribute__((address_space(4))) const Params KP;
DI unsigned short f2bf(float f) { unsigned u = __float_as_uint(f); u += 0x7fffu + ((u >> 16) & 1u); return (unsigned short)(u >> 16); }
typedef __bf16 bf16v2_t __attribute__((ext_vector_type(2)));
typedef float f32v2_t __attribute__((ext_vector_type(2)));
DI unsigned pack2(float a, float b) { f32v2_t v = {a, b}; return __builtin_bit_cast(unsigned, __builtin_convertvector(v, bf16v2_t)); }
DI float bf2f(unsigned short h) { return __uint_as_float(((unsigned)h) << 16); }
DI float bflo(unsigned u) { return __uint_as_float(u << 16); }
DI float bfhi(unsigned u) { return __uint_as_float(u & 0xffff0000u); }
typedef __attribute__((address_space(1))) const u32x4 g_u32x4;
DI u32x4 gld16(const void* p) { return *(g_u32x4*)p; }
#define SCHED_FENCE() __builtin_amdgcn_sched_barrier(0)
DI int ltid() { int t = threadIdx.x; asm volatile("" : "+v"(t)); return t & 255; }
DI int rtid() { int t = threadIdx.x; asm volatile("" : "+v"(t)); return t; }
DI int vgrp() { return __builtin_amdgcn_readfirstlane((int)(threadIdx.x >> 8)); }
DI int VB() { return (int)blockIdx.x * 2 + vgrp(); }
DI int VG() { return (int)gridDim.x * 2; }
DI float shx(float v, int o) {
  int l = __builtin_amdgcn_mbcnt_hi(~0u, __builtin_amdgcn_mbcnt_lo(~0u, 0u));
  asm volatile("" : "+v"(l));
  return __int_as_float(__builtin_amdgcn_ds_bpermute((l ^ o) << 2, __float_as_int(v)));
}
DI float x32_max(float v) { auto r = __builtin_amdgcn_permlane32_swap(__float_as_uint(v), __float_as_uint(v), false, false); return fmaxf(__uint_as_float(r[0]), __uint_as_float(r[1])); }
DI float x32_sum(float v) { auto r = __builtin_amdgcn_permlane32_swap(__float_as_uint(v), __float_as_uint(v), false, false); return __uint_as_float(r[0]) + __uint_as_float(r[1]); }
DI float wave_sum(float v) {
#pragma unroll
  for (int o = 32; o >= 1; o >>= 1) v += shx(v, o);
  return v;
}
DI float sigmoidf_(float x) { return 1.f / (1.f + __expf(-x)); }
DI int grp_of(int r) { return r < NCTX ? 0 : 1 + ((r - NCTX) >> 11); }
DI int kvrow_of(int r) { int rr = r - NCTX; return (rr >> 11) * SLAT + (rr & 2047); }
DI const float* xrow_in(KP& p, int r) { return r < NCTX ? p.x_prompt + (size_t)r * DM : p.x_sample + (size_t)(r - NCTX) * DM; }

template <int WN>
DI void gemm_kloop(f32x4 (&acc)[4][WN], const bf16_t* __restrict__ A, int lda, const bf16_t* __restrict__ B, int ldb, int K, char* smem) {
  const int tid = ltid(), wid = tid >> 6, lane = tid & 63, wr = wid >> 1, wc = wid & 1, fr = lane & 15, fq = lane >> 4;
  const int r0 = tid >> 3, ch = tid & 7;
  const bf16_t* ap = A + (size_t)r0 * lda + ch * 8;
  const bf16_t* bp = B + (size_t)r0 * ldb + ch * 8;
  u32x4 ra0[4], rb0[WN], ra1[4], rb1[WN];
  const int nk = K >> 6;
  const int swz_w = (r0 >> 1) & 7, swz_r = (fr >> 1) & 7;
  char* sa = smem + r0 * 128 + ((ch ^ swz_w) * 16);
  char* sb = smem + 32768 + r0 * 128 + ((ch ^ swz_w) * 16);
  const char* fa = smem + (64 * wr + fr) * 128;
  const char* fb = smem + 32768 + (16 * WN * wc + fr) * 128;
  const int ko0 = ((fq ^ swz_r) * 16), ko1 = (((4 + fq) ^ swz_r) * 16);
  auto gload = [&](u32x4 (&RA)[4], u32x4 (&RB)[WN], int kt) {
#pragma unroll
    for (int i = 0; i < 4; ++i) RA[i] = gld16(ap + (size_t)(32 * i) * lda + kt * 64);
#pragma unroll
    for (int i = 0; i < WN; ++i) RB[i] = gld16(bp + (size_t)(32 * i) * ldb + kt * 64);
  };
  auto sstore = [&](const u32x4 (&RA)[4], const u32x4 (&RB)[WN], int buf) {
#pragma unroll
    for (int i = 0; i < 4; ++i) *(u32x4*)(sa + buf * 16384 + i * 32 * 128) = RA[i];
#pragma unroll
    for (int i = 0; i < WN; ++i) *(u32x4*)(sb + buf * 16384 + i * 32 * 128) = RB[i];
  };
  auto compute = [&](int buf) {
#pragma unroll
    for (int ks = 0; ks < 2; ++ks) {
      bf16x8 af[4], bfr[WN];
#pragma unroll
      for (int mi = 0; mi < 4; ++mi) af[mi] = *(const bf16x8*)(fa + buf * 16384 + mi * 16 * 128 + (ks ? ko1 : ko0));
#pragma unroll
      for (int ni = 0; ni < WN; ++ni) bfr[ni] = *(const bf16x8*)(fb + buf * 16384 + ni * 16 * 128 + (ks ? ko1 : ko0));
#pragma unroll
      for (int mi = 0; mi < 4; ++mi)
#pragma unroll
        for (int ni = 0; ni < WN; ++ni) acc[mi][ni] = __builtin_amdgcn_mfma_f32_16x16x32_bf16(bfr[ni], af[mi], acc[mi][ni], 0, 0, 0);
    }
  };
  auto step = [&](u32x4 (&RA)[4], u32x4 (&RB)[WN], int buf, int kt) {
    compute(buf);
    SCHED_FENCE();
    if (kt + 1 < nk) {
      sstore(RA, RB, buf ^ 1);
      if (kt + 3 < nk) gload(RA, RB, kt + 3);
    }
    SCHED_FENCE();
    __syncthreads();
  };
  gload(ra0, rb0, 0);
  gload(ra1, rb1, 1);
  __syncthreads();
  sstore(ra0, rb0, 0);
  gload(ra0, rb0, 2);
  SCHED_FENCE();
  __syncthreads();
#pragma unroll 1
  for (int kt = 0; kt < nk; kt += 2) {
    step(ra1, rb1, 0, kt);
    step(ra0, rb0, 1, kt + 1);
  }
}

template <int WN, class F>
DI void gemm_epilogue(const f32x4 (&acc)[4][WN], char* smem, int m0, int n0, const F& f) {
  constexpr int BN = 32 * WN, CS = BN + 4;
  const int tid = ltid(), wid = tid >> 6, lane = tid & 63, wr = wid >> 1, wc = wid & 1, fr = lane & 15, fq = lane >> 4;
  float* ct = (float*)smem;
#pragma unroll
  for (int mi = 0; mi < 4; ++mi)
#pragma unroll
    for (int ni = 0; ni < WN; ++ni) *(f32x4*)(ct + (64 * wr + 16 * mi + fr) * CS + 16 * WN * wc + 16 * ni + 4 * fq) = acc[mi][ni];
  __syncthreads();
  constexpr int CPR = BN / 32;
#pragma unroll 1
  for (int u = tid; u < 128 * CPR; u += NTHR) {
    const int row = u / CPR, chn = u % CPR;
    float v[32];
#pragma unroll
    for (int j = 0; j < 8; ++j) {
      f32x4 t = *(const f32x4*)(ct + row * CS + chn * 32 + 4 * j);
      v[4 * j] = t[0]; v[4 * j + 1] = t[1]; v[4 * j + 2] = t[2]; v[4 * j + 3] = t[3];
    }
    f(m0 + row, n0 + chn * 32, v);
  }
  __syncthreads();
}

DI void store_bf16_32(bf16_t* dst, const float (&v)[32]) {
#pragma unroll
  for (int j = 0; j < 4; ++j) {
    u32x4 t;
    t[0] = pack2(v[8 * j], v[8 * j + 1]); t[1] = pack2(v[8 * j + 2], v[8 * j + 3]);
    t[2] = pack2(v[8 * j + 4], v[8 * j + 5]); t[3] = pack2(v[8 * j + 6], v[8 * j + 7]);
    *(u32x4*)(dst + 8 * j) = t;
  }
}
DI void store_f32_32(float* dst, const float (&v)[32]) {
#pragma unroll
  for (int j = 0; j < 8; ++j) { f32x4 t = {v[4 * j], v[4 * j + 1], v[4 * j + 2], v[4 * j + 3]}; *(f32x4*)(dst + 4 * j) = t; }
}


DI bool tile_map(int t, int nM, int nN, int PMS, int& pm, int& pn) {
  if (t >= nM * nN) return false;
  const int per_g = PMS * nN, g = t / per_g, r = t % per_g, j = r / (4 * PMS), q = r - j * 4 * PMS;
  pm = PMS * g + (q % PMS); pn = 4 * j + (q / PMS);
  return true;
}
DI int vtile_slot(int i) { const int b = blockIdx.x; return (i * 8 + (b & 7)) * ((int)(gridDim.x >> 3) * 2) + (b >> 3) * 2 + vgrp(); }
DI int rtile_slot(int i) { const int b = blockIdx.x; return (i * 8 + (b & 7)) * (int)(gridDim.x >> 3) + (b >> 3); }

template <int NI>
DI void gemm256_kloop(f32x4 (&acc)[8][NI], u32x4 (&ra)[4], u32x4 (&rb)[NI], const bf16_t* __restrict__ A, int lda, const bf16_t* __restrict__ B, int ldb, int K,
                      const bf16_t* __restrict__ An, int ldan, const bf16_t* __restrict__ Bn, int ldbn, bool chained, char* smem) {
  const int tid = rtid(), wid = tid >> 6, lane = tid & 63, wr = wid >> 2, wc = wid & 3, fr = lane & 15, fq = lane >> 4;
  const int r0 = tid >> 3, ch = tid & 7;
  const bf16_t* ap = A + (size_t)r0 * lda + ch * 8;
  const bf16_t* bp = B + (size_t)r0 * ldb + ch * 8;
  const bf16_t* apn = An + (size_t)r0 * ldan + ch * 8;
  const bf16_t* bpn = Bn + (size_t)r0 * ldbn + ch * 8;
  const int nk = K >> 6;
  const int swz_w = (r0 >> 1) & 7, swz_r = (fr >> 1) & 7;
  char* sa = smem + r0 * 128 + ((ch ^ swz_w) * 16);
  char* sb = smem + 65536 + r0 * 128 + ((ch ^ swz_w) * 16);
  const char* fa = smem + (128 * wr + fr) * 128;
  const char* fb = smem + 65536 + (16 * NI * wc + fr) * 128;
  const int ko0 = ((fq ^ swz_r) * 16), ko1 = (((4 + fq) ^ swz_r) * 16);
  auto gload = [&](int kt) {
#pragma unroll
    for (int i = 0; i < 4; ++i) ra[i] = gld16(ap + (size_t)(64 * i) * lda + kt * 64);
#pragma unroll
    for (int i = 0; i < NI; ++i) rb[i] = gld16(bp + (size_t)(64 * i) * ldb + kt * 64);
  };
  auto sstore = [&](int buf) {
#pragma unroll
    for (int i = 0; i < 4; ++i) *(u32x4*)(sa + buf * 32768 + i * 64 * 128) = ra[i];
#pragma unroll
    for (int i = 0; i < NI; ++i) *(u32x4*)(sb + buf * 32768 + i * 64 * 128) = rb[i];
  };
  if (!chained) {
    gload(0);
    __syncthreads();
    sstore(0);
    gload(1);
    SCHED_FENCE();
    __syncthreads();
  }
  auto ktile = [&](int buf, int ktn, bool nxt) {
    const char* pa = fa + buf * 32768;
    const char* pb = fb + buf * 32768;
    constexpr int RD = (NI == 4) ? 2 : 4;
    bf16x8 b0[NI], b1[NI], ar[RD];
#pragma unroll
    for (int ni = 0; ni < NI; ++ni) b0[ni] = *(const bf16x8*)(pb + ni * 2048 + ko0);
#pragma unroll
    for (int d = 0; d < RD; ++d) ar[d] = *(const bf16x8*)(pa + d * 2048 + ko0);
#pragma unroll
    for (int g = 0; g < 16; ++g) {
      const int mi = g & 7;
#pragma unroll
      for (int ni = 0; ni < NI; ++ni)
        acc[mi][ni] = __builtin_amdgcn_mfma_f32_16x16x32_bf16(g < 8 ? b0[ni] : b1[ni], ar[g % RD], acc[mi][ni], 0, 0, 0);
      if (g + RD < 16) ar[g % RD] = *(const bf16x8*)(pa + ((g + RD) & 7) * 2048 + ((g + RD) < 8 ? ko0 : ko1));
      if (g >= 8 - NI && g < 8) b1[g - (8 - NI)] = *(const bf16x8*)(pb + (g - (8 - NI)) * 2048 + ko1);
      if ((g & 1) == 0) {
        const int pc = g >> 1;
        if (pc < 4) {
          *(u32x4*)(sa + (buf ^ 1) * 32768 + pc * 64 * 128) = ra[pc];
          ra[pc] = gld16(nxt ? apn + (size_t)(64 * pc) * ldan + ktn * 64 : ap + (size_t)(64 * pc) * lda + ktn * 64);
        } else if (pc - 4 < NI) {
          *(u32x4*)(sb + (buf ^ 1) * 32768 + (pc - 4) * 64 * 128) = rb[pc - 4];
          rb[pc - 4] = gld16(nxt ? bpn + (size_t)(64 * (pc - 4)) * ldbn + ktn * 64 : bp + (size_t)(64 * (pc - 4)) * ldb + ktn * 64);
        }
      }
    }
    __builtin_amdgcn_sched_group_barrier(0x100, NI + RD, 0);
#pragma unroll
    for (int g = 0; g < 16; ++g) {
      __builtin_amdgcn_sched_group_barrier(0x008, NI, 0);
      if (g + RD < 16) __builtin_amdgcn_sched_group_barrier(0x100, 1, 0);
      if (g >= 8 - NI && g < 8) __builtin_amdgcn_sched_group_barrier(0x100, 1, 0);
      if ((g & 1) == 0 && ((g >> 1) < 4 || (g >> 1) - 4 < NI)) { __builtin_amdgcn_sched_group_barrier(0x200, 1, 0); __builtin_amdgcn_sched_group_barrier(0x020, 1, 0); }
    }
  };
#pragma unroll 1
  for (int kt = 0; kt < nk; ++kt) {
    const int buf = kt & 1;
    const bool nxt = kt + 2 >= nk;
    const int ktn = nxt ? kt + 2 - nk : kt + 2;
    ktile(buf, ktn, nxt);
    __syncthreads();
  }
}

template <int NI, class F>
DI void gemm256_epilogue(const f32x4 (&acc)[8][NI], char* smem, int m0, int n0, const F& f) {
  constexpr int CSB = NI * 128 + 16, CPR = NI * 2;
  const int tid = rtid(), wid = tid >> 6, lane = tid & 63, wr = wid >> 2, wc = wid & 3, fr = lane & 15, fq = lane >> 4;
#pragma unroll
  for (int mi = 0; mi < 8; ++mi)
#pragma unroll
    for (int ni = 0; ni < NI; ++ni) {
      u32x2 t = {pack2(acc[mi][ni][0], acc[mi][ni][1]), pack2(acc[mi][ni][2], acc[mi][ni][3])};
      *(u32x2*)(smem + (128 * wr + 16 * mi + fr) * CSB + (16 * NI * wc + 16 * ni + 4 * fq) * 2) = t;
    }
  __syncthreads();
#pragma unroll 1
  for (int u = tid; u < 256 * CPR; u += RTHR) {
    const int row = u / CPR, chn = u % CPR;
    float v[32];
#pragma unroll
    for (int j = 0; j < 4; ++j) {
      const u32x4 t = *(const u32x4*)(smem + row * CSB + chn * 64 + 16 * j);
#pragma unroll
      for (int e = 0; e < 4; ++e) { v[8 * j + 2 * e] = bflo(t[e]); v[8 * j + 2 * e + 1] = bfhi(t[e]); }
    }
    f(m0 + row, n0 + chn * 32, v);
  }
  __syncthreads();
}

template <class F>
DI void gemm256_phase(const bf16_t* A, int lda, const bf16_t* B, int ldb, int K, int nM, int nN, int pn_base, const F& f, char* smem) {
  for (int it = 0;; ++it) {
    int pm, pn;
    if (!tile_map(rtile_slot(it), nM, nN, 8, pm, pn)) break;
    pn += pn_base;
    f32x4 acc[8][4];
#pragma unroll
    for (int mi = 0; mi < 8; ++mi)
#pragma unroll
      for (int ni = 0; ni < 4; ++ni) acc[mi][ni] = (f32x4){0.f, 0.f, 0.f, 0.f};
    u32x4 ra[4], rb[4];
    const bf16_t* At = A + (size_t)pm * 256 * lda; const bf16_t* Bt = B + (size_t)pn * 256 * ldb;
    gemm256_kloop<4>(acc, ra, rb, At, lda, Bt, ldb, K, At, lda, Bt, ldb, false, smem);
    gemm256_epilogue<4>(acc, smem, pm * 256, pn * 256, f);
  }
}

template <int NF>
DI void rope_seg(float* v, float pos) {
#pragma unroll
  for (int f = 0; f < NF; ++f) {
    const float inv = exp2f(-(float)f / (float)NF * 13.287712379549449f) * 0.15915494309189535f;
    const float rev = pos * inv;
    const float cs = __builtin_amdgcn_cosf(rev), sn = __builtin_amdgcn_sinf(rev);
    const float a = v[f], b = v[NF + f];
    v[f] = a * cs - b * sn;
    v[NF + f] = b * cs + a * sn;
  }
}

struct ProjEpi {
  char* ws; float* out; int l;
  DI void state_out(size_t base, int W, int r, int c, const float (&v)[32]) const {
    const int b = r >> 8, t = r & 255;
    store_f32_32(out + base + ((size_t)((b * 2 + l) * 256 + t)) * W + c, v);
  }
  DI void operator()(int r, int c0, float (&v)[32]) const {
    bf16_t* const pq = (bf16_t*)(ws + OFF_PQ); bf16_t* const kmc = (bf16_t*)(ws + OFF_KMC); bf16_t* const kml = (bf16_t*)(ws + OFF_KML);
    bf16_t* const kdc = (bf16_t*)(ws + OFF_KDC); bf16_t* const vdc = (bf16_t*)(ws + OFF_VDC); bf16_t* const kdl = (bf16_t*)(ws + OFF_KDL);
    bf16_t* const vdl = (bf16_t*)(ws + OFF_VDL); bf16_t* const knc = (bf16_t*)(ws + OFF_KNC); bf16_t* const vnc = (bf16_t*)(ws + OFF_VNC);
    bf16_t* const knl = (bf16_t*)(ws + OFF_KNL); bf16_t* const vnl = (bf16_t*)(ws + OFF_VNL); float* const mckv = (float*)(ws + OFF_MCKV);
    const bool lat = r >= NCTX;
    int prow = 0, pcol = 0;
    if (lat) { const int t = (r - NCTX) & 2047; prow = t >> 6; pcol = t & 63; }
    if (c0 < 768) {
      if (lat && (c0 % 96) == 64) { rope_seg<8>(v, (float)prow); rope_seg<8>(v + 16, (float)pcol); }
      store_bf16_32(pq + (size_t)r * PQW + c0, v);
    } else if (c0 < 1024) {
      store_f32_32(mckv + (size_t)r * 256 + (c0 - 768), v);
    } else if (c0 < 1536) {
      if (lat) rope_seg<16>(v, (float)((((c0 - 1024) >> 5) & 1) ? pcol : prow));
      store_bf16_32(pq + (size_t)r * PQW + 768 + (c0 - 1024), v);
    } else if (c0 < 2048) {
      const int c = c0 - 1536;
      if (lat) { rope_seg<16>(v, (float)(((c >> 5) & 1) ? pcol : prow)); store_bf16_32(kdl + (size_t)kvrow_of(r) * 512 + c, v); }
      else { store_bf16_32(kdc + (size_t)r * 512 + c, v); state_out(OO_DK, 512, r, c, v); }
    } else if (c0 < 2560) {
      const int c = c0 - 2048;
      if (lat) store_bf16_32(vdl + (size_t)kvrow_of(r) * 512 + c, v);
      else { store_bf16_32(vdc + (size_t)r * 512 + c, v); state_out(OO_DV, 512, r, c, v); }
    } else if (c0 < 3072) {
      store_bf16_32(pq + (size_t)r * PQW + 1280 + (c0 - 2560), v);
    } else if (c0 < 3584) {
      const int c = c0 - 3072;
      if (lat) store_bf16_32(knl + (size_t)kvrow_of(r) * 512 + c, v);
      else { store_bf16_32(knc + (size_t)r * 512 + c, v); state_out(OO_NK, 512, r, c, v); }
    } else if (c0 < 4096) {
      const int c = c0 - 3584;
      if (lat) store_bf16_32(vnl + (size_t)kvrow_of(r) * 512 + c, v);
      else { store_bf16_32(vnc + (size_t)r * 512 + c, v); state_out(OO_NV, 512, r, c, v); }
    } else if (c0 < 5632) {
      store_bf16_32(pq + (size_t)r * PQW + 1792 + (c0 - 4096), v);
    } else if (c0 == 5632) {
      bf16_t* dst;
      if (lat) { rope_seg<8>(v, (float)prow); rope_seg<8>(v + 16, (float)pcol); dst = kml + (size_t)kvrow_of(r) * 768; }
      else { state_out(OO_KR, 32, r, 0, v); dst = kmc + (size_t)r * 768; }
#pragma unroll 1
      for (int h = 0; h < 8; ++h) store_bf16_32(dst + h * 96 + 64, v);
    }
  }
};

struct UkvEpi {
  char* ws;
  DI void operator()(int R, int c0, float (&v)[32]) const {
    size_t row, ko, vo;
    if (R < NCTX) { ko = OFF_KMC; vo = OFF_VMC; row = R; }
    else if (R < NTOK) { ko = OFF_KML; vo = OFF_VML; row = kvrow_of(R); }
    else { const int c = R - NTOK; ko = OFF_KML; vo = OFF_VML; row = (size_t)(c >> 9) * SLAT + 2048 + (c & 511); }
    const int hd = c0 >> 7, e = c0 & 127;
    if (e < 64) store_bf16_32((bf16_t*)(ws + ko) + row * 768 + hd * 96 + e, v);
    else store_bf16_32((bf16_t*)(ws + vo) + row * 512 + hd * 64 + (e - 64), v);
  }
};

struct StoreBf16Epi {
  bf16_t* dst; int ld; int coff;
  DI void operator()(int r, int c0, float (&v)[32]) const { store_bf16_32(dst + (size_t)r * ld + (c0 - coff), v); }
};

struct ResidEpi {
  const float* xp; const float* xs; float* out; const float* ga;
  DI void operator()(int r, int c0, float (&v)[32]) const {
    const float* xr = (r < NCTX ? xp + (size_t)r * DM : xs + (size_t)(r - NCTX) * DM) + c0;
    const float* g = ga + (size_t)grp_of(r) * 12288 + c0;
    float* o = out + (size_t)r * DM + c0;
#pragma unroll
    for (int j = 0; j < 8; ++j) {
      const f32x4 xv = *(const f32x4*)(xr + 4 * j), gv = *(const f32x4*)(g + 4 * j);
      f32x4 t = {xv[0] + gv[0] * v[4 * j], xv[1] + gv[1] * v[4 * j + 1], xv[2] + gv[2] * v[4 * j + 2], xv[3] + gv[3] * v[4 * j + 3]};
      *(f32x4*)(o + 4 * j) = t;
    }
  }
};

struct AttnArgs {
  const bf16_t *q, *k, *v; int q_ld, k_ld, v_ld; int n_keys; float sl2;
  bf16_t* y; int y_ld;
  int R0; const float* bias;
  int t0, T; float lgf, lgb; const float *s0f, *s0b; const bf16_t* rg; int rg_ld; const float* nw;
  float lam, omli;
};

constexpr int A_VT = 13312, A_BIAS = 30720, A_S0 = 32768;

template <int DQ, int DV, int MODE>
DI void attn_block(char* smem, const AttnArgs& a) {
  constexpr int KSTR = (DQ + 8) * 2, CK = DQ / 8, NKL = 64 * CK / NTHR, NVL = (32 * DV / 8) / NTHR, NKS = DQ / 16, NDB = DV / 32;
  const int tid = ltid(), w = tid >> 6, lane = tid & 63, ql = lane & 31, g = lane >> 5;
  const int qloc = 32 * w + ql;
  f32x16 O[NDB];
  float m_run = -1e30f, l_run = 0.f;
#pragma unroll
  for (int d = 0; d < NDB; ++d)
#pragma unroll
    for (int i = 0; i < 16; ++i) O[d][i] = 0.f;

  int na_r = 0, na_c = 0, na_rs = 0, na_cs = 0, rlo = 0, nloc = 0;
  if (MODE == 1) {
    na_r = a.R0 + (w >> 1); na_c = 32 * (w & 1) + ql;
    na_rs = min(max(na_r - 4, 0), 24); na_cs = min(max(na_c - 8, 0), 48);
    rlo = min(max(a.R0 - 4, 0), 24);
    nloc = 9;
    __syncthreads();
    float* bl = (float*)(smem + A_BIAS);
    for (int i = tid; i < 465; i += NTHR) bl[i] = a.bias[i] * LOG2E;
  }
  const int npass = (MODE == 3) ? 2 : 1;
  const int ntile = (MODE == 1) ? (nloc + 8) : (a.n_keys >> 6);
  const int t_q = a.t0 + qloc;

  bf16x8 qf[NKS];
  u32x4 rk[NKL], rv0[NVL], rv1[NVL];

  auto key0_of = [&](int it) -> int {
    if (MODE == 1) return it < nloc ? (rlo + it) * 64 : 2048 + 64 * (it - nloc);
    return it * 64;
  };
  auto prefetch = [&](int it, int pass) {
    const int key0 = key0_of(it);
    const bf16_t* kp = a.k + (MODE == 3 ? pass * 64 : 0);
#pragma unroll
    for (int i = 0; i < NKL; ++i) { const int idx = tid + NTHR * i, row = idx / CK, c = idx % CK; rk[i] = gld16(kp + (size_t)(key0 + row) * a.k_ld + 8 * c); }
#pragma unroll
    for (int i = 0; i < NVL; ++i) {
      const int idx = tid + NTHR * i, pr = idx & 31, c = idx >> 5;
      rv0[i] = gld16(a.v + (size_t)(key0 + 2 * pr) * a.v_ld + 8 * c);
      rv1[i] = gld16(a.v + (size_t)(key0 + 2 * pr + 1) * a.v_ld + 8 * c);
    }
  };
  auto stage = [&]() {
#pragma unroll
    for (int i = 0; i < NKL; ++i) { const int idx = tid + NTHR * i, row = idx / CK, c = idx % CK; *(u32x4*)(smem + row * KSTR + 16 * c) = rk[i]; }
#pragma unroll
    for (int i = 0; i < NVL; ++i) {
      const int idx = tid + NTHR * i, pr = idx & 31, c = idx >> 5;
      char* base = smem + A_VT + (8 * c) * 136 + 4 * pr;
#pragma unroll
      for (int e = 0; e < 4; ++e) {
        const unsigned x = rv0[i][e], y = rv1[i][e];
        *(unsigned*)(base + (2 * e) * 136) = (x & 0xffffu) | (y << 16);
        *(unsigned*)(base + (2 * e + 1) * 136) = (x >> 16) | (y & 0xffff0000u);
      }
    }
  };

#pragma unroll 1
  for (int pass = 0; pass < npass; ++pass) {
    {
      const bf16_t* qp = a.q + (MODE == 3 ? pass * 64 : 0) + (size_t)qloc * a.q_ld + 8 * g;
#pragma unroll
      for (int ks = 0; ks < NKS; ++ks) qf[ks] = *(const bf16x8*)(qp + 16 * ks);
    }
    prefetch(0, pass);
#pragma unroll 1
    for (int it = 0; it < ntile; ++it) {
      __syncthreads();
      stage();
      __syncthreads();
      if (it + 1 < ntile) prefetch(it + 1, pass);
      SCHED_FENCE();
      const int key0 = key0_of(it);
      bool active = true;
      int kr = 0;
      const bool local = (MODE == 1) && it < nloc;
      if (local) { kr = rlo + it; active = (kr >= na_rs) && (kr < na_rs + 8); }
      if (active) {
#pragma unroll
        for (int kb = 0; kb < 2; ++kb) {
          f32x16 s;
#pragma unroll
          for (int i = 0; i < 16; ++i) s[i] = 0.f;
          bf16x8 kfr[NKS];
#pragma unroll
          for (int ks = 0; ks < NKS; ++ks) kfr[ks] = *(const bf16x8*)(smem + (32 * kb + ql) * KSTR + (16 * ks + 8 * g) * 2);
          u32x4 vfr[NDB][2];
#pragma unroll
          for (int d = 0; d < NDB; ++d)
#pragma unroll
            for (int h2 = 0; h2 < 2; ++h2) {
              const char* vp = smem + A_VT + (32 * d + ql) * 136 + (32 * kb + 16 * h2 + 4 * g) * 2;
              const u32x2 lo = *(const u32x2*)vp, hi = *(const u32x2*)(vp + 16);
              vfr[d][h2] = (u32x4){lo[0], lo[1], hi[0], hi[1]};
            }
          SCHED_FENCE();
#pragma unroll
          for (int ks = 0; ks < NKS; ++ks) s = __builtin_amdgcn_mfma_f32_32x32x16_bf16(kfr[ks], qf[ks], s, 0, 0, 0);
          float p[16];
          if (MODE == 2) {
#pragma unroll
            for (int i = 0; i < 16; ++i) {
              const int j = key0 + 32 * kb + 8 * (i >> 2) + 4 * g + (i & 3);
              const int d = t_q - j;
              const float e = d >= 0 ? (float)d * a.lgf : (float)(-d) * a.lgb;
              p[i] = s[i] * a.sl2 * __builtin_amdgcn_exp2f(e);
            }
          } else {
            if (local) {
              const float* bl = (const float*)(smem + A_BIAS) + (kr - na_r + 7) * 31 + 15;
#pragma unroll
              for (int i = 0; i < 16; ++i) {
                const int kc = 32 * kb + 8 * (i >> 2) + 4 * g + (i & 3);
                const int dc = min(max(kc - na_c, -15), 15);
                const bool ok = (kc >= na_cs) && (kc < na_cs + 16);
                p[i] = ok ? (s[i] * a.sl2 + bl[dc]) : -1e30f;
              }
            }
            float mx;
            if (local) {
              mx = p[0];
#pragma unroll
              for (int i = 1; i < 16; ++i) mx = fmaxf(mx, p[i]);
            } else {
              mx = s[0];
#pragma unroll
              for (int i = 1; i < 16; ++i) mx = fmaxf(mx, s[i]);
              mx *= a.sl2;
            }
            mx = x32_max(mx);
            const float m_new = fmaxf(m_run, mx);
            const float alpha = __builtin_amdgcn_exp2f(m_run - m_new);
            m_run = m_new;
            float ls = 0.f;
            if (local) {
#pragma unroll
              for (int i = 0; i < 16; ++i) { p[i] = __builtin_amdgcn_exp2f(p[i] - m_new); ls += p[i]; }
            } else {
#pragma unroll
              for (int i = 0; i < 16; ++i) { p[i] = __builtin_amdgcn_exp2f(__builtin_fmaf(s[i], a.sl2, -m_new)); ls += p[i]; }
            }
            l_run = l_run * alpha + ls;
            if (__ballot(alpha != 1.f) != 0ull) {
#pragma unroll
              for (int d = 0; d < NDB; ++d)
#pragma unroll
                for (int i = 0; i < 16; ++i) O[d][i] *= alpha;
            }
          }
          bf16x8 pf[2];
#pragma unroll
          for (int h2 = 0; h2 < 2; ++h2) {
            u32x4 t;
#pragma unroll
            for (int e = 0; e < 4; ++e) t[e] = pack2(p[8 * h2 + 2 * e], p[8 * h2 + 2 * e + 1]);
            pf[h2] = __builtin_bit_cast(bf16x8, t);
          }
#pragma unroll
          for (int d = 0; d < NDB; ++d)
#pragma unroll
            for (int h2 = 0; h2 < 2; ++h2) {
              O[d] = __builtin_amdgcn_mfma_f32_32x32x16_bf16(__builtin_bit_cast(bf16x8, vfr[d][h2]), pf[h2], O[d], 0, 0, 0);
            }
        }
      }
    }
    if (MODE == 3 && pass == 0) {
      const float lt = x32_sum(l_run);
      const float inv = 1.f / lt;
#pragma unroll
      for (int d = 0; d < NDB; ++d)
#pragma unroll
        for (int i4 = 0; i4 < 4; ++i4) {
          u32x2 t = {pack2(O[d][4 * i4] * inv, O[d][4 * i4 + 1] * inv), pack2(O[d][4 * i4 + 2] * inv, O[d][4 * i4 + 3] * inv)};
          *(u32x2*)(smem + A_S0 + qloc * 264 + (32 * d + 8 * i4 + 4 * g) * 2) = t;
          O[d][4 * i4] = 0.f; O[d][4 * i4 + 1] = 0.f; O[d][4 * i4 + 2] = 0.f; O[d][4 * i4 + 3] = 0.f;
        }
      m_run = -1e30f; l_run = 0.f;
    }
  }

  if (MODE == 2 && a.s0f != nullptr) {
#pragma unroll 1
    for (int dir = 0; dir < 2; ++dir) {
      const float* s0 = dir ? a.s0b : a.s0f;
      __syncthreads();
      for (int idx = tid; idx < 64 * 32; idx += NTHR) {
        const int dk = idx >> 5, dv4 = (idx & 31) * 4;
        const f32x4 t = *(const f32x4*)(s0 + dk * 128 + dv4);
#pragma unroll
        for (int e = 0; e < 4; ++e) *(bf16_t*)(smem + A_S0 + (dv4 + e) * 144 + dk * 2) = f2bf(t[e]);
      }
      __syncthreads();
      const float sc = dir ? __builtin_amdgcn_exp2f((float)(a.T - t_q) * a.lgb) : __builtin_amdgcn_exp2f((float)(t_q + 1) * a.lgf);
#pragma unroll
      for (int d = 0; d < NDB; ++d) {
        f32x16 tacc;
#pragma unroll
        for (int i = 0; i < 16; ++i) tacc[i] = 0.f;
#pragma unroll
        for (int ks = 0; ks < NKS; ++ks) {
          const bf16x8 sf = *(const bf16x8*)(smem + A_S0 + (32 * d + ql) * 144 + (16 * ks + 8 * g) * 2);
          tacc = __builtin_amdgcn_mfma_f32_32x32x16_bf16(sf, qf[ks], tacc, 0, 0, 0);
        }
#pragma unroll
        for (int i = 0; i < 16; ++i) O[d][i] += sc * tacc[i];
      }
    }
  }

  if (MODE == 0 || MODE == 1) {
    const float lt = x32_sum(l_run);
    const float inv = 1.f / lt;
#pragma unroll
    for (int d = 0; d < NDB; ++d)
#pragma unroll
      for (int i = 0; i < 16; ++i) O[d][i] *= inv;
  } else if (MODE == 3) {
    const float lt = x32_sum(l_run);
    const float inv = a.lam / lt;
    float ss = 0.f;
#pragma unroll
    for (int d = 0; d < NDB; ++d)
#pragma unroll
      for (int i4 = 0; i4 < 4; ++i4) {
        const u32x2 t = *(const u32x2*)(smem + A_S0 + qloc * 264 + (32 * d + 8 * i4 + 4 * g) * 2);
        const float o0[4] = {bflo(t[0]), bfhi(t[0]), bflo(t[1]), bfhi(t[1])};
#pragma unroll
        for (int e = 0; e < 4; ++e) { const float o = o0[e] - O[d][4 * i4 + e] * inv; O[d][4 * i4 + e] = o; ss += o * o; }
      }
    ss = x32_sum(ss);
    const float rstd = rsqrtf(ss * (1.f / DV) + EPSV) * a.omli;
#pragma unroll
    for (int d = 0; d < NDB; ++d)
#pragma unroll
      for (int i4 = 0; i4 < 4; ++i4) {
        const f32x4 wv = *(const f32x4*)(a.nw + 32 * d + 8 * i4 + 4 * g);
#pragma unroll
        for (int e = 0; e < 4; ++e) O[d][4 * i4 + e] *= rstd * wv[e];
      }
  } else {
    float sm = 0.f;
#pragma unroll
    for (int d = 0; d < NDB; ++d)
#pragma unroll
      for (int i = 0; i < 16; ++i) sm += O[d][i];
    sm = x32_sum(sm);
    const float mu = sm * (1.f / DV);
    float ss = 0.f;
#pragma unroll
    for (int d = 0; d < NDB; ++d)
#pragma unroll
      for (int i = 0; i < 16; ++i) { const float o = O[d][i] - mu; O[d][i] = o; ss += o * o; }
    ss = x32_sum(ss);
    const float rstd = rsqrtf(ss * (1.f / DV) + EPSV);
#pragma unroll
    for (int d = 0; d < NDB; ++d)
#pragma unroll
      for (int i4 = 0; i4 < 4; ++i4) {
        const int dv0 = 32 * d + 8 * i4 + 4 * g;
        const f32x4 wv = *(const f32x4*)(a.nw + dv0);
        const u32x2 gq = *(const u32x2*)(a.rg + (size_t)qloc * a.rg_ld + dv0);
        const float gg[4] = {bflo(gq[0]), bfhi(gq[0]), bflo(gq[1]), bfhi(gq[1])};
#pragma unroll
        for (int e = 0; e < 4; ++e) O[d][4 * i4 + e] *= rstd * wv[e] * (gg[e] * sigmoidf_(gg[e]));
      }
  }
#pragma unroll
  for (int d = 0; d < NDB; ++d)
#pragma unroll
    for (int i4 = 0; i4 < 4; ++i4) {
      u32x2 t = {pack2(O[d][4 * i4], O[d][4 * i4 + 1]), pack2(O[d][4 * i4 + 2], O[d][4 * i4 + 3])};
      *(u32x2*)(a.y + (size_t)qloc * a.y_ld + 32 * d + 8 * i4 + 4 * g) = t;
    }
}

DI void ret_state_job(char* smem, const bf16_t* kp, const bf16_t* vp, int ld, float lg, int dir, float* outp) {
  float* kw = (float*)smem;
  const int tid = ltid();
  __syncthreads();
  for (int idx = tid; idx < 256 * 8; idx += NTHR) {
    const int j = idx >> 3, c = idx & 7;
    const u32x4 t = *(const u32x4*)(kp + (size_t)j * ld + 8 * c);
    const float wj = exp2f((float)(dir ? j : 255 - j) * lg) * 0.125f;
#pragma unroll
    for (int e = 0; e < 4; ++e) { kw[j * 64 + 8 * c + 2 * e] = bflo(t[e]) * wj; kw[j * 64 + 8 * c + 2 * e + 1] = bfhi(t[e]) * wj; }
  }
  __syncthreads();
  const int dv = tid & 127, dkh = tid >> 7;
  float acc[32];
#pragma unroll
  for (int e = 0; e < 32; ++e) acc[e] = 0.f;
#pragma unroll 2
  for (int j = 0; j < 256; ++j) {
    const float vj = bf2f(vp[(size_t)j * ld + dv]);
#pragma unroll
    for (int e4 = 0; e4 < 8; ++e4) {
      const f32x4 kk = *(const f32x4*)(kw + j * 64 + 32 * dkh + 4 * e4);
#pragma unroll
      for (int e = 0; e < 4; ++e) acc[4 * e4 + e] += kk[e] * vj;
    }
  }
#pragma unroll
  for (int e = 0; e < 32; ++e) outp[(32 * dkh + e) * 128 + dv] = acc[e];
}

DI float log2_sigmoid(float x) { return -log1pf(__expf(-x)) * LOG2E; }

#ifndef AM
#define AM 0xFFu
#endif
#define AEN(k) ((AM >> (k)) & 1u)
DI void attention_phase(KP& p, int l, char* smem) {
  char* ws = p.ws;
  bf16_t* pq = (bf16_t*)(ws + OFF_PQ);
  bf16_t* Y = (bf16_t*)(ws + OFF_Y);
  const float lam_init = 0.8f - 0.6f * expf(-0.3f * (float)l);
  float lam;
  {
    const float* lp = p.diff_lambda + l * 256;
    float s1 = 0.f, s2 = 0.f;
    for (int i = 0; i < 64; ++i) { s1 += lp[i] * lp[64 + i]; s2 += lp[128 + i] * lp[192 + i]; }
    lam = expf(s1) - expf(s2) + lam_init;
  }
  const int G = VG();
  auto init = [&](AttnArgs& a) {
    a.R0 = 0; a.bias = nullptr; a.t0 = 0; a.T = 0; a.lgf = 0.f; a.lgb = 0.f; a.s0f = nullptr; a.s0b = nullptr; a.rg = nullptr; a.rg_ld = 0; a.nw = nullptr;
    a.lam = lam; a.omli = 1.f - lam_init; a.q_ld = PQW; a.y_ld = DM;
  };
  int rot = 0;
  auto first = [&](int n) { int f = VB() - rot; if (f < 0) f += G; rot = (rot + n) % G; return f; };
  if (AEN(3)) for (int it = first(512); it < 512; it += G) {
    AttnArgs a; init(a);
    const int b = it >> 6, h = (it >> 4) & 3, qb = it & 15;
    const size_t row = NCTX + (size_t)b * 2048 + qb * 128;
    a.q = pq + row * PQW + 768 + h * 128; a.k = (bf16_t*)(ws + OFF_KDL) + (size_t)b * SLAT * 512 + h * 128; a.k_ld = 512;
    a.v = (bf16_t*)(ws + OFF_VDL) + (size_t)b * SLAT * 512 + h * 128; a.v_ld = 512; a.n_keys = SLAT; a.sl2 = 0.125f * LOG2E;
    a.y = Y + row * DM + 512 + h * 128; a.nw = p.diff_norm + l * 512 + h * 128;
    attn_block<64, 128, 3>(smem, a);
  }
  if (AEN(0)) for (int i = first(1024); i < 1024; i += G) {
    AttnArgs a; init(a);
    const int b = i >> 7, h = (i >> 4) & 7, qb = i & 15;
    const size_t row = NCTX + (size_t)b * 2048 + qb * 128;
    a.q = pq + row * PQW + h * 96; a.k = (bf16_t*)(ws + OFF_KML) + (size_t)b * SLAT * 768 + h * 96; a.k_ld = 768;
    a.v = (bf16_t*)(ws + OFF_VML) + (size_t)b * SLAT * 512 + h * 64; a.v_ld = 512; a.n_keys = SLAT; a.sl2 = 0.10206207261596577f * LOG2E;
    a.y = Y + row * DM + h * 64;
    attn_block<96, 64, 0>(smem, a);
  }
  if (AEN(2)) for (int i = first(512); i < 512; i += G) {
    AttnArgs a; init(a);
    const int b = i >> 6, h = (i >> 4) & 3, qb = i & 15;
    const size_t row0 = NCTX + (size_t)b * 2048, row = row0 + qb * 128;
    a.q = pq + row * PQW + 1792 + h * 64; a.k = pq + row0 * PQW + 2048 + h * 64; a.k_ld = PQW; a.v = pq + row0 * PQW + 2304 + h * 128; a.v_ld = PQW;
    a.n_keys = 2048; a.sl2 = 0.125f; a.y = Y + row * DM + 1536 + h * 128; a.t0 = qb * 128; a.T = 2048;
    a.lgf = log2_sigmoid(p.ret_decay[l * 8 + h]); a.lgb = log2_sigmoid(p.ret_decay[l * 8 + 4 + h]);
    a.s0f = p.st_ret + ((size_t)((b * 2 + l) * 2 + 0) * 4 + h) * 8192; a.s0b = p.st_ret + ((size_t)((b * 2 + l) * 2 + 1) * 4 + h) * 8192;
    a.rg = pq + row * PQW + 2816 + h * 128; a.rg_ld = PQW; a.nw = p.ret_norm + l * 512 + h * 128;
    attn_block<64, 128, 2>(smem, a);
  }
  if (AEN(1)) for (int i = first(1024); i < 1024; i += G) {
    AttnArgs a; init(a);
    const int b = i >> 7, h = (i >> 4) & 7, qb = i & 15;
    const size_t row = NCTX + (size_t)b * 2048 + qb * 128;
    a.q = pq + row * PQW + 1280 + h * 64; a.k = (bf16_t*)(ws + OFF_KNL) + (size_t)b * SLAT * 512 + h * 64; a.k_ld = 512;
    a.v = (bf16_t*)(ws + OFF_VNL) + (size_t)b * SLAT * 512 + h * 64; a.v_ld = 512; a.n_keys = SLAT; a.sl2 = 0.125f * LOG2E;
    a.y = Y + row * DM + 1024 + h * 64; a.R0 = 2 * qb; a.bias = p.na_bias + (size_t)(l * 8 + h) * 465;
    attn_block<64, 64, 1>(smem, a);
  }
  if (AEN(3)) for (int i = first(256); i < 256; i += G) {
    AttnArgs a; init(a);
    const int b = i >> 3, h = (i >> 1) & 3, qb = i & 1;
    const size_t row0 = (size_t)b * 256, row = row0 + qb * 128;
    a.q = pq + row * PQW + 768 + h * 128; a.k = (bf16_t*)(ws + OFF_KDC) + row0 * 512 + h * 128; a.k_ld = 512;
    a.v = (bf16_t*)(ws + OFF_VDC) + row0 * 512 + h * 128; a.v_ld = 512; a.n_keys = 256; a.sl2 = 0.125f * LOG2E;
    a.y = Y + row * DM + 512 + h * 128; a.nw = p.diff_norm + l * 512 + h * 128;
    attn_block<64, 128, 3>(smem, a);
  }
  if (AEN(0)) for (int i = first(512); i < 512; i += G) {
    AttnArgs a; init(a);
    const int b = i >> 4, h = (i >> 1) & 7, qb = i & 1;
    const size_t row0 = (size_t)b * 256, row = row0 + qb * 128;
    a.q = pq + row * PQW + h * 96; a.k = (bf16_t*)(ws + OFF_KMC) + row0 * 768 + h * 96; a.k_ld = 768;
    a.v = (bf16_t*)(ws + OFF_VMC) + row0 * 512 + h * 64; a.v_ld = 512; a.n_keys = 256; a.sl2 = 0.10206207261596577f * LOG2E;
    a.y = Y + row * DM + h * 64;
    attn_block<96, 64, 0>(smem, a);
  }
  if (AEN(4)) for (int i = first(512); i < 512; i += G) {
    AttnArgs a; init(a);
    const int b = i >> 4, h = (i >> 1) & 7, qb = i & 1;
    const size_t row0 = (size_t)b * 256, row = row0 + qb * 128;
    a.q = pq + row * PQW + 1280 + h * 64; a.k = (bf16_t*)(ws + OFF_KNC) + row0 * 512 + h * 64; a.k_ld = 512;
    a.v = (bf16_t*)(ws + OFF_VNC) + row0 * 512 + h * 64; a.v_ld = 512; a.n_keys = 256; a.sl2 = 0.125f * LOG2E;
    a.y = Y + row * DM + 1024 + h * 64;
    attn_block<64, 64, 0>(smem, a);
  }
  if (AEN(2)) for (int i = first(256); i < 256; i += G) {
    AttnArgs a; init(a);
    const int b = i >> 3, h = (i >> 1) & 3, qb = i & 1;
    const size_t row0 = (size_t)b * 256, row = row0 + qb * 128;
    a.q = pq + row * PQW + 1792 + h * 64; a.k = pq + row0 * PQW + 2048 + h * 64; a.k_ld = PQW; a.v = pq + row0 * PQW + 2304 + h * 128; a.v_ld = PQW;
    a.n_keys = 256; a.sl2 = 0.125f; a.y = Y + row * DM + 1536 + h * 128; a.t0 = qb * 128; a.T = 256;
    a.lgf = log2_sigmoid(p.ret_decay[l * 8 + h]); a.lgb = log2_sigmoid(p.ret_decay[l * 8 + 4 + h]);
    a.rg = pq + row * PQW + 2816 + h * 128; a.rg_ld = PQW; a.nw = p.ret_norm + l * 512 + h * 128;
    attn_block<64, 128, 2>(smem, a);
  }
  if (AEN(5)) for (int i = first(256); i < 256; i += G) {
    const int b = i >> 3, h = (i >> 1) & 3, dir = i & 1;
    const size_t row0 = (size_t)b * 256;
    const float lg = log2_sigmoid(p.ret_decay[l * 8 + dir * 4 + h]);
    ret_state_job(smem, pq + row0 * PQW + 2048 + h * 64, pq + row0 * PQW + 2304 + h * 128, PQW, lg, dir,
                  p.out + OO_RET + ((size_t)((b * 2 + l) * 2 + dir) * 4 + h) * 8192);
  }
}

DI void convT_unit(char* smem, const float* src, int ld, int srccol, int k0, bf16_t* dst  , int K) {
  float* T = (float*)smem;
  const int tid = ltid();
  __syncthreads();
  {
    const int n4 = tid & 7, kr = tid >> 3;
#pragma unroll
    for (int i = 0; i < 8; ++i) {
      const int k = kr + 32 * i;
      f32x4 v = {0.f, 0.f, 0.f, 0.f};
      if (srccol >= 0) v = *(const f32x4*)(src + (size_t)(k0 + k) * ld + srccol + 4 * n4);
      T[k * 33 + 4 * n4] = v[0]; T[k * 33 + 4 * n4 + 1] = v[1]; T[k * 33 + 4 * n4 + 2] = v[2]; T[k * 33 + 4 * n4 + 3] = v[3];
    }
  }
  __syncthreads();
  {
    const int k2 = tid & 127, nh = tid >> 7;
#pragma unroll
    for (int i = 0; i < 16; ++i) {
      const int n = nh + 2 * i;
      *(unsigned*)(dst + (size_t)n * K + 2 * k2) = pack2(T[(2 * k2) * 33 + n], T[(2 * k2 + 1) * 33 + n]);
    }
  }
}

DI void prep_phase(KP& p, char* smem) {
  constexpr int NADA = 2 * 16 * 12;
  constexpr int U_IN = 440 * 8, U_BR = 512, U_O = 512, U_UP = 352 * 8, U_DN = 64 * 22, U_UKV = 32, U_L = U_IN + U_BR + U_O + U_UP + U_DN + U_UKV;
  const int tid = ltid();
  const int n_units = NADA + 2 * U_L, trips = (n_units + VG() - 1) / VG();
  for (int tr = 0; tr < trips; ++tr) {
    const int u = VB() + tr * VG();
    if (u >= n_units) { __syncthreads(); __syncthreads(); continue; }
    if (u < NADA) {
      const int l = u / 192, kc = (u % 192) / 12, nc = u % 12;
      float* cs = (float*)smem;
      __syncthreads();
      for (int i = tid; i < 9 * 128; i += NTHR) {
        const int g = i >> 7, k = kc * 128 + (i & 127);
        const float cv = g == 0 ? p.c_ctx[k] : p.c[(g - 1) * DM + k];
        cs[i] = cv * sigmoidf_(cv);
      }
      __syncthreads();
      f32x4 acc[9];
#pragma unroll
      for (int g = 0; g < 9; ++g) acc[g] = (f32x4){0.f, 0.f, 0.f, 0.f};
      const float* wp = p.w_ada + ((size_t)l * DM + kc * 128) * 12288 + nc * 1024 + 4 * tid;
#pragma unroll 4
      for (int k = 0; k < 128; ++k) {
        const f32x4 wv = *(const f32x4*)(wp + (size_t)k * 12288);
#pragma unroll
        for (int g = 0; g < 9; ++g) { const float s = cs[g * 128 + k]; acc[g] += wv * s; }
      }
      float* pp = (float*)(p.ws + OFF_MODP) + ((size_t)(kc * 2 + l) * 9) * 12288 + nc * 1024 + 4 * tid;
#pragma unroll
      for (int g = 0; g < 9; ++g) *(f32x4*)(pp + (size_t)g * 12288) = acc[g];
    } else {
      const int uu = u - NADA, l = uu / U_L;
      int r = uu % U_L;
      char* wl = p.ws + l * SZ_WL;
      if (r < U_IN) {
        const int cn = r >> 3, kt = r & 7, n = cn * 32;
        int sc;
        if (n < 1024) sc = n; else if (n < 5632) sc = n + 32; else if (n < 5664) sc = n - 5632 + 1024; else if (n < NPROJ) sc = -1; else sc = n - 224;
        convT_unit(smem, p.w_in + (size_t)l * DM * 13856, 13856, sc, kt * 256, (bf16_t*)(wl + WO_IN) + (size_t)n * 2048 + kt * 256, 2048);
      } else if ((r -= U_IN) < U_BR) {
        const int cn = r >> 1, kt = r & 1, i = cn >> 6, n = (cn & 63) * 32;
        convT_unit(smem, p.w_branch + ((size_t)(l * 4 + i) * 512) * 2048, 2048, n, kt * 256, (bf16_t*)(wl + WO_BR) + ((size_t)i * 2048 + n) * 512 + kt * 256, 512);
      } else if ((r -= U_BR) < U_O) {
        const int cn = r >> 3, kt = r & 7, n = cn * 32;
        convT_unit(smem, p.w_o + (size_t)l * DM * DM, 2048, n, kt * 256, (bf16_t*)(wl + WO_O) + (size_t)n * 2048 + kt * 256, 2048);
      } else if ((r -= U_O) < U_UP) {
        const int cn = r >> 3, kt = r & 7, n = cn * 32, J = n >> 7, w = n & 127, chn = 64 * J + (w & 63), sc = (w < 64) ? chn : FF + chn;
        convT_unit(smem, p.w_up + (size_t)l * DM * 11264, 11264, sc, kt * 256, (bf16_t*)(wl + WO_UP) + (size_t)n * 2048 + kt * 256, 2048);
      } else if ((r -= U_UP) < U_DN) {
        const int cn = r / 22, kt = r % 22, n = cn * 32;
        convT_unit(smem, p.w_down + (size_t)l * FF * DM, 2048, n, kt * 256, (bf16_t*)(wl + WO_DN) + (size_t)n * FF + kt * 256, FF);
      } else {
        r -= U_DN;
        const int n = r * 32;
        convT_unit(smem, p.w_ukv + (size_t)l * 256 * 1024, 1024, n, 0, (bf16_t*)(wl + WO_UKV) + (size_t)n * 256, 256);
      }
    }
  }
}

DI void ada_reduce_phase(KP& p) {
  const float* pp = (const float*)(p.ws + OFF_MODP);
  float* mod = (float*)(p.ws + OFF_MOD);
  constexpr int NE = 2 * 9 * 12288;
  for (int e = VB() * NTHR + ltid(); e < NE; e += VG() * NTHR) {
    const int l = e / (9 * 12288), n = e % 12288;
    float s = p.b_ada[l * 12288 + n];
    for (int kc = 0; kc < 16; ++kc) s += pp[(size_t)kc * NE + e];
    mod[e] = s;
  }
}

DI void modulate_phase(KP& p, int l, int which  , bool x_from_input) {
  const int vt_ = ltid(), lane = vt_ & 63, wv = vt_ >> 6;
  const float* gvec = (which ? p.g_ffn : p.g_attn) + l * DM;
  const float* mod = (const float*)(p.ws + OFF_MOD) + (size_t)l * 9 * 12288;
  bf16_t* h = (bf16_t*)(p.ws + OFF_H);
  const int nwv = VG() * 4, per = (NTOK + nwv - 1) / nwv, r0 = (VB() * 4 + wv) * per, r1 = min(r0 + per, NTOK);
  f32x4 av[8], bv[8], xn[8];
  int curg = -1;
  auto ldrow = [&](int r) {
    const float* xr = x_from_input ? xrow_in(p, r) : p.out + (size_t)r * DM;
#pragma unroll
    for (int i = 0; i < 8; ++i) xn[i] = *(const f32x4*)(xr + 4 * (lane + 64 * i));
  };
  if (r0 < r1) ldrow(r0);
  for (int r = r0; r < r1; ++r) {
    f32x4 xv[8];
    float ss = 0.f;
#pragma unroll
    for (int i = 0; i < 8; ++i) { xv[i] = xn[i]; ss += xv[i][0] * xv[i][0] + xv[i][1] * xv[i][1] + xv[i][2] * xv[i][2] + xv[i][3] * xv[i][3]; }
    if (r + 1 < r1) ldrow(r + 1);
    const int g = grp_of(r);
    if (g != curg) {
      curg = g;
      const float* sh = mod + (size_t)g * 12288 + (which ? 3 : 0) * DM;
      const float* sc = sh + DM;
#pragma unroll
      for (int i = 0; i < 8; ++i) {
        const int c = 4 * (lane + 64 * i);
        const f32x4 gv = *(const f32x4*)(gvec + c), sv = *(const f32x4*)(sc + c);
        bv[i] = *(const f32x4*)(sh + c);
#pragma unroll
        for (int e = 0; e < 4; ++e) av[i][e] = gv[e] * (1.f + sv[e]);
      }
    }
    ss = wave_sum(ss);
    const float rstd = rsqrtf(ss * (1.f / DM) + EPSV);
#pragma unroll
    for (int i = 0; i < 8; ++i) {
      const int c = 4 * (lane + 64 * i);
      float o[4];
#pragma unroll
      for (int e = 0; e < 4; ++e) o[e] = xv[i][e] * rstd * av[i][e] + bv[i][e];
      u32x2 t = {pack2(o[0], o[1]), pack2(o[2], o[3])};
      *(u32x2*)(h + (size_t)r * DM + c) = t;
    }
  }
}

DI void cache_prep(KP& p, int l) {
  char* ws = p.ws;
  const int total = 4096 * 292;
  for (int u = VB() * NTHR + ltid(); u < total; u += VG() * NTHR) {
    const int cr = u / 292, w = u % 292, b = cr >> 9, j = cr & 511;
    const size_t srow = (size_t)(b * 2 + l) * 512 + j;
    const size_t drow = (size_t)b * SLAT + 2048 + j;
    const float* src; bf16_t* dst; bool rep = false;
    if (w < 32) { src = p.c_ckv + srow * 256 + 8 * w; dst = (bf16_t*)(ws + OFF_CKVA) + ((size_t)NTOK + cr) * 256 + 8 * w; }
    else if (w < 36) { src = p.c_kr + srow * 32 + 8 * (w - 32); dst = (bf16_t*)(ws + OFF_KML) + drow * 768 + 64 + 8 * (w - 32); rep = true; }
    else {
      const int ww = w - 36, which = ww >> 6, c = 8 * (ww & 63);
      const float* sb = which == 0 ? p.c_dk : which == 1 ? p.c_dv : which == 2 ? p.c_nk : p.c_nv;
      const size_t off = which == 0 ? OFF_KDL : which == 1 ? OFF_VDL : which == 2 ? OFF_KNL : OFF_VNL;
      src = sb + srow * 512 + c; dst = (bf16_t*)(ws + off) + drow * 512 + c;
    }
    const f32x4 a = *(const f32x4*)src, bq = *(const f32x4*)(src + 4);
    u32x4 t = {pack2(a[0], a[1]), pack2(a[2], a[3]), pack2(bq[0], bq[1]), pack2(bq[2], bq[3])};
    if (rep) { for (int h = 0; h < 8; ++h) *(u32x4*)(dst + h * 96) = t; }
    else *(u32x4*)dst = t;
  }
}

DI void ckv_phase(KP& p, int l) {
  const int vt_ = ltid(), lane = vt_ & 63, wv = vt_ >> 6;
  const float* mck = (const float*)(p.ws + OFF_MCKV);
  bf16_t* ca = (bf16_t*)(p.ws + OFF_CKVA);
  const f32x4 wn = *(const f32x4*)(p.kv_norm + l * 256 + 4 * lane);
  for (int r = VB() * 4 + wv; r < NTOK; r += VG() * 4) {
    const f32x4 v = *(const f32x4*)(mck + (size_t)r * 256 + 4 * lane);
    float ss = wave_sum(v[0] * v[0] + v[1] * v[1] + v[2] * v[2] + v[3] * v[3]);
    const float rstd = rsqrtf(ss * (1.f / 256.f) + EPSV);
    f32x4 o = {v[0] * rstd * wn[0], v[1] * rstd * wn[1], v[2] * rstd * wn[2], v[3] * rstd * wn[3]};
    u32x2 t = {pack2(o[0], o[1]), pack2(o[2], o[3])};
    *(u32x2*)(ca + (size_t)r * 256 + 4 * lane) = t;
    if (r < NCTX) { const int b = r >> 8, tt = r & 255; *(f32x4*)(p.out + OO_CKV + ((size_t)((b * 2 + l) * 256 + tt)) * 256 + 4 * lane) = o; }
  }
}

DI void merge_phase(KP& p, int l, char* smem) {
  char* wl = p.ws + l * SZ_WL;
  const bf16_t* h = (const bf16_t*)(p.ws + OFF_H);
  const bf16_t* Y = (const bf16_t*)(p.ws + OFF_Y);
  const bf16_t* wg = (const bf16_t*)(wl + WO_IN) + (size_t)NPROJ * 2048;
  const bf16_t* wb = (const bf16_t*)(wl + WO_BR);
  StoreBf16Epi epi{(bf16_t*)(p.ws + OFF_M), DM, 0};
  constexpr int nM = 96, nN = 16;
  for (int it = 0;; ++it) {
    int pm, pn;
    if (!tile_map(rtile_slot(it), nM, nN, 8, pm, pn)) break;
    f32x4 tot[8][2];
#pragma unroll
    for (int mi = 0; mi < 8; ++mi)
#pragma unroll
      for (int ni = 0; ni < 2; ++ni) tot[mi][ni] = (f32x4){0.f, 0.f, 0.f, 0.f};
 u32x4 ra[4], rb[2];
#pragma unroll 1
    for (int i = 0; i < 4; ++i) {
      const bf16_t* Ag = h + (size_t)pm * 256 * DM; const bf16_t* Bg = wg + ((size_t)i * 2048 + pn * 128) * 2048;
      const bf16_t* Ab = Y + (size_t)pm * 256 * DM + 512 * i; const bf16_t* Bb = wb + ((size_t)i * 2048 + pn * 128) * 512;
      const bf16_t* Bg2 = wg + ((size_t)(i < 3 ? i + 1 : i) * 2048 + pn * 128) * 2048;
      unsigned gp[4][2][2];
      char* park = smem + 114688 + rtid() * 64;
      {
        f32x4 ga[8][2];
#pragma unroll
        for (int mi = 0; mi < 8; ++mi)
#pragma unroll
          for (int ni = 0; ni < 2; ++ni) ga[mi][ni] = (f32x4){0.f, 0.f, 0.f, 0.f};
        gemm256_kloop<2>(ga, ra, rb, Ag, DM, Bg, 2048, 2048, Ab, DM, Bb, 512, i > 0, smem);
#pragma unroll
        for (int mi = 0; mi < 8; ++mi)
#pragma unroll
          for (int ni = 0; ni < 2; ++ni) {
            const unsigned g0 = pack2(sigmoidf_(ga[mi][ni][0]), sigmoidf_(ga[mi][ni][1]));
            const unsigned g1 = pack2(sigmoidf_(ga[mi][ni][2]), sigmoidf_(ga[mi][ni][3]));
            if (mi < 4) { u32x2 t = {g0, g1}; *(u32x2*)(park + (mi * 2 + ni) * 8) = t; }
            else { gp[mi - 4][ni][0] = g0; gp[mi - 4][ni][1] = g1; }
          }
      }
      f32x4 ba[8][2];
#pragma unroll
      for (int mi = 0; mi < 8; ++mi)
#pragma unroll
        for (int ni = 0; ni < 2; ++ni) ba[mi][ni] = (f32x4){0.f, 0.f, 0.f, 0.f};
      gemm256_kloop<2>(ba, ra, rb, Ab, DM, Bb, 512, 512, Ag, DM, Bg2, 2048, true, smem);
#pragma unroll
      for (int mi = 0; mi < 8; ++mi)
#pragma unroll
        for (int ni = 0; ni < 2; ++ni) {
          unsigned g0, g1;
          if (mi < 4) { const u32x2 t = *(const u32x2*)(park + (mi * 2 + ni) * 8); g0 = t[0]; g1 = t[1]; }
          else { g0 = gp[mi - 4][ni][0]; g1 = gp[mi - 4][ni][1]; }
          tot[mi][ni][0] += bflo(g0) * ba[mi][ni][0]; tot[mi][ni][1] += bfhi(g0) * ba[mi][ni][1];
          tot[mi][ni][2] += bflo(g1) * ba[mi][ni][2]; tot[mi][ni][3] += bfhi(g1) * ba[mi][ni][3];
        }
    }
    gemm256_epilogue<2>(tot, smem, pm * 256, pn * 128, epi);
  }
}

struct ConvW { float wa[3][8], wb[3][8], ba[8], bb[8]; };
DI void load_convw(ConvW& c, const float* cw, const float* cb, int chn) {
#pragma unroll
  for (int j = 0; j < 3; ++j)
#pragma unroll
    for (int e4 = 0; e4 < 2; ++e4) {
      const f32x4 x = *(const f32x4*)(cw + j * 11264 + chn + 4 * e4), y = *(const f32x4*)(cw + j * 11264 + FF + chn + 4 * e4);
#pragma unroll
      for (int e = 0; e < 4; ++e) { c.wa[j][4 * e4 + e] = x[e]; c.wb[j][4 * e4 + e] = y[e]; }
    }
#pragma unroll
  for (int e4 = 0; e4 < 2; ++e4) {
    const f32x4 x = *(const f32x4*)(cb + chn + 4 * e4), y = *(const f32x4*)(cb + FF + chn + 4 * e4);
#pragma unroll
    for (int e = 0; e < 4; ++e) { c.ba[4 * e4 + e] = x[e]; c.bb[4 * e4 + e] = y[e]; }
  }
}
DI void unpack8(const u32x4& v, float (&x)[8]) {
#pragma unroll
  for (int e = 0; e < 4; ++e) { x[2 * e] = bflo(v[e]); x[2 * e + 1] = bfhi(v[e]); }
}
DI u32x4 conv_out(const ConvW& c, const float (&pa)[8], const float (&pb)[8], const float (&ca)[8], const float (&cb_)[8],
                  const float (&na)[8], const float (&nb)[8]) {
  u32x4 o;
#pragma unroll
  for (int e = 0; e < 4; ++e) {
    float s[2];
#pragma unroll
    for (int q = 0; q < 2; ++q) {
      const int k = 2 * e + q;
      const float sa = c.ba[k] + c.wa[0][k] * pa[k] + c.wa[1][k] * ca[k] + c.wa[2][k] * na[k];
      const float sb = c.bb[k] + c.wb[0][k] * pb[k] + c.wb[1][k] * cb_[k] + c.wb[2][k] * nb[k];
      s[q] = sa * sigmoidf_(sa) * sb;
    }
    o[e] = pack2(s[0], s[1]);
  }
  return o;
}

constexpr size_t OFF_HALO = OFF_ACT + SZ_ACT;
static_assert(OFF_HALO + (size_t)96 * 4 * 11264 * 2 <= OFF_KVEND, "halo alias");

DI void up_phase(KP& p, int l, char* smem) {
  char* wl = p.ws + l * SZ_WL;
  const bf16_t* h = (const bf16_t*)(p.ws + OFF_H);
  const bf16_t* W = (const bf16_t*)(wl + WO_UP);
  bf16_t* act = (bf16_t*)(p.ws + OFF_ACT);
  bf16_t* halo = (bf16_t*)(p.ws + OFF_HALO);
  const float* cw = p.conv_w + (size_t)l * 3 * 11264;
  const float* cb = p.conv_b + (size_t)l * 11264;
  constexpr int CSB = 528;
  for (int it = 0;; ++it) {
    int pm, pn;
    if (!tile_map(rtile_slot(it), 96, 44, 8, pm, pn)) break;
    {
      f32x4 acc[8][4];
#pragma unroll
      for (int mi = 0; mi < 8; ++mi)
#pragma unroll
        for (int ni = 0; ni < 4; ++ni) acc[mi][ni] = (f32x4){0.f, 0.f, 0.f, 0.f};
      u32x4 ra[4], rb[4];
      const bf16_t* At = h + (size_t)pm * 256 * DM; const bf16_t* Bt = W + (size_t)pn * 256 * 2048;
      gemm256_kloop<4>(acc, ra, rb, At, DM, Bt, 2048, 2048, At, DM, Bt, 2048, false, smem);
      const int tid = rtid(), wid = tid >> 6, lane = tid & 63, wr = wid >> 2, wc = wid & 3, fr = lane & 15, fq = lane >> 4;
#pragma unroll
      for (int mi = 0; mi < 8; ++mi)
#pragma unroll
        for (int ni = 0; ni < 4; ++ni) {
          u32x2 t = {pack2(acc[mi][ni][0], acc[mi][ni][1]), pack2(acc[mi][ni][2], acc[mi][ni][3])};
          *(u32x2*)(smem + (128 * wr + 16 * mi + fr) * CSB + (64 * wc + 16 * ni + 4 * fq) * 2) = t;
        }
    }
    __syncthreads();
    const int tid = rtid();
    const bool top_edge = (pm < 32) || (((pm - 32) & 7) == 0), bot_edge = (pm < 32) || (((pm - 32) & 7) == 7);
    if (tid < 128) {
      const int hr = tid >> 5, c16 = tid & 31, row = hr < 2 ? hr : 252 + hr;
      *(u32x4*)(halo + ((size_t)(pm * 4 + hr)) * 11264 + pn * 256 + c16 * 8) = *(const u32x4*)(smem + row * CSB + c16 * 16);
    }
    {
      const int cu = tid & 15, rb = tid >> 4, g2 = cu >> 3, c8 = (cu & 7) * 8;
      const int chn = 64 * (2 * pn + g2) + c8;
      ConvW c; load_convw(c, cw, cb, chn);
      const char* col = smem + (128 * g2 + c8) * 2;
      float pa[8], pb[8], ca[8], cb_[8], na[8], nb[8];
      auto ldrow = [&](int r, float (&xa)[8], float (&xb)[8]) {
        if (r < 0 || r > 255) {
#pragma unroll
          for (int e = 0; e < 8; ++e) { xa[e] = 0.f; xb[e] = 0.f; }
        } else {
          unpack8(*(const u32x4*)(col + r * CSB), xa);
          unpack8(*(const u32x4*)(col + r * CSB + 128), xb);
        }
      };
      const int r0 = rb * 8;
      ldrow(r0 - 1, pa, pb);
      ldrow(r0, ca, cb_);
#pragma unroll
      for (int i = 0; i < 8; ++i) {
        const int r = r0 + i;
        ldrow(r + 1, na, nb);
        const bool defer = (r == 0 && !top_edge) || (r == 255 && !bot_edge);
        if (!defer) *(u32x4*)(act + ((size_t)pm * 256 + r) * FF + chn) = conv_out(c, pa, pb, ca, cb_, na, nb);
#pragma unroll
        for (int e = 0; e < 8; ++e) { pa[e] = ca[e]; pb[e] = cb_[e]; ca[e] = na[e]; cb_[e] = nb[e]; }
      }
    }
    __syncthreads();
  }
}

DI void fixup_phase(KP& p, int l) {
  const bf16_t* halo = (const bf16_t*)(p.ws + OFF_HALO);
  bf16_t* act = (bf16_t*)(p.ws + OFF_ACT);
  const float* cw = p.conv_w + (size_t)l * 3 * 11264;
  const float* cb = p.conv_b + (size_t)l * 11264;
  const int total = 56 * 2 * 704;
  for (int u = VB() * NTHR + ltid(); u < total; u += VG() * NTHR) {
    const int cu = u % 704, br = u / 704, which = br & 1, bd = br >> 1, seq = bd / 7, ti = bd % 7;
    const int pm = 32 + seq * 8 + ti;
    const int chn = cu * 8, g = chn >> 6, c = chn & 63;
    ConvW cwv; load_convw(cwv, cw, cb, chn);
    const bf16_t* rp = halo + ((size_t)(pm * 4 + (which ? 3 : 2))) * 11264 + 128 * g + c;
    const bf16_t* rc = halo + ((size_t)(which ? (pm + 1) * 4 + 0 : pm * 4 + 3)) * 11264 + 128 * g + c;
    const bf16_t* rn = halo + ((size_t)((pm + 1) * 4 + (which ? 1 : 0))) * 11264 + 128 * g + c;
    float pa[8], pb[8], ca[8], cb_[8], na[8], nb[8];
    unpack8(*(const u32x4*)rp, pa); unpack8(*(const u32x4*)(rp + 64), pb);
    unpack8(*(const u32x4*)rc, ca); unpack8(*(const u32x4*)(rc + 64), cb_);
    unpack8(*(const u32x4*)rn, na); unpack8(*(const u32x4*)(rn + 64), nb);
    const size_t row = which ? (size_t)(pm + 1) * 256 : (size_t)pm * 256 + 255;
    *(u32x4*)(act + row * FF + chn) = conv_out(cwv, pa, pb, ca, cb_, na, nb);
  }
}

DI void conv_phase(KP& p, int l, int g0, int ng) {
  const bf16_t* U = (const bf16_t*)(p.ws + OFF_U);
  bf16_t* act = (bf16_t*)(p.ws + OFF_ACT);
  const float* cw = p.conv_w + (size_t)l * 3 * 11264;
  const float* cb = p.conv_b + (size_t)l * 11264;
  const int upr = ng * 8, uw = ng * 128;
  const int total = (NTOK / 8) * upr;
  for (int u = VB() * NTHR + ltid(); u < total; u += VG() * NTHR) {
    const int rb = u / upr, w = u % upr, J = w >> 3, c8 = (w & 7) * 8;
    const int chn = 64 * (g0 + J) + c8, r0 = rb * 8;
    int t0, T;
    if (r0 < NCTX) { t0 = r0 & 255; T = 256; } else { t0 = (r0 - NCTX) & 2047; T = 2048; }
    float wa[3][8], wb[3][8], ba[8], bb[8];
#pragma unroll
    for (int j = 0; j < 3; ++j)
#pragma unroll
      for (int e4 = 0; e4 < 2; ++e4) {
        const f32x4 x = *(const f32x4*)(cw + j * 11264 + chn + 4 * e4), y = *(const f32x4*)(cw + j * 11264 + FF + chn + 4 * e4);
#pragma unroll
        for (int e = 0; e < 4; ++e) { wa[j][4 * e4 + e] = x[e]; wb[j][4 * e4 + e] = y[e]; }
      }
#pragma unroll
    for (int e4 = 0; e4 < 2; ++e4) {
      const f32x4 x = *(const f32x4*)(cb + chn + 4 * e4), y = *(const f32x4*)(cb + FF + chn + 4 * e4);
#pragma unroll
      for (int e = 0; e < 4; ++e) { ba[4 * e4 + e] = x[e]; bb[4 * e4 + e] = y[e]; }
    }
    const bf16_t* ua = U + (size_t)r0 * uw + 128 * J + c8;
    float pa[8], pb[8], ca[8], cb_[8], na[8], nb[8];
    auto ldrow = [&](int i, float (&xa)[8], float (&xb)[8]) {
      const int tt = t0 + i;
      if (tt < 0 || tt >= T) {
#pragma unroll
        for (int e = 0; e < 8; ++e) { xa[e] = 0.f; xb[e] = 0.f; }
      } else {
        const u32x4 av = *(const u32x4*)(ua + (ptrdiff_t)i * uw), bv = *(const u32x4*)(ua + (ptrdiff_t)i * uw + 64);
#pragma unroll
        for (int e = 0; e < 4; ++e) { xa[2 * e] = bflo(av[e]); xa[2 * e + 1] = bfhi(av[e]); xb[2 * e] = bflo(bv[e]); xb[2 * e + 1] = bfhi(bv[e]); }
      }
    };
    ldrow(-1, pa, pb);
    ldrow(0, ca, cb_);
#pragma unroll
    for (int i = 0; i < 8; ++i) {
      ldrow(i + 1, na, nb);
      u32x4 o;
#pragma unroll
      for (int e = 0; e < 4; ++e) {
        float s[2];
#pragma unroll
        for (int q = 0; q < 2; ++q) {
          const int c = 2 * e + q;
          const float sa = ba[c] + wa[0][c] * pa[c] + wa[1][c] * ca[c] + wa[2][c] * na[c];
          const float sb = bb[c] + wb[0][c] * pb[c] + wb[1][c] * cb_[c] + wb[2][c] * nb[c];
          s[q] = sa * sigmoidf_(sa) * sb;
        }
        o[e] = pack2(s[0], s[1]);
      }
      *(u32x4*)(act + (size_t)(r0 + i) * FF + chn) = o;
#pragma unroll
      for (int e = 0; e < 8; ++e) { pa[e] = ca[e]; pb[e] = cb_[e]; ca[e] = na[e]; cb_[e] = nb[e]; }
    }
  }
}

DI void final_phase(KP& p) {
  const int vt_ = ltid(), lane = vt_ & 63, wv = vt_ >> 6;
  for (int r = VB() * 4 + wv; r < NTOK; r += VG() * 4) {
    float* xr = p.out + (size_t)r * DM;
    f32x4 xv[8];
    float ss = 0.f;
#pragma unroll
    for (int i = 0; i < 8; ++i) { xv[i] = *(const f32x4*)(xr + 4 * (lane + 64 * i)); ss += xv[i][0] * xv[i][0] + xv[i][1] * xv[i][1] + xv[i][2] * xv[i][2] + xv[i][3] * xv[i][3]; }
    ss = wave_sum(ss);
    const float rstd = rsqrtf(ss * (1.f / DM) + EPSV);
#pragma unroll
    for (int i = 0; i < 8; ++i) {
      const int c = 4 * (lane + 64 * i);
      const f32x4 gv = *(const f32x4*)(p.g_final + c);
      f32x4 o = {xv[i][0] * rstd * gv[0], xv[i][1] * rstd * gv[1], xv[i][2] * rstd * gv[2], xv[i][3] * rstd * gv[3]};
      *(f32x4*)(xr + c) = o;
    }
  }
}

constexpr int LSTEPS = 11, NSTEPS = 2 + 2 * LSTEPS + 1;

DI void run_step(KP& p, int step, char* smem) {
  char* ws = p.ws;
  asm volatile("" : "+s"(ws));
  char* gsm = smem + vgrp() * GRP_LDS;
  if (step == 0) { prep_phase(p, gsm); return; }
  if (step == 1) { ada_reduce_phase(p); return; }
  if (step == NSTEPS - 1) { final_phase(p); return; }
  const int l = (step - 2) / LSTEPS, s = (step - 2) % LSTEPS;
  char* wl = ws + l * SZ_WL;
  const float* mod = (const float*)(ws + OFF_MOD) + (size_t)l * 9 * 12288;
  const bf16_t* h = (const bf16_t*)(ws + OFF_H);
  switch (s) {
    case 0: modulate_phase(p, l, 0, l == 0); cache_prep(p, l); break;
    case 1: {
      ProjEpi e; e.ws = ws; e.out = p.out; e.l = l;
      gemm256_phase(h, DM, (const bf16_t*)(wl + WO_IN), 2048, 2048, 96, 23, 0, e, smem);
    } break;
    case 2: ckv_phase(p, l); break;
    case 3: {
      UkvEpi e{ws};
      gemm256_phase((const bf16_t*)(ws + OFF_CKVA), 256, (const bf16_t*)(wl + WO_UKV), 256, 256, 112, 4, 0, e, smem);
    } break;
    case 4: attention_phase(p, l, gsm); break;
    case 5: merge_phase(p, l, smem); break;
    case 6: {
      ResidEpi e{l == 0 ? p.x_prompt : p.out, l == 0 ? p.x_sample : p.out + (size_t)NCTX * DM, p.out, mod + 2 * DM};
      gemm256_phase((const bf16_t*)(ws + OFF_M), DM, (const bf16_t*)(wl + WO_O), 2048, 2048, 96, 8, 0, e, smem);
    } break;
    case 7: modulate_phase(p, l, 1, false); break;
    case 8: up_phase(p, l, smem); break;
    case 9: fixup_phase(p, l); break;
    case 10: {
      ResidEpi e{p.out, p.out + (size_t)NCTX * DM, p.out, mod + 5 * DM};
      gemm256_phase((const bf16_t*)(ws + OFF_ACT), FF, (const bf16_t*)(wl + WO_DN), FF, FF, 96, 8, 0, e, smem);
    } break;
  }
}

#define XB_TMO      128
#define XB_XCNT(j)  (256  + 64 * (j))
#define XB_XSUB(j)  (1280 + 64 * (j))
#define XB_XGEN(j)  (2304 + 64 * (j))
#define XB_TOP      3328
#define XB_TOPGEN   3392
#define XCD_BAR_WORDS 3456
#define XB_SPIN_CAP (1u << 18)
#define LAS __attribute__((address_space(3)))

__device__ __forceinline__ unsigned xb_ld(unsigned* p)              { return __hip_atomic_load(p, __ATOMIC_RELAXED, __HIP_MEMORY_SCOPE_AGENT); }
__device__ __forceinline__ unsigned xb_add(unsigned* p, unsigned v) { return __hip_atomic_fetch_add(p, v, __ATOMIC_RELAXED, __HIP_MEMORY_SCOPE_AGENT); }
__device__ __forceinline__ unsigned xb_xcc_id() { return (unsigned)__builtin_amdgcn_s_getreg((3 << 11) | 20) & 0xFu; }
#define XB_SPIN(cond, bar) do { unsigned _sp = 0; while (cond) { __builtin_amdgcn_s_sleep(1); \
    if ((++_sp & 255u) == 0u) { if (xb_ld(&(bar)[XB_TMO])) break; if (_sp > XB_SPIN_CAP) { atomicAdd(&(bar)[XB_TMO], 1u); break; } } } } while (0)

struct XcdBarrier {
    unsigned* bar; unsigned x;
    volatile LAS unsigned* st;
};

__device__ __forceinline__ XcdBarrier xcd_barrier_post(unsigned* bar, volatile LAS unsigned* st) {
    XcdBarrier b; b.bar = bar; b.x = xb_xcc_id(); b.st = st;
    if (threadIdx.x == 0) (void)xb_add(&bar[XB_XCNT(b.x)], 1u);
    return b;
}
__device__ __forceinline__ void xcd_barrier_complete(unsigned* bar, unsigned x, unsigned& nloc, unsigned& nx) {
    const unsigned G = gridDim.x * gridDim.y * gridDim.z;
    unsigned sum, cnt, mine, sp = 0u;
    for (;;) {
        sum = 0u; cnt = 0u; mine = 0u;
#pragma unroll
        for (unsigned j = 0; j < 16; ++j) { const unsigned c = xb_ld(&bar[XB_XCNT(j)]); sum += c; cnt += (c > 0u) ? 1u : 0u; mine = (j == x) ? c : mine; }
        if (sum == G) break;
        __builtin_amdgcn_s_sleep(1);
        if ((++sp & 255u) == 0u) { if (xb_ld(&bar[XB_TMO])) break; if (sp > XB_SPIN_CAP) { atomicAdd(&bar[XB_TMO], 1u); break; } }
    }
    nloc = mine > 0u ? mine : 1u; nx = cnt > 0u ? cnt : 1u;
}

__device__ __forceinline__ void xcd_barrier(const XcdBarrier& b) {
    asm volatile("s_waitcnt vmcnt(0)" ::: "memory");
    __syncthreads();
    if (threadIdx.x == 0) {
        unsigned* bar = b.bar;
        __builtin_amdgcn_s_waitcnt(0);
        unsigned nloc = b.st[0], nx = b.st[1];
        if (nloc == 0u) { xcd_barrier_complete(bar, b.x, nloc, nx); b.st[0] = nloc; b.st[1] = nx; }
        const unsigned old = xb_add(&bar[XB_XSUB(b.x)], 1u);
        const unsigned gen = old / nloc;
        if (old + 1u == (gen + 1u) * nloc) {
            __builtin_amdgcn_fence(__ATOMIC_RELEASE, "agent");
            asm volatile("s_waitcnt vmcnt(0)" ::: "memory");
            const unsigned og = xb_add(&bar[XB_TOP], 1u);
            const unsigned tg = og / nx;
            if (og + 1u == (tg + 1u) * nx) xb_add(&bar[XB_TOPGEN], 1u);
            else XB_SPIN(xb_ld(&bar[XB_TOPGEN]) == tg, bar);
            __builtin_amdgcn_fence(__ATOMIC_ACQUIRE, "agent");
            xb_add(&bar[XB_XGEN(b.x)], 1u);
            asm volatile("s_waitcnt vmcnt(0)" ::: "memory");
        } else {
            XB_SPIN(xb_ld(&bar[XB_XGEN(b.x)]) == gen, bar);
            __builtin_amdgcn_fence(__ATOMIC_ACQUIRE, "agent");
            asm volatile("s_waitcnt vmcnt(0)" ::: "memory");
        }
    }
    __syncthreads();
}

extern "C" __global__ void __launch_bounds__(RTHR, 2) mega_kernel(Params p) {
  extern __shared__ __attribute__((aligned(16))) char smem[];
  __shared__ unsigned xb_words[4];
  cg::grid_group grid = cg::this_grid();
  if (threadIdx.x < 4) xb_words[threadIdx.x] = 0u;
  __syncthreads();
  XcdBarrier xb = xcd_barrier_post((unsigned*)(p.ws + OFF_BAR), (volatile LAS unsigned*)&xb_words);
  for (int s = p.step_lo; s < p.step_hi; ++s) {
    KP* pp = (KP*)__builtin_amdgcn_kernarg_segment_ptr();
    asm volatile("" : "+s"(pp));
    run_step(*pp, s, smem);
    if (s + 1 < p.step_hi) { if (s == p.step_lo) grid.sync(); else xcd_barrier(xb); }
  }
}

extern "C" void kernel_launch(void* const* d_in, const int* in_sizes, int n_in, void* d_out, int out_size, void* d_ws, size_t ws_size,
                              hipStream_t stream) {
  static int grid_blocks = 0;
  if (!grid_blocks) {
    int dev = 0, cus = 0, per_cu = 0;
    hipGetDevice(&dev);
    hipDeviceGetAttribute(&cus, hipDeviceAttributeMultiprocessorCount, dev);
    hipFuncSetAttribute((const void*)mega_kernel, hipFuncAttributeMaxDynamicSharedMemorySize, LDS_BYTES);
    hipOccupancyMaxActiveBlocksPerMultiprocessor(&per_cu, mega_kernel, RTHR, LDS_BYTES);
    if (per_cu != 1) per_cu = 1;
    grid_blocks = cus * per_cu;
  }
  if (ws_size < WS_NEED) { fprintf(stderr, "workspace too small: %zu < %zu\n", ws_size, (size_t)WS_NEED); return; }
  Params p{};
  const float** pf = (const float**)&p;
  for (int i = 0; i < 30; ++i) pf[i] = (const float*)d_in[i];
  p.out = (float*)d_out;
  p.ws = (char*)d_ws;
#if MULTI
  for (int s = 0; s < NSTEPS; ++s) {
    p.step_lo = s; p.step_hi = s + 1;
    hipLaunchKernelGGL(mega_kernel, dim3(grid_blocks), dim3(RTHR), LDS_BYTES, stream, p);
  }
#else
  p.step_lo = 0; p.step_hi = NSTEPS;
  (void)hipMemsetAsync((char*)d_ws + OFF_BAR, 0, 16384, stream);
  void* args[] = {&p};
  hipError_t e = hipLaunchCooperativeKernel((const void*)mega_kernel, dim3(grid_blocks), dim3(RTHR), args, LDS_BYTES, stream);
  if (e != hipSuccess) fprintf(stderr, "cooperative launch failed: %s (grid %d)\n", hipGetErrorString(e), grid_blocks);
#endif
}
```

```cpp
#include <hip/hip_runtime.h>
#include <hip/hip_cooperative_groups.h>
#include <cstdio>
namespace cg = cooperative_groups;

typedef unsigned short bf16_t;
typedef short bf16x8 __attribute__((ext_vector_type(8)));
typedef float f32x4 __attribute__((ext_vector_type(4)));
typedef float f32x16 __attribute__((ext_vector_type(16)));
typedef unsigned u32x4 __attribute__((ext_vector_type(4)));
typedef unsigned u32x2 __attribute__((ext_vector_type(2)));
#define DI __device__ __forceinline__
#ifndef MULTI
#define MULTI 0
#endif

constexpr int NTHR = 256;
constexpr int RTHR = 512;
constexpr int GRP_LDS = 73728;
constexpr int LDS_BYTES = 2 * GRP_LDS;
constexpr int DM = 2048, NTOK = 24576, NCTX = 8192, SLAT = 2560;
constexpr int NPROJ = 5888, NIN = 14080, FF = 5632, PQW = 3328;
constexpr float EPSV = 1e-6f, LOG2E = 1.4426950408889634f;

constexpr size_t SZ_WIN = (size_t)NIN * 2048 * 2, SZ_WBR = (size_t)4 * 2048 * 512 * 2, SZ_WO = (size_t)2048 * 2048 * 2,
                 SZ_WUP = (size_t)11264 * 2048 * 2, SZ_WDN = (size_t)2048 * 5632 * 2, SZ_WUKV = (size_t)1024 * 256 * 2;
constexpr size_t WO_IN = 0, WO_BR = WO_IN + SZ_WIN, WO_O = WO_BR + SZ_WBR, WO_UP = WO_O + SZ_WO, WO_DN = WO_UP + SZ_WUP, WO_UKV = WO_DN + SZ_WDN,
                 SZ_WL = WO_UKV + SZ_WUKV;
constexpr size_t OFF_MODP = 2 * SZ_WL, SZ_MODP = (size_t)16 * 2 * 9 * 12288 * 4;
constexpr size_t OFF_MOD = OFF_MODP + SZ_MODP, SZ_MOD = (size_t)2 * 9 * 12288 * 4;
constexpr size_t OFF_H = OFF_MOD + SZ_MOD, SZ_H = (size_t)NTOK * 2048 * 2;
constexpr size_t OFF_AR = OFF_H + SZ_H;
constexpr size_t OFF_Y = OFF_AR;
constexpr size_t OFF_PQ = OFF_Y + SZ_H, SZ_PQ = (size_t)NTOK * PQW * 2;
constexpr size_t OFF_MCKV = OFF_PQ + SZ_PQ, SZ_MCKV = (size_t)NTOK * 256 * 4;
constexpr size_t OFF_CKVA = OFF_MCKV + SZ_MCKV, SZ_CKVA = (size_t)28672 * 256 * 2;
constexpr size_t OFF_KV = OFF_CKVA + SZ_CKVA;
constexpr size_t NLROW = 8 * SLAT;
constexpr size_t OFF_KMC = OFF_KV, OFF_VMC = OFF_KMC + (size_t)NCTX * 768 * 2, OFF_KML = OFF_VMC + (size_t)NCTX * 512 * 2,
                 OFF_VML = OFF_KML + NLROW * 768 * 2, OFF_KDC = OFF_VML + NLROW * 512 * 2, OFF_VDC = OFF_KDC + (size_t)NCTX * 512 * 2,
                 OFF_KDL = OFF_VDC + (size_t)NCTX * 512 * 2, OFF_VDL = OFF_KDL + NLROW * 512 * 2, OFF_KNC = OFF_VDL + NLROW * 512 * 2,
                 OFF_VNC = OFF_KNC + (size_t)NCTX * 512 * 2, OFF_KNL = OFF_VNC + (size_t)NCTX * 512 * 2, OFF_VNL = OFF_KNL + NLROW * 512 * 2,
                 OFF_KVEND = OFF_VNL + NLROW * 512 * 2;
constexpr size_t OFF_M = OFF_KV;
static_assert(OFF_KVEND - OFF_KV >= SZ_H, "m alias");
constexpr size_t OFF_ACT = OFF_AR, SZ_ACT = (size_t)NTOK * FF * 2;
constexpr size_t OFF_U = OFF_ACT + SZ_ACT, SZ_U = (size_t)NTOK * 4352 * 2;
static_assert(OFF_U + SZ_U <= OFF_KVEND, "ffn alias");
constexpr size_t OFF_BAR = OFF_KVEND;
constexpr size_t WS_NEED = OFF_BAR + 16384;

constexpr size_t OO_Y = 0, OO_CKV = (size_t)NTOK * 2048, OO_KR = OO_CKV + 4194304, OO_DK = OO_KR + 524288, OO_DV = OO_DK + 8388608,
                 OO_NK = OO_DV + 8388608, OO_NV = OO_NK + 8388608, OO_RET = OO_NV + 8388608;

struct Params {
  const float *x_prompt, *x_sample, *c_ckv, *c_kr, *c_dk, *c_dv, *c_nk, *c_nv, *st_ret, *c, *c_ctx, *w_ada, *b_ada, *g_attn, *g_ffn, *w_in,
      *kv_norm, *w_ukv, *diff_lambda, *diff_norm, *na_bias, *ret_decay, *ret_norm, *w_branch, *w_o, *w_up, *conv_w, *conv_b, *w_down, *g_final;
  float* out;
  char* ws;
  int step_lo, step_hi;
};

typedef __attribute__((address_space(4))) const Params KP;
DI unsigned short f2bf(float f) { unsigned u = __float_as_uint(f); u += 0x7fffu + ((u >> 16) & 1u); return (unsigned short)(u >> 16); }
typedef __bf16 bf16v2_t __attribute__((ext_vector_type(2)));
typedef float f32v2_t __attribute__((ext_vector_type(2)));
DI unsigned pack2(float a, float b) { f32v2_t v = {a, b}; return __builtin_bit_cast(unsigned, __builtin_convertvector(v, bf16v2_t)); }
DI float bf2f(unsigned short h) { return __uint_as_float(((unsigned)h) << 16); }
DI float bflo(unsigned u) { return __uint_as_float(u << 16); }
DI float bfhi(unsigned u) { return __uint_as_float(u & 0xffff0000u); }
typedef __attribute__((address_space(1))) const u32x4 g_u32x4;
DI u32x4 gld16(const void* p) { return *(g_u32x4*)p; }
#define SCHED_FENCE() __builtin_amdgcn_sched_barrier(0)
DI int ltid() { int t = threadIdx.x; asm volatile("" : "+v"(t)); return t & 255; }
DI int rtid() { int t = threadIdx.x; asm volatile("" : "+v"(t)); return t; }
DI int vgrp() { return __builtin_amdgcn_readfirstlane((int)(threadIdx.x >> 8)); }
DI int VB() { return (int)blockIdx.x * 2 + vgrp(); }
DI int VG() { return (int)gridDim.x * 2; }
DI float shx(float v, int o) {
  int l = __builtin_amdgcn_mbcnt_hi(~0u, __builtin_amdgcn_mbcnt_lo(~0u, 0u));
  asm volatile("" : "+v"(l));
  return __int_as_float(__builtin_amdgcn_ds_bpermute((l ^ o) << 2, __float_as_int(v)));
}
DI float x32_max(float v) { auto r = __builtin_amdgcn_permlane32_swap(__float_as_uint(v), __float_as_uint(v), false, false); return fmaxf(__uint_as_float(r[0]), __uint_as_float(r[1])); }
DI float x32_sum(float v) { auto r = __builtin_amdgcn_permlane32_swap(__float_as_uint(v), __float_as_uint(v), false, false); return __uint_as_float(r[0]) + __uint_as_float(r[1]); }
DI float wave_sum(float v) {
#pragma unroll
  for (int o = 32; o >= 1; o >>= 1) v += shx(v, o);
  return v;
}
DI float sigmoidf_(float x) { return __builtin_amdgcn_rcpf(1.f + __builtin_amdgcn_exp2f(-1.4426950408889634f * x)); }
DI int grp_of(int r) { return r < NCTX ? 0 : 1 + ((r - NCTX) >> 11); }
DI int kvrow_of(int r) { int rr = r - NCTX; return (rr >> 11) * SLAT + (rr & 2047); }
DI const float* xrow_in(KP& p, int r) { return r < NCTX ? p.x_prompt + (size_t)r * DM : p.x_sample + (size_t)(r - NCTX) * DM; }

template <int WN>
DI void gemm_kloop(f32x4 (&acc)[4][WN], const bf16_t* __restrict__ A, int lda, const bf16_t* __restrict__ B, int ldb, int K, char* smem) {
  const int tid = ltid(), wid = tid >> 6, lane = tid & 63, wr = wid >> 1, wc = wid & 1, fr = lane & 15, fq = lane >> 4;
  const int r0 = tid >> 3, ch = tid & 7;
  const bf16_t* ap = A + (size_t)r0 * lda + ch * 8;
  const bf16_t* bp = B + (size_t)r0 * ldb + ch * 8;
  u32x4 ra0[4], rb0[WN], ra1[4], rb1[WN];
  const int nk = K >> 6;
  const int swz_w = (r0 >> 1) & 7, swz_r = (fr >> 1) & 7;
  char* sa = smem + r0 * 128 + ((ch ^ swz_w) * 16);
  char* sb = smem + 32768 + r0 * 128 + ((ch ^ swz_w) * 16);
  const char* fa = smem + (64 * wr + fr) * 128;
  const char* fb = smem + 32768 + (16 * WN * wc + fr) * 128;
  const int ko0 = ((fq ^ swz_r) * 16), ko1 = (((4 + fq) ^ swz_r) * 16);
  auto gload = [&](u32x4 (&RA)[4], u32x4 (&RB)[WN], int kt) {
#pragma unroll
    for (int i = 0; i < 4; ++i) RA[i] = gld16(ap + (size_t)(32 * i) * lda + kt * 64);
#pragma unroll
    for (int i = 0; i < WN; ++i) RB[i] = gld16(bp + (size_t)(32 * i) * ldb + kt * 64);
  };
  auto sstore = [&](const u32x4 (&RA)[4], const u32x4 (&RB)[WN], int buf) {
#pragma unroll
    for (int i = 0; i < 4; ++i) *(u32x4*)(sa + buf * 16384 + i * 32 * 128) = RA[i];
#pragma unroll
    for (int i = 0; i < WN; ++i) *(u32x4*)(sb + buf * 16384 + i * 32 * 128) = RB[i];
  };
  auto compute = [&](int buf) {
#pragma unroll
    for (int ks = 0; ks < 2; ++ks) {
      bf16x8 af[4], bfr[WN];
#pragma unroll
      for (int mi = 0; mi < 4; ++mi) af[mi] = *(const bf16x8*)(fa + buf * 16384 + mi * 16 * 128 + (ks ? ko1 : ko0));
#pragma unroll
      for (int ni = 0; ni < WN; ++ni) bfr[ni] = *(const bf16x8*)(fb + buf * 16384 + ni * 16 * 128 + (ks ? ko1 : ko0));
#pragma unroll
      for (int mi = 0; mi < 4; ++mi)
#pragma unroll
        for (int ni = 0; ni < WN; ++ni) acc[mi][ni] = __builtin_amdgcn_mfma_f32_16x16x32_bf16(bfr[ni], af[mi], acc[mi][ni], 0, 0, 0);
    }
  };
  auto step = [&](u32x4 (&RA)[4], u32x4 (&RB)[WN], int buf, int kt) {
    compute(buf);
    SCHED_FENCE();
    if (kt + 1 < nk) {
      sstore(RA, RB, buf ^ 1);
      if (kt + 3 < nk) gload(RA, RB, kt + 3);
    }
    SCHED_FENCE();
    __syncthreads();
  };
  gload(ra0, rb0, 0);
  gload(ra1, rb1, 1);
  __syncthreads();
  sstore(ra0, rb0, 0);
  gload(ra0, rb0, 2);
  SCHED_FENCE();
  __syncthreads();
#pragma unroll 1
  for (int kt = 0; kt < nk; kt += 2) {
    step(ra1, rb1, 0, kt);
    step(ra0, rb0, 1, kt + 1);
  }
}

template <int WN, class F>
DI void gemm_epilogue(const f32x4 (&acc)[4][WN], char* smem, int m0, int n0, const F& f) {
  constexpr int BN = 32 * WN, CS = BN + 4;
  const int tid = ltid(), wid = tid >> 6, lane = tid & 63, wr = wid >> 1, wc = wid & 1, fr = lane & 15, fq = lane >> 4;
  float* ct = (float*)smem;
#pragma unroll
  for (int mi = 0; mi < 4; ++mi)
#pragma unroll
    for (int ni = 0; ni < WN; ++ni) *(f32x4*)(ct + (64 * wr + 16 * mi + fr) * CS + 16 * WN * wc + 16 * ni + 4 * fq) = acc[mi][ni];
  __syncthreads();
  constexpr int CPR = BN / 32;
#pragma unroll 1
  for (int u = tid; u < 128 * CPR; u += NTHR) {
    const int row = u / CPR, chn = u % CPR;
    float v[32];
#pragma unroll
    for (int j = 0; j < 8; ++j) {
      f32x4 t = *(const f32x4*)(ct + row * CS + chn * 32 + 4 * j);
      v[4 * j] = t[0]; v[4 * j + 1] = t[1]; v[4 * j + 2] = t[2]; v[4 * j + 3] = t[3];
    }
    f(m0 + row, n0 + chn * 32, v);
  }
  __syncthreads();
}

DI void store_bf16_32(bf16_t* dst, const float (&v)[32]) {
#pragma unroll
  for (int j = 0; j < 4; ++j) {
    u32x4 t;
    t[0] = pack2(v[8 * j], v[8 * j + 1]); t[1] = pack2(v[8 * j + 2], v[8 * j + 3]);
    t[2] = pack2(v[8 * j + 4], v[8 * j + 5]); t[3] = pack2(v[8 * j + 6], v[8 * j + 7]);
    *(u32x4*)(dst + 8 * j) = t;
  }
}
DI void store_f32_32(float* dst, const float (&v)[32]) {
#pragma unroll
  for (int j = 0; j < 8; ++j) { f32x4 t = {v[4 * j], v[4 * j + 1], v[4 * j + 2], v[4 * j + 3]}; *(f32x4*)(dst + 4 * j) = t; }
}


DI bool tile_map(int t, int nM, int nN, int PMS, int& pm, int& pn) {
  if (t >= nM * nN) return false;
  const int per_g = PMS * nN, g = t / per_g, r = t % per_g, j = r / (4 * PMS), q = r - j * 4 * PMS;
  pm = PMS * g + (q % PMS); pn = 4 * j + (q / PMS);
  return true;
}
DI int vtile_slot(int i) { const int b = blockIdx.x; return (i * 8 + (b & 7)) * ((int)(gridDim.x >> 3) * 2) + (b >> 3) * 2 + vgrp(); }
DI int rtile_slot(int i) { const int b = blockIdx.x; return (i * 8 + (b & 7)) * (int)(gridDim.x >> 3) + (b >> 3); }

template <int NI>
DI void gemm256_kloop(f32x4 (&acc)[8][NI], u32x4 (&ra)[4], u32x4 (&rb)[NI], const bf16_t* __restrict__ A, int lda, const bf16_t* __restrict__ B, int ldb, int K,
                      const bf16_t* __restrict__ An, int ldan, const bf16_t* __restrict__ Bn, int ldbn, bool chained, char* smem) {
  const int tid = rtid(), wid = tid >> 6, lane = tid & 63, wr = wid >> 2, wc = wid & 3, fr = lane & 15, fq = lane >> 4;
  const int r0 = tid >> 3, ch = tid & 7;
  const bf16_t* ap = A + (size_t)r0 * lda + ch * 8;
  const bf16_t* bp = B + (size_t)r0 * ldb + ch * 8;
  const bf16_t* apn = An + (size_t)r0 * ldan + ch * 8;
  const bf16_t* bpn = Bn + (size_t)r0 * ldbn + ch * 8;
  const int nk = K >> 6;
  const int swz_w = (r0 >> 1) & 7, swz_r = (fr >> 1) & 7;
  char* sa = smem + r0 * 128 + ((ch ^ swz_w) * 16);
  char* sb = smem + 65536 + r0 * 128 + ((ch ^ swz_w) * 16);
  const char* fa = smem + (128 * wr + fr) * 128;
  const char* fb = smem + 65536 + (16 * NI * wc + fr) * 128;
  const int ko0 = ((fq ^ swz_r) * 16), ko1 = (((4 + fq) ^ swz_r) * 16);
  auto gload = [&](int kt) {
#pragma unroll
    for (int i = 0; i < 4; ++i) ra[i] = gld16(ap + (size_t)(64 * i) * lda + kt * 64);
#pragma unroll
    for (int i = 0; i < NI; ++i) rb[i] = gld16(bp + (size_t)(64 * i) * ldb + kt * 64);
  };
  auto sstore = [&](int buf) {
#pragma unroll
    for (int i = 0; i < 4; ++i) *(u32x4*)(sa + buf * 32768 + i * 64 * 128) = ra[i];
#pragma unroll
    for (int i = 0; i < NI; ++i) *(u32x4*)(sb + buf * 32768 + i * 64 * 128) = rb[i];
  };
  if (!chained) {
    gload(0);
    __syncthreads();
    sstore(0);
    gload(1);
    SCHED_FENCE();
    __syncthreads();
  }
  auto half = [&](int buf, int ks, bool refill, int ktn, bool nxt) {
    const char* pa = fa + buf * 32768 + (ks ? ko1 : ko0);
    const char* pb = fb + buf * 32768 + (ks ? ko1 : ko0);
    constexpr int RD = (NI == 4) ? 2 : 4;
    bf16x8 bfr[NI], ar[RD];
#pragma unroll
    for (int ni = 0; ni < NI; ++ni) bfr[ni] = *(const bf16x8*)(pb + ni * 2048);
#pragma unroll
    for (int d = 0; d < RD; ++d) ar[d] = *(const bf16x8*)(pa + d * 2048);
#pragma unroll
    for (int mi = 0; mi < 8; ++mi) {
#pragma unroll
      for (int ni = 0; ni < NI; ++ni) acc[mi][ni] = __builtin_amdgcn_mfma_f32_16x16x32_bf16(bfr[ni], ar[mi % RD], acc[mi][ni], 0, 0, 0);
      if (mi + RD < 8) ar[mi % RD] = *(const bf16x8*)(pa + (mi + RD) * 2048);
      if ((mi & 1) == 0) {
        const int pc = mi >> 1;
        if (ks == 0) {
          *(u32x4*)(sa + (buf ^ 1) * 32768 + pc * 64 * 128) = ra[pc];
          ra[pc] = gld16(nxt ? apn + (size_t)(64 * pc) * ldan + ktn * 64 : ap + (size_t)(64 * pc) * lda + ktn * 64);
        } else if (pc < NI) {
          *(u32x4*)(sb + (buf ^ 1) * 32768 + pc * 64 * 128) = rb[pc];
          rb[pc] = gld16(nxt ? bpn + (size_t)(64 * pc) * ldbn + ktn * 64 : bp + (size_t)(64 * pc) * ldb + ktn * 64);
        }
      }
    }
    __builtin_amdgcn_sched_group_barrier(0x100, NI + RD, 0);
#pragma unroll
    for (int mi = 0; mi < 8; ++mi) {
      __builtin_amdgcn_sched_group_barrier(0x008, NI, 0);
      if (mi + RD < 8) __builtin_amdgcn_sched_group_barrier(0x100, 1, 0);
      if ((mi & 1) == 0 && (ks == 0 || (mi >> 1) < NI)) { __builtin_amdgcn_sched_group_barrier(0x200, 1, 0); __builtin_amdgcn_sched_group_barrier(0x020, 1, 0); }
    }
  };
#pragma unroll 1
  for (int kt = 0; kt < nk; ++kt) {
    const int buf = kt & 1;
    const bool nxt = kt + 2 >= nk;
    const int ktn = nxt ? kt + 2 - nk : kt + 2;
    half(buf, 0, true, ktn, nxt);
    half(buf, 1, true, ktn, nxt);
    __syncthreads();
  }
}

template <int NI, class F>
DI void gemm256_epilogue(const f32x4 (&acc)[8][NI], char* smem, int m0, int n0, const F& f) {
  constexpr int CSB = NI * 128 + 16, CPR = NI * 2;
  const int tid = rtid(), wid = tid >> 6, lane = tid & 63, wr = wid >> 2, wc = wid & 3, fr = lane & 15, fq = lane >> 4;
#pragma unroll
  for (int mi = 0; mi < 8; ++mi)
#pragma unroll
    for (int ni = 0; ni < NI; ++ni) {
      u32x2 t = {pack2(acc[mi][ni][0], acc[mi][ni][1]), pack2(acc[mi][ni][2], acc[mi][ni][3])};
      *(u32x2*)(smem + (128 * wr + 16 * mi + fr) * CSB + (16 * NI * wc + 16 * ni + 4 * fq) * 2) = t;
    }
  __syncthreads();
#pragma unroll 1
  for (int u = tid; u < 256 * CPR; u += RTHR) {
    const int row = u / CPR, chn = u % CPR;
    float v[32];
#pragma unroll
    for (int j = 0; j < 4; ++j) {
      const u32x4 t = *(const u32x4*)(smem + row * CSB + chn * 64 + 16 * j);
#pragma unroll
      for (int e = 0; e < 4; ++e) { v[8 * j + 2 * e] = bflo(t[e]); v[8 * j + 2 * e + 1] = bfhi(t[e]); }
    }
    f(m0 + row, n0 + chn * 32, v);
  }
  __syncthreads();
}

template <class F>
DI void gemm256_phase(const bf16_t* A, int lda, const bf16_t* B, int ldb, int K, int nM, int nN, int pn_base, const F& f, char* smem) {
  for (int it = 0;; ++it) {
    int pm, pn;
    if (!tile_map(rtile_slot(it), nM, nN, 8, pm, pn)) break;
    pn += pn_base;
    f32x4 acc[8][4];
#pragma unroll
    for (int mi = 0; mi < 8; ++mi)
#pragma unroll
      for (int ni = 0; ni < 4; ++ni) acc[mi][ni] = (f32x4){0.f, 0.f, 0.f, 0.f};
    u32x4 ra[4], rb[4];
    const bf16_t* At = A + (size_t)pm * 256 * lda; const bf16_t* Bt = B + (size_t)pn * 256 * ldb;
    gemm256_kloop<4>(acc, ra, rb, At, lda, Bt, ldb, K, At, lda, Bt, ldb, false, smem);
    gemm256_epilogue<4>(acc, smem, pm * 256, pn * 256, f);
  }
}

template <int NF>
DI void rope_seg(float* v, float pos) {
#pragma unroll
  for (int f = 0; f < NF; ++f) {
    const float inv = exp2f(-(float)f / (float)NF * 13.287712379549449f) * 0.15915494309189535f;
    const float rev = pos * inv;
    const float cs = __builtin_amdgcn_cosf(rev), sn = __builtin_amdgcn_sinf(rev);
    const float a = v[f], b = v[NF + f];
    v[f] = a * cs - b * sn;
    v[NF + f] = b * cs + a * sn;
  }
}

struct ProjEpi {
  char* ws; float* out; int l;
  DI void state_out(size_t base, int W, int r, int c, const float (&v)[32]) const {
    const int b = r >> 8, t = r & 255;
    store_f32_32(out + base + ((size_t)((b * 2 + l) * 256 + t)) * W + c, v);
  }
  DI void operator()(int r, int c0, float (&v)[32]) const {
    bf16_t* const pq = (bf16_t*)(ws + OFF_PQ); bf16_t* const kmc = (bf16_t*)(ws + OFF_KMC); bf16_t* const kml = (bf16_t*)(ws + OFF_KML);
    bf16_t* const kdc = (bf16_t*)(ws + OFF_KDC); bf16_t* const vdc = (bf16_t*)(ws + OFF_VDC); bf16_t* const kdl = (bf16_t*)(ws + OFF_KDL);
    bf16_t* const vdl = (bf16_t*)(ws + OFF_VDL); bf16_t* const knc = (bf16_t*)(ws + OFF_KNC); bf16_t* const vnc = (bf16_t*)(ws + OFF_VNC);
    bf16_t* const knl = (bf16_t*)(ws + OFF_KNL); bf16_t* const vnl = (bf16_t*)(ws + OFF_VNL); float* const mckv = (float*)(ws + OFF_MCKV);
    const bool lat = r >= NCTX;
    int prow = 0, pcol = 0;
    if (lat) { const int t = (r - NCTX) & 2047; prow = t >> 6; pcol = t & 63; }
    if (c0 < 768) {
      if (lat && (c0 % 96) == 64) { rope_seg<8>(v, (float)prow); rope_seg<8>(v + 16, (float)pcol); }
      store_bf16_32(pq + (size_t)r * PQW + c0, v);
    } else if (c0 < 1024) {
      store_f32_32(mckv + (size_t)r * 256 + (c0 - 768), v);
    } else if (c0 < 1536) {
      if (lat) rope_seg<16>(v, (float)((((c0 - 1024) >> 5) & 1) ? pcol : prow));
      store_bf16_32(pq + (size_t)r * PQW + 768 + (c0 - 1024), v);
    } else if (c0 < 2048) {
      const int c = c0 - 1536;
      if (lat) { rope_seg<16>(v, (float)(((c >> 5) & 1) ? pcol : prow)); store_bf16_32(kdl + (size_t)kvrow_of(r) * 512 + c, v); }
      else { store_bf16_32(kdc + (size_t)r * 512 + c, v); state_out(OO_DK, 512, r, c, v); }
    } else if (c0 < 2560) {
      const int c = c0 - 2048;
      if (lat) store_bf16_32(vdl + (size_t)kvrow_of(r) * 512 + c, v);
      else { store_bf16_32(vdc + (size_t)r * 512 + c, v); state_out(OO_DV, 512, r, c, v); }
    } else if (c0 < 3072) {
      store_bf16_32(pq + (size_t)r * PQW + 1280 + (c0 - 2560), v);
    } else if (c0 < 3584) {
      const int c = c0 - 3072;
      if (lat) store_bf16_32(knl + (size_t)kvrow_of(r) * 512 + c, v);
      else { store_bf16_32(knc + (size_t)r * 512 + c, v); state_out(OO_NK, 512, r, c, v); }
    } else if (c0 < 4096) {
      const int c = c0 - 3584;
      if (lat) store_bf16_32(vnl + (size_t)kvrow_of(r) * 512 + c, v);
      else { store_bf16_32(vnc + (size_t)r * 512 + c, v); state_out(OO_NV, 512, r, c, v); }
    } else if (c0 < 5632) {
      store_bf16_32(pq + (size_t)r * PQW + 1792 + (c0 - 4096), v);
    } else if (c0 == 5632) {
      bf16_t* dst;
      if (lat) { rope_seg<8>(v, (float)prow); rope_seg<8>(v + 16, (float)pcol); dst = kml + (size_t)kvrow_of(r) * 768; }
      else { state_out(OO_KR, 32, r, 0, v); dst = kmc + (size_t)r * 768; }
#pragma unroll 1
      for (int h = 0; h < 8; ++h) store_bf16_32(dst + h * 96 + 64, v);
    }
  }
};

struct UkvEpi {
  char* ws;
  DI void operator()(int R, int c0, float (&v)[32]) const {
    size_t row, ko, vo;
    if (R < NCTX) { ko = OFF_KMC; vo = OFF_VMC; row = R; }
    else if (R < NTOK) { ko = OFF_KML; vo = OFF_VML; row = kvrow_of(R); }
    else { const int c = R - NTOK; ko = OFF_KML; vo = OFF_VML; row = (size_t)(c >> 9) * SLAT + 2048 + (c & 511); }
    const int hd = c0 >> 7, e = c0 & 127;
    if (e < 64) store_bf16_32((bf16_t*)(ws + ko) + row * 768 + hd * 96 + e, v);
    else store_bf16_32((bf16_t*)(ws + vo) + row * 512 + hd * 64 + (e - 64), v);
  }
};

struct StoreBf16Epi {
  bf16_t* dst; int ld; int coff;
  DI void operator()(int r, int c0, float (&v)[32]) const { store_bf16_32(dst + (size_t)r * ld + (c0 - coff), v); }
};

struct ResidEpi {
  const float* xp; const float* xs; float* out; const float* ga;
  DI void operator()(int r, int c0, float (&v)[32]) const {
    const float* xr = (r < NCTX ? xp + (size_t)r * DM : xs + (size_t)(r - NCTX) * DM) + c0;
    const float* g = ga + (size_t)grp_of(r) * 12288 + c0;
    float* o = out + (size_t)r * DM + c0;
#pragma unroll
    for (int j = 0; j < 8; ++j) {
      const f32x4 xv = *(const f32x4*)(xr + 4 * j), gv = *(const f32x4*)(g + 4 * j);
      f32x4 t = {xv[0] + gv[0] * v[4 * j], xv[1] + gv[1] * v[4 * j + 1], xv[2] + gv[2] * v[4 * j + 2], xv[3] + gv[3] * v[4 * j + 3]};
      *(f32x4*)(o + 4 * j) = t;
    }
  }
};

struct AttnArgs {
  const bf16_t *q, *k, *v; int q_ld, k_ld, v_ld; int n_keys; float sl2;
  bf16_t* y; int y_ld;
  int R0; const float* bias;
  int t0, T; float lgf, lgb; const float *s0f, *s0b; const bf16_t* rg; int rg_ld; const float* nw;
  float lam, omli;
};

constexpr int A_VT = 13312, A_BIAS = 30720, A_S0 = 32768;

template <int DQ, int DV, int MODE>
DI void attn_block(char* smem, const AttnArgs& a) {
  constexpr int KSTR = (DQ + 8) * 2, CK = DQ / 8, NKL = 64 * CK / NTHR, NVL = (32 * DV / 8) / NTHR, NKS = DQ / 16, NDB = DV / 32;
  const int tid = ltid(), w = tid >> 6, lane = tid & 63, ql = lane & 31, g = lane >> 5;
  const int qloc = 32 * w + ql;
  f32x16 O[NDB];
  float m_run = -1e30f, l_run = 0.f;
#pragma unroll
  for (int d = 0; d < NDB; ++d)
#pragma unroll
    for (int i = 0; i < 16; ++i) O[d][i] = 0.f;

  int na_r = 0, na_c = 0, na_rs = 0, na_cs = 0, rlo = 0, nloc = 0;
  if (MODE == 1) {
    na_r = a.R0 + (w >> 1); na_c = 32 * (w & 1) + ql;
    na_rs = min(max(na_r - 4, 0), 24); na_cs = min(max(na_c - 8, 0), 48);
    rlo = min(max(a.R0 - 4, 0), 24);
    nloc = 9;
    __syncthreads();
    float* bl = (float*)(smem + A_BIAS);
    for (int i = tid; i < 465; i += NTHR) bl[i] = a.bias[i] * LOG2E;
  }
  const int npass = (MODE == 3) ? 2 : 1;
  const int ntile = (MODE == 1) ? (nloc + 8) : (a.n_keys >> 6);
  const int t_q = a.t0 + qloc;

  bf16x8 qf[NKS];
  u32x4 rk[NKL], rv0[NVL], rv1[NVL];

  auto key0_of = [&](int it) -> int {
    if (MODE == 1) return it < nloc ? (rlo + it) * 64 : 2048 + 64 * (it - nloc);
    return it * 64;
  };
  auto prefetch = [&](int it, int pass) {
    const int key0 = key0_of(it);
    const bf16_t* kp = a.k + (MODE == 3 ? pass * 64 : 0);
#pragma unroll
    for (int i = 0; i < NKL; ++i) { const int idx = tid + NTHR * i, row = idx / CK, c = idx % CK; rk[i] = gld16(kp + (size_t)(key0 + row) * a.k_ld + 8 * c); }
#pragma unroll
    for (int i = 0; i < NVL; ++i) {
      const int idx = tid + NTHR * i, pr = idx & 31, c = idx >> 5;
      rv0[i] = gld16(a.v + (size_t)(key0 + 2 * pr) * a.v_ld + 8 * c);
      rv1[i] = gld16(a.v + (size_t)(key0 + 2 * pr + 1) * a.v_ld + 8 * c);
    }
  };
  auto stage = [&]() {
#pragma unroll
    for (int i = 0; i < NKL; ++i) { const int idx = tid + NTHR * i, row = idx / CK, c = idx % CK; *(u32x4*)(smem + row * KSTR + 16 * c) = rk[i]; }
#pragma unroll
    for (int i = 0; i < NVL; ++i) {
      const int idx = tid + NTHR * i, pr = idx & 31, c = idx >> 5;
      char* base = smem + A_VT + (8 * c) * 136 + 4 * pr;
#pragma unroll
      for (int e = 0; e < 4; ++e) {
        const unsigned x = rv0[i][e], y = rv1[i][e];
        *(unsigned*)(base + (2 * e) * 136) = (x & 0xffffu) | (y << 16);
        *(unsigned*)(base + (2 * e + 1) * 136) = (x >> 16) | (y & 0xffff0000u);
      }
    }
  };

#pragma unroll 1
  for (int pass = 0; pass < npass; ++pass) {
    {
      const bf16_t* qp = a.q + (MODE == 3 ? pass * 64 : 0) + (size_t)qloc * a.q_ld + 8 * g;
#pragma unroll
      for (int ks = 0; ks < NKS; ++ks) qf[ks] = *(const bf16x8*)(qp + 16 * ks);
    }
    prefetch(0, pass);
#pragma unroll 1
    for (int it = 0; it < ntile; ++it) {
      __syncthreads();
      stage();
      __syncthreads();
      if (it + 1 < ntile) prefetch(it + 1, pass);
      SCHED_FENCE();
      const int key0 = key0_of(it);
      bool active = true;
      int kr = 0;
      const bool local = (MODE == 1) && it < nloc;
      if (local) { kr = rlo + it; active = (kr >= na_rs) && (kr < na_rs + 8); }
      if (active) {
#pragma unroll
        for (int kb = 0; kb < 2; ++kb) {
          f32x16 s;
#pragma unroll
          for (int i = 0; i < 16; ++i) s[i] = 0.f;
          bf16x8 kfr[NKS];
#pragma unroll
          for (int ks = 0; ks < NKS; ++ks) kfr[ks] = *(const bf16x8*)(smem + (32 * kb + ql) * KSTR + (16 * ks + 8 * g) * 2);
          u32x4 vfr[NDB][2];
#pragma unroll
          for (int d = 0; d < NDB; ++d)
#pragma unroll
            for (int h2 = 0; h2 < 2; ++h2) {
              const char* vp = smem + A_VT + (32 * d + ql) * 136 + (32 * kb + 16 * h2 + 4 * g) * 2;
              const u32x2 lo = *(const u32x2*)vp, hi = *(const u32x2*)(vp + 16);
              vfr[d][h2] = (u32x4){lo[0], lo[1], hi[0], hi[1]};
            }
          SCHED_FENCE();
#pragma unroll
          for (int ks = 0; ks < NKS; ++ks) s = __builtin_amdgcn_mfma_f32_32x32x16_bf16(kfr[ks], qf[ks], s, 0, 0, 0);
          float p[16];
          if (MODE == 2) {
#pragma unroll
            for (int i = 0; i < 16; ++i) {
              const int j = key0 + 32 * kb + 8 * (i >> 2) + 4 * g + (i & 3);
              const int d = t_q - j;
              const float e = d >= 0 ? (float)d * a.lgf : (float)(-d) * a.lgb;
              p[i] = s[i] * a.sl2 * __builtin_amdgcn_exp2f(e);
            }
          } else {
            if (local) {
              const float* bl = (const float*)(smem + A_BIAS) + (kr - na_r + 7) * 31 + 15;
#pragma unroll
              for (int i = 0; i < 16; ++i) {
                const int kc = 32 * kb + 8 * (i >> 2) + 4 * g + (i & 3);
                const int dc = min(max(kc - na_c, -15), 15);
                const bool ok = (kc >= na_cs) && (kc < na_cs + 16);
                p[i] = ok ? (s[i] * a.sl2 + bl[dc]) : -1e30f;
              }
            }
            float mx;
            if (local) {
              mx = p[0];
#pragma unroll
              for (int i = 1; i < 16; ++i) mx = fmaxf(mx, p[i]);
            } else {
              mx = s[0];
#pragma unroll
              for (int i = 1; i < 16; ++i) mx = fmaxf(mx, s[i]);
              mx *= a.sl2;
            }
            mx = x32_max(mx);
            const float m_new = fmaxf(m_run, mx);
            const float alpha = __builtin_amdgcn_exp2f(m_run - m_new);
            m_run = m_new;
            float ls = 0.f;
            if (local) {
#pragma unroll
              for (int i = 0; i < 16; ++i) { p[i] = __builtin_amdgcn_exp2f(p[i] - m_new); ls += p[i]; }
            } else {
#pragma unroll
              for (int i = 0; i < 16; ++i) { p[i] = __builtin_amdgcn_exp2f(__builtin_fmaf(s[i], a.sl2, -m_new)); ls += p[i]; }
            }
            l_run = l_run * alpha + ls;
            if (__ballot(alpha != 1.f) != 0ull) {
#pragma unroll
              for (int d = 0; d < NDB; ++d)
#pragma unroll
                for (int i = 0; i < 16; ++i) O[d][i] *= alpha;
            }
          }
          bf16x8 pf[2];
#pragma unroll
          for (int h2 = 0; h2 < 2; ++h2) {
            u32x4 t;
#pragma unroll
            for (int e = 0; e < 4; ++e) t[e] = pack2(p[8 * h2 + 2 * e], p[8 * h2 + 2 * e + 1]);
            pf[h2] = __builtin_bit_cast(bf16x8, t);
          }
#pragma unroll
          for (int d = 0; d < NDB; ++d)
#pragma unroll
            for (int h2 = 0; h2 < 2; ++h2) {
              O[d] = __builtin_amdgcn_mfma_f32_32x32x16_bf16(__builtin_bit_cast(bf16x8, vfr[d][h2]), pf[h2], O[d], 0, 0, 0);
            }
        }
      }
    }
    if (MODE == 3 && pass == 0) {
      const float lt = x32_sum(l_run);
      const float inv = 1.f / lt;
#pragma unroll
      for (int d = 0; d < NDB; ++d)
#pragma unroll
        for (int i4 = 0; i4 < 4; ++i4) {
          u32x2 t = {pack2(O[d][4 * i4] * inv, O[d][4 * i4 + 1] * inv), pack2(O[d][4 * i4 + 2] * inv, O[d][4 * i4 + 3] * inv)};
          *(u32x2*)(smem + A_S0 + qloc * 264 + (32 * d + 8 * i4 + 4 * g) * 2) = t;
          O[d][4 * i4] = 0.f; O[d][4 * i4 + 1] = 0.f; O[d][4 * i4 + 2] = 0.f; O[d][4 * i4 + 3] = 0.f;
        }
      m_run = -1e30f; l_run = 0.f;
    }
  }

  if (MODE == 2 && a.s0f != nullptr) {
#pragma unroll 1
    for (int dir = 0; dir < 2; ++dir) {
      const float* s0 = dir ? a.s0b : a.s0f;
      __syncthreads();
      for (int idx = tid; idx < 64 * 32; idx += NTHR) {
        const int dk = idx >> 5, dv4 = (idx & 31) * 4;
        const f32x4 t = *(const f32x4*)(s0 + dk * 128 + dv4);
#pragma unroll
        for (int e = 0; e < 4; ++e) *(bf16_t*)(smem + A_S0 + (dv4 + e) * 144 + dk * 2) = f2bf(t[e]);
      }
      __syncthreads();
      const float sc = dir ? __builtin_amdgcn_exp2f((float)(a.T - t_q) * a.lgb) : __builtin_amdgcn_exp2f((float)(t_q + 1) * a.lgf);
#pragma unroll
      for (int d = 0; d < NDB; ++d) {
        f32x16 tacc;
#pragma unroll
        for (int i = 0; i < 16; ++i) tacc[i] = 0.f;
#pragma unroll
        for (int ks = 0; ks < NKS; ++ks) {
          const bf16x8 sf = *(const bf16x8*)(smem + A_S0 + (32 * d + ql) * 144 + (16 * ks + 8 * g) * 2);
          tacc = __builtin_amdgcn_mfma_f32_32x32x16_bf16(sf, qf[ks], tacc, 0, 0, 0);
        }
#pragma unroll
        for (int i = 0; i < 16; ++i) O[d][i] += sc * tacc[i];
      }
    }
  }

  if (MODE == 0 || MODE == 1) {
    const float lt = x32_sum(l_run);
    const float inv = 1.f / lt;
#pragma unroll
    for (int d = 0; d < NDB; ++d)
#pragma unroll
      for (int i = 0; i < 16; ++i) O[d][i] *= inv;
  } else if (MODE == 3) {
    const float lt = x32_sum(l_run);
    const float inv = a.lam / lt;
    float ss = 0.f;
#pragma unroll
    for (int d = 0; d < NDB; ++d)
#pragma unroll
      for (int i4 = 0; i4 < 4; ++i4) {
        const u32x2 t = *(const u32x2*)(smem + A_S0 + qloc * 264 + (32 * d + 8 * i4 + 4 * g) * 2);
        const float o0[4] = {bflo(t[0]), bfhi(t[0]), bflo(t[1]), bfhi(t[1])};
#pragma unroll
        for (int e = 0; e < 4; ++e) { const float o = o0[e] - O[d][4 * i4 + e] * inv; O[d][4 * i4 + e] = o; ss += o * o; }
      }
    ss = x32_sum(ss);
    const float rstd = rsqrtf(ss * (1.f / DV) + EPSV) * a.omli;
#pragma unroll
    for (int d = 0; d < NDB; ++d)
#pragma unroll
      for (int i4 = 0; i4 < 4; ++i4) {
        const f32x4 wv = *(const f32x4*)(a.nw + 32 * d + 8 * i4 + 4 * g);
#pragma unroll
        for (int e = 0; e < 4; ++e) O[d][4 * i4 + e] *= rstd * wv[e];
      }
  } else {
    float sm = 0.f;
#pragma unroll
    for (int d = 0; d < NDB; ++d)
#pragma unroll
      for (int i = 0; i < 16; ++i) sm += O[d][i];
    sm = x32_sum(sm);
    const float mu = sm * (1.f / DV);
    float ss = 0.f;
#pragma unroll
    for (int d = 0; d < NDB; ++d)
#pragma unroll
      for (int i = 0; i < 16; ++i) { const float o = O[d][i] - mu; O[d][i] = o; ss += o * o; }
    ss = x32_sum(ss);
    const float rstd = rsqrtf(ss * (1.f / DV) + EPSV);
#pragma unroll
    for (int d = 0; d < NDB; ++d)
#pragma unroll
      for (int i4 = 0; i4 < 4; ++i4) {
        const int dv0 = 32 * d + 8 * i4 + 4 * g;
        const f32x4 wv = *(const f32x4*)(a.nw + dv0);
        const u32x2 gq = *(const u32x2*)(a.rg + (size_t)qloc * a.rg_ld + dv0);
        const float gg[4] = {bflo(gq[0]), bfhi(gq[0]), bflo(gq[1]), bfhi(gq[1])};
#pragma unroll
        for (int e = 0; e < 4; ++e) O[d][4 * i4 + e] *= rstd * wv[e] * (gg[e] * sigmoidf_(gg[e]));
      }
  }
#pragma unroll
  for (int d = 0; d < NDB; ++d)
#pragma unroll
    for (int i4 = 0; i4 < 4; ++i4) {
      u32x2 t = {pack2(O[d][4 * i4], O[d][4 * i4 + 1]), pack2(O[d][4 * i4 + 2], O[d][4 * i4 + 3])};
      *(u32x2*)(a.y + (size_t)qloc * a.y_ld + 32 * d + 8 * i4 + 4 * g) = t;
    }
}

DI void ret_state_job(char* smem, const bf16_t* kp, const bf16_t* vp, int ld, float lg, int dir, float* outp) {
  float* kw = (float*)smem;
  const int tid = ltid();
  __syncthreads();
  for (int idx = tid; idx < 256 * 8; idx += NTHR) {
    const int j = idx >> 3, c = idx & 7;
    const u32x4 t = *(const u32x4*)(kp + (size_t)j * ld + 8 * c);
    const float wj = exp2f((float)(dir ? j : 255 - j) * lg) * 0.125f;
#pragma unroll
    for (int e = 0; e < 4; ++e) { kw[j * 64 + 8 * c + 2 * e] = bflo(t[e]) * wj; kw[j * 64 + 8 * c + 2 * e + 1] = bfhi(t[e]) * wj; }
  }
  __syncthreads();
  const int dv = tid & 127, dkh = tid >> 7;
  float acc[32];
#pragma unroll
  for (int e = 0; e < 32; ++e) acc[e] = 0.f;
#pragma unroll 2
  for (int j = 0; j < 256; ++j) {
    const float vj = bf2f(vp[(size_t)j * ld + dv]);
#pragma unroll
    for (int e4 = 0; e4 < 8; ++e4) {
      const f32x4 kk = *(const f32x4*)(kw + j * 64 + 32 * dkh + 4 * e4);
#pragma unroll
      for (int e = 0; e < 4; ++e) acc[4 * e4 + e] += kk[e] * vj;
    }
  }
#pragma unroll
  for (int e = 0; e < 32; ++e) outp[(32 * dkh + e) * 128 + dv] = acc[e];
}

DI float log2_sigmoid(float x) { return -log1pf(__expf(-x)) * LOG2E; }

#ifndef AM
#define AM 0xFFu
#endif
#define AEN(k) ((AM >> (k)) & 1u)
DI void attention_phase(KP& p, int l, char* smem) {
  char* ws = p.ws;
  bf16_t* pq = (bf16_t*)(ws + OFF_PQ);
  bf16_t* Y = (bf16_t*)(ws + OFF_Y);
  const float lam_init = 0.8f - 0.6f * expf(-0.3f * (float)l);
  float lam;
  {
    const float* lp = p.diff_lambda + l * 256;
    float s1 = 0.f, s2 = 0.f;
    for (int i = 0; i < 64; ++i) { s1 += lp[i] * lp[64 + i]; s2 += lp[128 + i] * lp[192 + i]; }
    lam = expf(s1) - expf(s2) + lam_init;
  }
  const int G = VG();
  auto init = [&](AttnArgs& a) {
    a.R0 = 0; a.bias = nullptr; a.t0 = 0; a.T = 0; a.lgf = 0.f; a.lgb = 0.f; a.s0f = nullptr; a.s0b = nullptr; a.rg = nullptr; a.rg_ld = 0; a.nw = nullptr;
    a.lam = lam; a.omli = 1.f - lam_init; a.q_ld = PQW; a.y_ld = DM;
  };
  int rot = 0;
  auto first = [&](int n) { int f = VB() - rot; if (f < 0) f += G; rot = (rot + n) % G; return f; };
  if (AEN(3)) for (int it = first(512); it < 512; it += G) {
    AttnArgs a; init(a);
    const int b = it >> 6, h = (it >> 4) & 3, qb = it & 15;
    const size_t row = NCTX + (size_t)b * 2048 + qb * 128;
    a.q = pq + row * PQW + 768 + h * 128; a.k = (bf16_t*)(ws + OFF_KDL) + (size_t)b * SLAT * 512 + h * 128; a.k_ld = 512;
    a.v = (bf16_t*)(ws + OFF_VDL) + (size_t)b * SLAT * 512 + h * 128; a.v_ld = 512; a.n_keys = SLAT; a.sl2 = 0.125f * LOG2E;
    a.y = Y + row * DM + 512 + h * 128; a.nw = p.diff_norm + l * 512 + h * 128;
    attn_block<64, 128, 3>(smem, a);
  }
  if (AEN(0)) for (int i = first(1024); i < 1024; i += G) {
    AttnArgs a; init(a);
    const int b = i >> 7, h = (i >> 4) & 7, qb = i & 15;
    const size_t row = NCTX + (size_t)b * 2048 + qb * 128;
    a.q = pq + row * PQW + h * 96; a.k = (bf16_t*)(ws + OFF_KML) + (size_t)b * SLAT * 768 + h * 96; a.k_ld = 768;
    a.v = (bf16_t*)(ws + OFF_VML) + (size_t)b * SLAT * 512 + h * 64; a.v_ld = 512; a.n_keys = SLAT; a.sl2 = 0.10206207261596577f * LOG2E;
    a.y = Y + row * DM + h * 64;
    attn_block<96, 64, 0>(smem, a);
  }
  if (AEN(2)) for (int i = first(512); i < 512; i += G) {
    AttnArgs a; init(a);
    const int b = i >> 6, h = (i >> 4) & 3, qb = i & 15;
    const size_t row0 = NCTX + (size_t)b * 2048, row = row0 + qb * 128;
    a.q = pq + row * PQW + 1792 + h * 64; a.k = pq + row0 * PQW + 2048 + h * 64; a.k_ld = PQW; a.v = pq + row0 * PQW + 2304 + h * 128; a.v_ld = PQW;
    a.n_keys = 2048; a.sl2 = 0.125f; a.y = Y + row * DM + 1536 + h * 128; a.t0 = qb * 128; a.T = 2048;
    a.lgf = log2_sigmoid(p.ret_decay[l * 8 + h]); a.lgb = log2_sigmoid(p.ret_decay[l * 8 + 4 + h]);
    a.s0f = p.st_ret + ((size_t)((b * 2 + l) * 2 + 0) * 4 + h) * 8192; a.s0b = p.st_ret + ((size_t)((b * 2 + l) * 2 + 1) * 4 + h) * 8192;
    a.rg = pq + row * PQW + 2816 + h * 128; a.rg_ld = PQW; a.nw = p.ret_norm + l * 512 + h * 128;
    attn_block<64, 128, 2>(smem, a);
  }
  if (AEN(1)) for (int i = first(1024); i < 1024; i += G) {
    AttnArgs a; init(a);
    const int b = i >> 7, h = (i >> 4) & 7, qb = i & 15;
    const size_t row = NCTX + (size_t)b * 2048 + qb * 128;
    a.q = pq + row * PQW + 1280 + h * 64; a.k = (bf16_t*)(ws + OFF_KNL) + (size_t)b * SLAT * 512 + h * 64; a.k_ld = 512;
    a.v = (bf16_t*)(ws + OFF_VNL) + (size_t)b * SLAT * 512 + h * 64; a.v_ld = 512; a.n_keys = SLAT; a.sl2 = 0.125f * LOG2E;
    a.y = Y + row * DM + 1024 + h * 64; a.R0 = 2 * qb; a.bias = p.na_bias + (size_t)(l * 8 + h) * 465;
    attn_block<64, 64, 1>(smem, a);
  }
  if (AEN(3)) for (int i = first(256); i < 256; i += G) {
    AttnArgs a; init(a);
    const int b = i >> 3, h = (i >> 1) & 3, qb = i & 1;
    const size_t row0 = (size_t)b * 256, row = row0 + qb * 128;
    a.q = pq + row * PQW + 768 + h * 128; a.k = (bf16_t*)(ws + OFF_KDC) + row0 * 512 + h * 128; a.k_ld = 512;
    a.v = (bf16_t*)(ws + OFF_VDC) + row0 * 512 + h * 128; a.v_ld = 512; a.n_keys = 256; a.sl2 = 0.125f * LOG2E;
    a.y = Y + row * DM + 512 + h * 128; a.nw = p.diff_norm + l * 512 + h * 128;
    attn_block<64, 128, 3>(smem, a);
  }
  if (AEN(0)) for (int i = first(512); i < 512; i += G) {
    AttnArgs a; init(a);
    const int b = i >> 4, h = (i >> 1) & 7, qb = i & 1;
    const size_t row0 = (size_t)b * 256, row = row0 + qb * 128;
    a.q = pq + row * PQW + h * 96; a.k = (bf16_t*)(ws + OFF_KMC) + row0 * 768 + h * 96; a.k_ld = 768;
    a.v = (bf16_t*)(ws + OFF_VMC) + row0 * 512 + h * 64; a.v_ld = 512; a.n_keys = 256; a.sl2 = 0.10206207261596577f * LOG2E;
    a.y = Y + row * DM + h * 64;
    attn_block<96, 64, 0>(smem, a);
  }
  if (AEN(4)) for (int i = first(512); i < 512; i += G) {
    AttnArgs a; init(a);
    const int b = i >> 4, h = (i >> 1) & 7, qb = i & 1;
    const size_t row0 = (size_t)b * 256, row = row0 + qb * 128;
    a.q = pq + row * PQW + 1280 + h * 64; a.k = (bf16_t*)(ws + OFF_KNC) + row0 * 512 + h * 64; a.k_ld = 512;
    a.v = (bf16_t*)(ws + OFF_VNC) + row0 * 512 + h * 64; a.v_ld = 512; a.n_keys = 256; a.sl2 = 0.125f * LOG2E;
    a.y = Y + row * DM + 1024 + h * 64;
    attn_block<64, 64, 0>(smem, a);
  }
  if (AEN(2)) for (int i = first(256); i < 256; i += G) {
    AttnArgs a; init(a);
    const int b = i >> 3, h = (i >> 1) & 3, qb = i & 1;
    const size_t row0 = (size_t)b * 256, row = row0 + qb * 128;
    a.q = pq + row * PQW + 1792 + h * 64; a.k = pq + row0 * PQW + 2048 + h * 64; a.k_ld = PQW; a.v = pq + row0 * PQW + 2304 + h * 128; a.v_ld = PQW;
    a.n_keys = 256; a.sl2 = 0.125f; a.y = Y + row * DM + 1536 + h * 128; a.t0 = qb * 128; a.T = 256;
    a.lgf = log2_sigmoid(p.ret_decay[l * 8 + h]); a.lgb = log2_sigmoid(p.ret_decay[l * 8 + 4 + h]);
    a.rg = pq + row * PQW + 2816 + h * 128; a.rg_ld = PQW; a.nw = p.ret_norm + l * 512 + h * 128;
    attn_block<64, 128, 2>(smem, a);
  }
  if (AEN(5)) for (int i = first(256); i < 256; i += G) {
    const int b = i >> 3, h = (i >> 1) & 3, dir = i & 1;
    const size_t row0 = (size_t)b * 256;
    const float lg = log2_sigmoid(p.ret_decay[l * 8 + dir * 4 + h]);
    ret_state_job(smem, pq + row0 * PQW + 2048 + h * 64, pq + row0 * PQW + 2304 + h * 128, PQW, lg, dir,
                  p.out + OO_RET + ((size_t)((b * 2 + l) * 2 + dir) * 4 + h) * 8192);
  }
}

DI void convT_unit(char* smem, const float* src, int ld, int srccol, int k0, bf16_t* dst  , int K) {
  float* T = (float*)smem;
  const int tid = ltid();
  __syncthreads();
  {
    const int n4 = tid & 7, kr = tid >> 3;
#pragma unroll
    for (int i = 0; i < 8; ++i) {
      const int k = kr + 32 * i;
      f32x4 v = {0.f, 0.f, 0.f, 0.f};
      if (srccol >= 0) v = *(const f32x4*)(src + (size_t)(k0 + k) * ld + srccol + 4 * n4);
      T[k * 33 + 4 * n4] = v[0]; T[k * 33 + 4 * n4 + 1] = v[1]; T[k * 33 + 4 * n4 + 2] = v[2]; T[k * 33 + 4 * n4 + 3] = v[3];
    }
  }
  __syncthreads();
  {
    const int k2 = tid & 127, nh = tid >> 7;
#pragma unroll
    for (int i = 0; i < 16; ++i) {
      const int n = nh + 2 * i;
      *(unsigned*)(dst + (size_t)n * K + 2 * k2) = pack2(T[(2 * k2) * 33 + n], T[(2 * k2 + 1) * 33 + n]);
    }
  }
}

DI void prep_phase(KP& p, char* smem) {
  constexpr int NADA = 2 * 16 * 12;
  constexpr int U_IN = 440 * 8, U_BR = 512, U_O = 512, U_UP = 352 * 8, U_DN = 64 * 22, U_UKV = 32, U_L = U_IN + U_BR + U_O + U_UP + U_DN + U_UKV;
  const int tid = ltid();
  const int n_units = NADA + 2 * U_L, trips = (n_units + VG() - 1) / VG();
  for (int tr = 0; tr < trips; ++tr) {
    const int u = VB() + tr * VG();
    if (u >= n_units) { __syncthreads(); __syncthreads(); continue; }
    if (u < NADA) {
      const int l = u / 192, kc = (u % 192) / 12, nc = u % 12;
      float* cs = (float*)smem;
      __syncthreads();
      for (int i = tid; i < 9 * 128; i += NTHR) {
        const int g = i >> 7, k = kc * 128 + (i & 127);
        const float cv = g == 0 ? p.c_ctx[k] : p.c[(g - 1) * DM + k];
        cs[i] = cv * sigmoidf_(cv);
      }
      __syncthreads();
      f32x4 acc[9];
#pragma unroll
      for (int g = 0; g < 9; ++g) acc[g] = (f32x4){0.f, 0.f, 0.f, 0.f};
      const float* wp = p.w_ada + ((size_t)l * DM + kc * 128) * 12288 + nc * 1024 + 4 * tid;
#pragma unroll 4
      for (int k = 0; k < 128; ++k) {
        const f32x4 wv = *(const f32x4*)(wp + (size_t)k * 12288);
#pragma unroll
        for (int g = 0; g < 9; ++g) { const float s = cs[g * 128 + k]; acc[g] += wv * s; }
      }
      float* pp = (float*)(p.ws + OFF_MODP) + ((size_t)(kc * 2 + l) * 9) * 12288 + nc * 1024 + 4 * tid;
#pragma unroll
      for (int g = 0; g < 9; ++g) *(f32x4*)(pp + (size_t)g * 12288) = acc[g];
    } else {
      const int uu = u - NADA, l = uu / U_L;
      int r = uu % U_L;
      char* wl = p.ws + l * SZ_WL;
      if (r < U_IN) {
        const int cn = r >> 3, kt = r & 7, n = cn * 32;
        int sc;
        if (n < 1024) sc = n; else if (n < 5632) sc = n + 32; else if (n < 5664) sc = n - 5632 + 1024; else if (n < NPROJ) sc = -1; else sc = n - 224;
        convT_unit(smem, p.w_in + (size_t)l * DM * 13856, 13856, sc, kt * 256, (bf16_t*)(wl + WO_IN) + (size_t)n * 2048 + kt * 256, 2048);
      } else if ((r -= U_IN) < U_BR) {
        const int cn = r >> 1, kt = r & 1, i = cn >> 6, n = (cn & 63) * 32;
        convT_unit(smem, p.w_branch + ((size_t)(l * 4 + i) * 512) * 2048, 2048, n, kt * 256, (bf16_t*)(wl + WO_BR) + ((size_t)i * 2048 + n) * 512 + kt * 256, 512);
      } else if ((r -= U_BR) < U_O) {
        const int cn = r >> 3, kt = r & 7, n = cn * 32;
        convT_unit(smem, p.w_o + (size_t)l * DM * DM, 2048, n, kt * 256, (bf16_t*)(wl + WO_O) + (size_t)n * 2048 + kt * 256, 2048);
      } else if ((r -= U_O) < U_UP) {
        const int cn = r >> 3, kt = r & 7, n = cn * 32, J = n >> 7, w = n & 127, chn = 64 * J + (w & 63), sc = (w < 64) ? chn : FF + chn;
        convT_unit(smem, p.w_up + (size_t)l * DM * 11264, 11264, sc, kt * 256, (bf16_t*)(wl + WO_UP) + (size_t)n * 2048 + kt * 256, 2048);
      } else if ((r -= U_UP) < U_DN) {
        const int cn = r / 22, kt = r % 22, n = cn * 32;
        convT_unit(smem, p.w_down + (size_t)l * FF * DM, 2048, n, kt * 256, (bf16_t*)(wl + WO_DN) + (size_t)n * FF + kt * 256, FF);
      } else {
        r -= U_DN;
        const int n = r * 32;
        convT_unit(smem, p.w_ukv + (size_t)l * 256 * 1024, 1024, n, 0, (bf16_t*)(wl + WO_UKV) + (size_t)n * 256, 256);
      }
    }
  }
}

DI void ada_reduce_phase(KP& p) {
  const float* pp = (const float*)(p.ws + OFF_MODP);
  float* mod = (float*)(p.ws + OFF_MOD);
  constexpr int NE = 2 * 9 * 12288;
  for (int e = VB() * NTHR + ltid(); e < NE; e += VG() * NTHR) {
    const int l = e / (9 * 12288), n = e % 12288;
    float s = p.b_ada[l * 12288 + n];
    for (int kc = 0; kc < 16; ++kc) s += pp[(size_t)kc * NE + e];
    mod[e] = s;
  }
}

DI void modulate_phase(KP& p, int l, int which  , bool x_from_input) {
  const int vt_ = ltid(), lane = vt_ & 63, wv = vt_ >> 6;
  const float* gvec = (which ? p.g_ffn : p.g_attn) + l * DM;
  const float* mod = (const float*)(p.ws + OFF_MOD) + (size_t)l * 9 * 12288;
  bf16_t* h = (bf16_t*)(p.ws + OFF_H);
  const int nwv = VG() * 4, per = (NTOK + nwv - 1) / nwv, r0 = (VB() * 4 + wv) * per, r1 = min(r0 + per, NTOK);
  f32x4 av[8], bv[8], xn[8];
  int curg = -1;
  auto ldrow = [&](int r) {
    const float* xr = x_from_input ? xrow_in(p, r) : p.out + (size_t)r * DM;
#pragma unroll
    for (int i = 0; i < 8; ++i) xn[i] = *(const f32x4*)(xr + 4 * (lane + 64 * i));
  };
  if (r0 < r1) ldrow(r0);
  for (int r = r0; r < r1; ++r) {
    f32x4 xv[8];
    float ss = 0.f;
#pragma unroll
    for (int i = 0; i < 8; ++i) { xv[i] = xn[i]; ss += xv[i][0] * xv[i][0] + xv[i][1] * xv[i][1] + xv[i][2] * xv[i][2] + xv[i][3] * xv[i][3]; }
    if (r + 1 < r1) ldrow(r + 1);
    const int g = grp_of(r);
    if (g != curg) {
      curg = g;
      const float* sh = mod + (size_t)g * 12288 + (which ? 3 : 0) * DM;
      const float* sc = sh + DM;
#pragma unroll
      for (int i = 0; i < 8; ++i) {
        const int c = 4 * (lane + 64 * i);
        const f32x4 gv = *(const f32x4*)(gvec + c), sv = *(const f32x4*)(sc + c);
        bv[i] = *(const f32x4*)(sh + c);
#pragma unroll
        for (int e = 0; e < 4; ++e) av[i][e] = gv[e] * (1.f + sv[e]);
      }
    }
    ss = wave_sum(ss);
    const float rstd = rsqrtf(ss * (1.f / DM) + EPSV);
#pragma unroll
    for (int i = 0; i < 8; ++i) {
      const int c = 4 * (lane + 64 * i);
      float o[4];
#pragma unroll
      for (int e = 0; e < 4; ++e) o[e] = xv[i][e] * rstd * av[i][e] + bv[i][e];
      u32x2 t = {pack2(o[0], o[1]), pack2(o[2], o[3])};
      *(u32x2*)(h + (size_t)r * DM + c) = t;
    }
  }
}

DI void cache_prep(KP& p, int l) {
  char* ws = p.ws;
  const int total = 4096 * 292;
  for (int u = VB() * NTHR + ltid(); u < total; u += VG() * NTHR) {
    const int cr = u / 292, w = u % 292, b = cr >> 9, j = cr & 511;
    const size_t srow = (size_t)(b * 2 + l) * 512 + j;
    const size_t drow = (size_t)b * SLAT + 2048 + j;
    const float* src; bf16_t* dst; bool rep = false;
    if (w < 32) { src = p.c_ckv + srow * 256 + 8 * w; dst = (bf16_t*)(ws + OFF_CKVA) + ((size_t)NTOK + cr) * 256 + 8 * w; }
    else if (w < 36) { src = p.c_kr + srow * 32 + 8 * (w - 32); dst = (bf16_t*)(ws + OFF_KML) + drow * 768 + 64 + 8 * (w - 32); rep = true; }
    else {
      const int ww = w - 36, which = ww >> 6, c = 8 * (ww & 63);
      const float* sb = which == 0 ? p.c_dk : which == 1 ? p.c_dv : which == 2 ? p.c_nk : p.c_nv;
      const size_t off = which == 0 ? OFF_KDL : which == 1 ? OFF_VDL : which == 2 ? OFF_KNL : OFF_VNL;
      src = sb + srow * 512 + c; dst = (bf16_t*)(ws + off) + drow * 512 + c;
    }
    const f32x4 a = *(const f32x4*)src, bq = *(const f32x4*)(src + 4);
    u32x4 t = {pack2(a[0], a[1]), pack2(a[2], a[3]), pack2(bq[0], bq[1]), pack2(bq[2], bq[3])};
    if (rep) { for (int h = 0; h < 8; ++h) *(u32x4*)(dst + h * 96) = t; }
    else *(u32x4*)dst = t;
  }
}

DI void ckv_phase(KP& p, int l) {
  const int vt_ = ltid(), lane = vt_ & 63, wv = vt_ >> 6;
  const float* mck = (const float*)(p.ws + OFF_MCKV);
  bf16_t* ca = (bf16_t*)(p.ws + OFF_CKVA);
  const f32x4 wn = *(const f32x4*)(p.kv_norm + l * 256 + 4 * lane);
  for (int r = VB() * 4 + wv; r < NTOK; r += VG() * 4) {
    const f32x4 v = *(const f32x4*)(mck + (size_t)r * 256 + 4 * lane);
    float ss = wave_sum(v[0] * v[0] + v[1] * v[1] + v[2] * v[2] + v[3] * v[3]);
    const float rstd = rsqrtf(ss * (1.f / 256.f) + EPSV);
    f32x4 o = {v[0] * rstd * wn[0], v[1] * rstd * wn[1], v[2] * rstd * wn[2], v[3] * rstd * wn[3]};
    u32x2 t = {pack2(o[0], o[1]), pack2(o[2], o[3])};
    *(u32x2*)(ca + (size_t)r * 256 + 4 * lane) = t;
    if (r < NCTX) { const int b = r >> 8, tt = r & 255; *(f32x4*)(p.out + OO_CKV + ((size_t)((b * 2 + l) * 256 + tt)) * 256 + 4 * lane) = o; }
  }
}

DI void merge_phase(KP& p, int l, char* smem) {
  char* wl = p.ws + l * SZ_WL;
  const bf16_t* h = (const bf16_t*)(p.ws + OFF_H);
  const bf16_t* Y = (const bf16_t*)(p.ws + OFF_Y);
  const bf16_t* wg = (const bf16_t*)(wl + WO_IN) + (size_t)NPROJ * 2048;
  const bf16_t* wb = (const bf16_t*)(wl + WO_BR);
  StoreBf16Epi epi{(bf16_t*)(p.ws + OFF_M), DM, 0};
  constexpr int nM = 96, nN = 16;
  for (int it = 0;; ++it) {
    int pm, pn;
    if (!tile_map(rtile_slot(it), nM, nN, 8, pm, pn)) break;
    f32x4 tot[8][2];
#pragma unroll
    for (int mi = 0; mi < 8; ++mi)
#pragma unroll
      for (int ni = 0; ni < 2; ++ni) tot[mi][ni] = (f32x4){0.f, 0.f, 0.f, 0.f};
 u32x4 ra[4], rb[2];
#pragma unroll 1
    for (int i = 0; i < 4; ++i) {
      const bf16_t* Ag = h + (size_t)pm * 256 * DM; const bf16_t* Bg = wg + ((size_t)i * 2048 + pn * 128) * 2048;
      const bf16_t* Ab = Y + (size_t)pm * 256 * DM + 512 * i; const bf16_t* Bb = wb + ((size_t)i * 2048 + pn * 128) * 512;
      const bf16_t* Bg2 = wg + ((size_t)(i < 3 ? i + 1 : i) * 2048 + pn * 128) * 2048;
      unsigned gp[4][2][2];
      char* park = smem + 114688 + rtid() * 64;
      {
        f32x4 ga[8][2];
#pragma unroll
        for (int mi = 0; mi < 8; ++mi)
#pragma unroll
          for (int ni = 0; ni < 2; ++ni) ga[mi][ni] = (f32x4){0.f, 0.f, 0.f, 0.f};
        gemm256_kloop<2>(ga, ra, rb, Ag, DM, Bg, 2048, 2048, Ab, DM, Bb, 512, i > 0, smem);
#pragma unroll
        for (int mi = 0; mi < 8; ++mi)
#pragma unroll
          for (int ni = 0; ni < 2; ++ni) {
            const unsigned g0 = pack2(sigmoidf_(ga[mi][ni][0]), sigmoidf_(ga[mi][ni][1]));
            const unsigned g1 = pack2(sigmoidf_(ga[mi][ni][2]), sigmoidf_(ga[mi][ni][3]));
            if (mi < 4) { u32x2 t = {g0, g1}; *(u32x2*)(park + (mi * 2 + ni) * 8) = t; }
            else { gp[mi - 4][ni][0] = g0; gp[mi - 4][ni][1] = g1; }
          }
      }
      f32x4 ba[8][2];
#pragma unroll
      for (int mi = 0; mi < 8; ++mi)
#pragma unroll
        for (int ni = 0; ni < 2; ++ni) ba[mi][ni] = (f32x4){0.f, 0.f, 0.f, 0.f};
      gemm256_kloop<2>(ba, ra, rb, Ab, DM, Bb, 512, 512, Ag, DM, Bg2, 2048, true, smem);
#pragma unroll
      for (int mi = 0; mi < 8; ++mi)
#pragma unroll
        for (int ni = 0; ni < 2; ++ni) {
          unsigned g0, g1;
          if (mi < 4) { const u32x2 t = *(const u32x2*)(park + (mi * 2 + ni) * 8); g0 = t[0]; g1 = t[1]; }
          else { g0 = gp[mi - 4][ni][0]; g1 = gp[mi - 4][ni][1]; }
          tot[mi][ni][0] += bflo(g0) * ba[mi][ni][0]; tot[mi][ni][1] += bfhi(g0) * ba[mi][ni][1];
          tot[mi][ni][2] += bflo(g1) * ba[mi][ni][2]; tot[mi][ni][3] += bfhi(g1) * ba[mi][ni][3];
        }
    }
    gemm256_epilogue<2>(tot, smem, pm * 256, pn * 128, epi);
  }
}

struct ConvW { float wa[3][8], wb[3][8], ba[8], bb[8]; };
DI void load_convw(ConvW& c, const float* cw, const float* cb, int chn) {
#pragma unroll
  for (int j = 0; j < 3; ++j)
#pragma unroll
    for (int e4 = 0; e4 < 2; ++e4) {
      const f32x4 x = *(const f32x4*)(cw + j * 11264 + chn + 4 * e4), y = *(const f32x4*)(cw + j * 11264 + FF + chn + 4 * e4);
#pragma unroll
      for (int e = 0; e < 4; ++e) { c.wa[j][4 * e4 + e] = x[e]; c.wb[j][4 * e4 + e] = y[e]; }
    }
#pragma unroll
  for (int e4 = 0; e4 < 2; ++e4) {
    const f32x4 x = *(const f32x4*)(cb + chn + 4 * e4), y = *(const f32x4*)(cb + FF + chn + 4 * e4);
#pragma unroll
    for (int e = 0; e < 4; ++e) { c.ba[4 * e4 + e] = x[e]; c.bb[4 * e4 + e] = y[e]; }
  }
}
DI void unpack8(const u32x4& v, float (&x)[8]) {
#pragma unroll
  for (int e = 0; e < 4; ++e) { x[2 * e] = bflo(v[e]); x[2 * e + 1] = bfhi(v[e]); }
}
DI u32x4 conv_out(const ConvW& c, const float (&pa)[8], const float (&pb)[8], const float (&ca)[8], const float (&cb_)[8],
                  const float (&na)[8], const float (&nb)[8]) {
  u32x4 o;
#pragma unroll
  for (int e = 0; e < 4; ++e) {
    float s[2];
#pragma unroll
    for (int q = 0; q < 2; ++q) {
      const int k = 2 * e + q;
      const float sa = c.ba[k] + c.wa[0][k] * pa[k] + c.wa[1][k] * ca[k] + c.wa[2][k] * na[k];
      const float sb = c.bb[k] + c.wb[0][k] * pb[k] + c.wb[1][k] * cb_[k] + c.wb[2][k] * nb[k];
      s[q] = sa * sigmoidf_(sa) * sb;
    }
    o[e] = pack2(s[0], s[1]);
  }
  return o;
}

constexpr size_t OFF_HALO = OFF_ACT + SZ_ACT;
static_assert(OFF_HALO + (size_t)96 * 4 * 11264 * 2 <= OFF_KVEND, "halo alias");

DI void up_phase(KP& p, int l, char* smem) {
  char* wl = p.ws + l * SZ_WL;
  const bf16_t* h = (const bf16_t*)(p.ws + OFF_H);
  const bf16_t* W = (const bf16_t*)(wl + WO_UP);
  bf16_t* act = (bf16_t*)(p.ws + OFF_ACT);
  bf16_t* halo = (bf16_t*)(p.ws + OFF_HALO);
  const float* cw = p.conv_w + (size_t)l * 3 * 11264;
  const float* cb = p.conv_b + (size_t)l * 11264;
  constexpr int CSB = 528;
  for (int it = 0;; ++it) {
    int pm, pn;
    if (!tile_map(rtile_slot(it), 96, 44, 8, pm, pn)) break;
    {
      f32x4 acc[8][4];
#pragma unroll
      for (int mi = 0; mi < 8; ++mi)
#pragma unroll
        for (int ni = 0; ni < 4; ++ni) acc[mi][ni] = (f32x4){0.f, 0.f, 0.f, 0.f};
      u32x4 ra[4], rb[4];
      const bf16_t* At = h + (size_t)pm * 256 * DM; const bf16_t* Bt = W + (size_t)pn * 256 * 2048;
      gemm256_kloop<4>(acc, ra, rb, At, DM, Bt, 2048, 2048, At, DM, Bt, 2048, false, smem);
      const int tid = rtid(), wid = tid >> 6, lane = tid & 63, wr = wid >> 2, wc = wid & 3, fr = lane & 15, fq = lane >> 4;
#pragma unroll
      for (int mi = 0; mi < 8; ++mi)
#pragma unroll
        for (int ni = 0; ni < 4; ++ni) {
          u32x2 t = {pack2(acc[mi][ni][0], acc[mi][ni][1]), pack2(acc[mi][ni][2], acc[mi][ni][3])};
          *(u32x2*)(smem + (128 * wr + 16 * mi + fr) * CSB + (64 * wc + 16 * ni + 4 * fq) * 2) = t;
        }
    }
    __syncthreads();
    const int tid = rtid();
    const bool top_edge = (pm < 32) || (((pm - 32) & 7) == 0), bot_edge = (pm < 32) || (((pm - 32) & 7) == 7);
    if (tid < 128) {
      const int hr = tid >> 5, c16 = tid & 31, row = hr < 2 ? hr : 252 + hr;
      *(u32x4*)(halo + ((size_t)(pm * 4 + hr)) * 11264 + pn * 256 + c16 * 8) = *(const u32x4*)(smem + row * CSB + c16 * 16);
    }
    {
      const int cu = tid & 15, rb = tid >> 4, g2 = cu >> 3, c8 = (cu & 7) * 8;
      const int chn = 64 * (2 * pn + g2) + c8;
      ConvW c; load_convw(c, cw, cb, chn);
      const char* col = smem + (128 * g2 + c8) * 2;
      float pa[8], pb[8], ca[8], cb_[8], na[8], nb[8];
      auto ldrow = [&](int r, float (&xa)[8], float (&xb)[8]) {
        if (r < 0 || r > 255) {
#pragma unroll
          for (int e = 0; e < 8; ++e) { xa[e] = 0.f; xb[e] = 0.f; }
        } else {
          unpack8(*(const u32x4*)(col + r * CSB), xa);
          unpack8(*(const u32x4*)(col + r * CSB + 128), xb);
        }
      };
      const int r0 = rb * 8;
      ldrow(r0 - 1, pa, pb);
      ldrow(r0, ca, cb_);
#pragma unroll
      for (int i = 0; i < 8; ++i) {
        const int r = r0 + i;
        ldrow(r + 1, na, nb);
        const bool defer = (r == 0 && !top_edge) || (r == 255 && !bot_edge);
        if (!defer) *(u32x4*)(act + ((size_t)pm * 256 + r) * FF + chn) = conv_out(c, pa, pb, ca, cb_, na, nb);
#pragma unroll
        for (int e = 0; e < 8; ++e) { pa[e] = ca[e]; pb[e] = cb_[e]; ca[e] = na[e]; cb_[e] = nb[e]; }
      }
    }
    __syncthreads();
  }
}

DI void fixup_phase(KP& p, int l) {
  const bf16_t* halo = (const bf16_t*)(p.ws + OFF_HALO);
  bf16_t* act = (bf16_t*)(p.ws + OFF_ACT);
  const float* cw = p.conv_w + (size_t)l * 3 * 11264;
  const float* cb = p.conv_b + (size_t)l * 11264;
  const int total = 56 * 2 * 704;
  for (int u = VB() * NTHR + ltid(); u < total; u += VG() * NTHR) {
    const int cu = u % 704, br = u / 704, which = br & 1, bd = br >> 1, seq = bd / 7, ti = bd % 7;
    const int pm = 32 + seq * 8 + ti;
    const int chn = cu * 8, g = chn >> 6, c = chn & 63;
    ConvW cwv; load_convw(cwv, cw, cb, chn);
    const bf16_t* rp = halo + ((size_t)(pm * 4 + (which ? 3 : 2))) * 11264 + 128 * g + c;
    const bf16_t* rc = halo + ((size_t)(which ? (pm + 1) * 4 + 0 : pm * 4 + 3)) * 11264 + 128 * g + c;
    const bf16_t* rn = halo + ((size_t)((pm + 1) * 4 + (which ? 1 : 0))) * 11264 + 128 * g + c;
    float pa[8], pb[8], ca[8], cb_[8], na[8], nb[8];
    unpack8(*(const u32x4*)rp, pa); unpack8(*(const u32x4*)(rp + 64), pb);
    unpack8(*(const u32x4*)rc, ca); unpack8(*(const u32x4*)(rc + 64), cb_);
    unpack8(*(const u32x4*)rn, na); unpack8(*(const u32x4*)(rn + 64), nb);
    const size_t row = which ? (size_t)(pm + 1) * 256 : (size_t)pm * 256 + 255;
    *(u32x4*)(act + row * FF + chn) = conv_out(cwv, pa, pb, ca, cb_, na, nb);
  }
}

DI void conv_phase(KP& p, int l, int g0, int ng) {
  const bf16_t* U = (const bf16_t*)(p.ws + OFF_U);
  bf16_t* act = (bf16_t*)(p.ws + OFF_ACT);
  const float* cw = p.conv_w + (size_t)l * 3 * 11264;
  const float* cb = p.conv_b + (size_t)l * 11264;
  const int upr = ng * 8, uw = ng * 128;
  const int total = (NTOK / 8) * upr;
  for (int u = VB() * NTHR + ltid(); u < total; u += VG() * NTHR) {
    const int rb = u / upr, w = u % upr, J = w >> 3, c8 = (w & 7) * 8;
    const int chn = 64 * (g0 + J) + c8, r0 = rb * 8;
    int t0, T;
    if (r0 < NCTX) { t0 = r0 & 255; T = 256; } else { t0 = (r0 - NCTX) & 2047; T = 2048; }
    float wa[3][8], wb[3][8], ba[8], bb[8];
#pragma unroll
    for (int j = 0; j < 3; ++j)
#pragma unroll
      for (int e4 = 0; e4 < 2; ++e4) {
        const f32x4 x = *(const f32x4*)(cw + j * 11264 + chn + 4 * e4), y = *(const f32x4*)(cw + j * 11264 + FF + chn + 4 * e4);
#pragma unroll
        for (int e = 0; e < 4; ++e) { wa[j][4 * e4 + e] = x[e]; wb[j][4 * e4 + e] = y[e]; }
      }
#pragma unroll
    for (int e4 = 0; e4 < 2; ++e4) {
      const f32x4 x = *(const f32x4*)(cb + chn + 4 * e4), y = *(const f32x4*)(cb + FF + chn + 4 * e4);
#pragma unroll
      for (int e = 0; e < 4; ++e) { ba[4 * e4 + e] = x[e]; bb[4 * e4 + e] = y[e]; }
    }
    const bf16_t* ua = U + (size_t)r0 * uw + 128 * J + c8;
    float pa[8], pb[8], ca[8], cb_[8], na[8], nb[8];
    auto ldrow = [&](int i, float (&xa)[8], float (&xb)[8]) {
      const int tt = t0 + i;
      if (tt < 0 || tt >= T) {
#pragma unroll
        for (int e = 0; e < 8; ++e) { xa[e] = 0.f; xb[e] = 0.f; }
      } else {
        const u32x4 av = *(const u32x4*)(ua + (ptrdiff_t)i * uw), bv = *(const u32x4*)(ua + (ptrdiff_t)i * uw + 64);
#pragma unroll
        for (int e = 0; e < 4; ++e) { xa[2 * e] = bflo(av[e]); xa[2 * e + 1] = bfhi(av[e]); xb[2 * e] = bflo(bv[e]); xb[2 * e + 1] = bfhi(bv[e]); }
      }
    };
    ldrow(-1, pa, pb);
    ldrow(0, ca, cb_);
#pragma unroll
    for (int i = 0; i < 8; ++i) {
      ldrow(i + 1, na, nb);
      u32x4 o;
#pragma unroll
      for (int e = 0; e < 4; ++e) {
        float s[2];
#pragma unroll
        for (int q = 0; q < 2; ++q) {
          const int c = 2 * e + q;
          const float sa = ba[c] + wa[0][c] * pa[c] + wa[1][c] * ca[c] + wa[2][c] * na[c];
          const float sb = bb[c] + wb[0][c] * pb[c] + wb[1][c] * cb_[c] + wb[2][c] * nb[c];
          s[q] = sa * sigmoidf_(sa) * sb;
        }
        o[e] = pack2(s[0], s[1]);
      }
      *(u32x4*)(act + (size_t)(r0 + i) * FF + chn) = o;
#pragma unroll
      for (int e = 0; e < 8; ++e) { pa[e] = ca[e]; pb[e] = cb_[e]; ca[e] = na[e]; cb_[e] = nb[e]; }
    }
  }
}

DI void final_phase(KP& p) {
  const int vt_ = ltid(), lane = vt_ & 63, wv = vt_ >> 6;
  for (int r = VB() * 4 + wv; r < NTOK; r += VG() * 4) {
    float* xr = p.out + (size_t)r * DM;
    f32x4 xv[8];
    float ss = 0.f;
#pragma unroll
    for (int i = 0; i < 8; ++i) { xv[i] = *(const f32x4*)(xr + 4 * (lane + 64 * i)); ss += xv[i][0] * xv[i][0] + xv[i][1] * xv[i][1] + xv[i][2] * xv[i][2] + xv[i][3] * xv[i][3]; }
    ss = wave_sum(ss);
    const float rstd = rsqrtf(ss * (1.f / DM) + EPSV);
#pragma unroll
    for (int i = 0; i < 8; ++i) {
      const int c = 4 * (lane + 64 * i);
      const f32x4 gv = *(const f32x4*)(p.g_final + c);
      f32x4 o = {xv[i][0] * rstd * gv[0], xv[i][1] * rstd * gv[1], xv[i][2] * rstd * gv[2], xv[i][3] * rstd * gv[3]};
      *(f32x4*)(xr + c) = o;
    }
  }
}

constexpr int LSTEPS = 11, NSTEPS = 2 + 2 * LSTEPS + 1;

DI void run_step(KP& p, int step, char* smem) {
  char* ws = p.ws;
  asm volatile("" : "+s"(ws));
  char* gsm = smem + vgrp() * GRP_LDS;
  if (step == 0) { prep_phase(p, gsm); return; }
  if (step == 1) { ada_reduce_phase(p); return; }
  if (step == NSTEPS - 1) { final_phase(p); return; }
  const int l = (step - 2) / LSTEPS, s = (step - 2) % LSTEPS;
  char* wl = ws + l * SZ_WL;
  const float* mod = (const float*)(ws + OFF_MOD) + (size_t)l * 9 * 12288;
  const bf16_t* h = (const bf16_t*)(ws + OFF_H);
  switch (s) {
    case 0: modulate_phase(p, l, 0, l == 0); cache_prep(p, l); break;
    case 1: {
      ProjEpi e; e.ws = ws; e.out = p.out; e.l = l;
      gemm256_phase(h, DM, (const bf16_t*)(wl + WO_IN), 2048, 2048, 96, 23, 0, e, smem);
    } break;
    case 2: ckv_phase(p, l); break;
    case 3: {
      UkvEpi e{ws};
      gemm256_phase((const bf16_t*)(ws + OFF_CKVA), 256, (const bf16_t*)(wl + WO_UKV), 256, 256, 112, 4, 0, e, smem);
    } break;
    case 4: attention_phase(p, l, gsm); break;
    case 5: merge_phase(p, l, smem); break;
    case 6: {
      ResidEpi e{l == 0 ? p.x_prompt : p.out, l == 0 ? p.x_sample : p.out + (size_t)NCTX * DM, p.out, mod + 2 * DM};
      gemm256_phase((const bf16_t*)(ws + OFF_M), DM, (const bf16_t*)(wl + WO_O), 2048, 2048, 96, 8, 0, e, smem);
    } break;
    case 7: modulate_phase(p, l, 1, false); break;
    case 8: up_phase(p, l, smem); break;
    case 9: fixup_phase(p, l); break;
    case 10: {
      ResidEpi e{p.out, p.out + (size_t)NCTX * DM, p.out, mod + 5 * DM};
      gemm256_phase((const bf16_t*)(ws + OFF_ACT), FF, (const bf16_t*)(wl + WO_DN), FF, FF, 96, 8, 0, e, smem);
    } break;
  }
}

#define XB_TMO      128
#define XB_XCNT(j)  (256  + 64 * (j))
#define XB_XSUB(j)  (1280 + 64 * (j))
#define XB_XGEN(j)  (2304 + 64 * (j))
#define XB_TOP      3328
#define XB_TOPGEN   3392
#define XCD_BAR_WORDS 3456
#define XB_SPIN_CAP (1u << 18)
#define LAS __attribute__((address_space(3)))

__device__ __forceinline__ unsigned xb_ld(unsigned* p)              { return __hip_atomic_load(p, __ATOMIC_RELAXED, __HIP_MEMORY_SCOPE_AGENT); }
__device__ __forceinline__ unsigned xb_add(unsigned* p, unsigned v) { return __hip_atomic_fetch_add(p, v, __ATOMIC_RELAXED, __HIP_MEMORY_SCOPE_AGENT); }
__device__ __forceinline__ unsigned xb_xcc_id() { return (unsigned)__builtin_amdgcn_s_getreg((3 << 11) | 20) & 0xFu; }
#define XB_SPIN(cond, bar) do { unsigned _sp = 0; while (cond) { __builtin_amdgcn_s_sleep(1); \
    if ((++_sp & 255u) == 0u) { if (xb_ld(&(bar)[XB_TMO])) break; if (_sp > XB_SPIN_CAP) { atomicAdd(&(bar)[XB_TMO], 1u); break; } } } } while (0)

struct XcdBarrier {
    unsigned* bar; unsigned x;
    volatile LAS unsigned* st;
};

__device__ __forceinline__ XcdBarrier xcd_barrier_post(unsigned* bar, volatile LAS unsigned* st) {
    XcdBarrier b; b.bar = bar; b.x = xb_xcc_id(); b.st = st;
    if (threadIdx.x == 0) (void)xb_add(&bar[XB_XCNT(b.x)], 1u);
    return b;
}
__device__ __forceinline__ void xcd_barrier_complete(unsigned* bar, unsigned x, unsigned& nloc, unsigned& nx) {
    const unsigned G = gridDim.x * gridDim.y * gridDim.z;
    unsigned sum, cnt, mine, sp = 0u;
    for (;;) {
        sum = 0u; cnt = 0u; mine = 0u;
#pragma unroll
        for (unsigned j = 0; j < 16; ++j) { const unsigned c = xb_ld(&bar[XB_XCNT(j)]); sum += c; cnt += (c > 0u) ? 1u : 0u; mine = (j == x) ? c : mine; }
        if (sum == G) break;
        __builtin_amdgcn_s_sleep(1);
        if ((++sp & 255u) == 0u) { if (xb_ld(&bar[XB_TMO])) break; if (sp > XB_SPIN_CAP) { atomicAdd(&bar[XB_TMO], 1u); break; } }
    }
    nloc = mine > 0u ? mine : 1u; nx = cnt > 0u ? cnt : 1u;
}

__device__ __forceinline__ void xcd_barrier(const XcdBarrier& b) {
    asm volatile("s_waitcnt vmcnt(0)" ::: "memory");
    __syncthreads();
    if (threadIdx.x == 0) {
        unsigned* bar = b.bar;
        __builtin_amdgcn_s_waitcnt(0);
        unsigned nloc = b.st[0], nx = b.st[1];
        if (nloc == 0u) { xcd_barrier_complete(bar, b.x, nloc, nx); b.st[0] = nloc; b.st[1] = nx; }
        const unsigned old = xb_add(&bar[XB_XSUB(b.x)], 1u);
        const unsigned gen = old / nloc;
        if (old + 1u == (gen + 1u) * nloc) {
            __builtin_amdgcn_fence(__ATOMIC_RELEASE, "agent");
            asm volatile("s_waitcnt vmcnt(0)" ::: "memory");
            const unsigned og = xb_add(&bar[XB_TOP], 1u);
            const unsigned tg = og / nx;
            if (og + 1u == (tg + 1u) * nx) xb_add(&bar[XB_TOPGEN], 1u);
            else XB_SPIN(xb_ld(&bar[XB_TOPGEN]) == tg, bar);
            __builtin_amdgcn_fence(__ATOMIC_ACQUIRE, "agent");
            xb_add(&bar[XB_XGEN(b.x)], 1u);
            asm volatile("s_waitcnt vmcnt(0)" ::: "memory");
        } else {
            XB_SPIN(xb_ld(&bar[XB_XGEN(b.x)]) == gen, bar);
            __builtin_amdgcn_fence(__ATOMIC_ACQUIRE, "agent");
            asm volatile("s_waitcnt vmcnt(0)" ::: "memory");
        }
    }
    __syncthreads();
}

extern "C" __global__ void __launch_bounds__(RTHR, 2) mega_kernel(Params p) {
  extern __shared__ __attribute__((aligned(16))) char smem[];
  __shared__ unsigned xb_words[4];
  cg::grid_group grid = cg::this_grid();
  if (threadIdx.x < 4) xb_words[threadIdx.x] = 0u;
  __syncthreads();
  XcdBarrier xb = xcd_barrier_post((unsigned*)(p.ws + OFF_BAR), (volatile LAS unsigned*)&xb_words);
  for (int s = p.step_lo; s < p.step_hi; ++s) {
    KP* pp = (KP*)__builtin_amdgcn_kernarg_segment_ptr();
    asm volatile("" : "+s"(pp));
    run_step(*pp, s, smem);
    if (s + 1 < p.step_hi) { if (s == p.step_lo) grid.sync(); else xcd_barrier(xb); }
  }
}

extern "C" void kernel_launch(void* const* d_in, const int* in_sizes, int n_in, void* d_out, int out_size, void* d_ws, size_t ws_size,
                              hipStream_t stream) {
  static int grid_blocks = 0;
  if (!grid_blocks) {
    int dev = 0, cus = 0, per_cu = 0;
    hipGetDevice(&dev);
    hipDeviceGetAttribute(&cus, hipDeviceAttributeMultiprocessorCount, dev);
    hipFuncSetAttribute((const void*)mega_kernel, hipFuncAttributeMaxDynamicSharedMemorySize, LDS_BYTES);
    hipOccupancyMaxActiveBlocksPerMultiprocessor(&per_cu, mega_kernel, RTHR, LDS_BYTES);
    if (per_cu != 1) per_cu = 1;
    grid_blocks = cus * per_cu;
  }
  if (ws_size < WS_NEED) { fprintf(stderr, "workspace too small: %zu < %zu\n", ws_size, (size_t)WS_NEED); return; }
  Params p{};
  const float** pf = (const float**)&p;
  for (int i = 0; i < 30; ++i) pf[i] = (const float*)d_in[i];
  p.out = (float*)d_out;
  p.ws = (char*)d_ws;
#if MULTI
  for (int s = 0; s < NSTEPS; ++s) {
    p.step_lo = s; p.step_hi = s + 1;
    hipLaunchKernelGGL(mega_kernel, dim3(grid_blocks), dim3(RTHR), LDS_BYTES, stream, p);
  }
#else
  p.step_lo = 0; p.step_hi = NSTEPS;
  (void)hipMemsetAsync((char*)d_ws + OFF_BAR, 0, 16384, stream);
  void* args[] = {&p};
  hipError_t e = hipLaunchCooperativeKernel((const void*)mega_kernel, dim3(grid_blocks), dim3(RTHR), args, LDS_BYTES, stream);
  if (e != hipSuccess) fprintf(stderr, "cooperative launch failed: %s (grid %d)\n", hipGetErrorString(e), grid_blocks);
#endif
}
```

```cpp
#include <hip/hip_runtime.h>
#include <hip/hip_cooperative_groups.h>
#include <cstdio>
namespace cg = cooperative_groups;

typedef unsigned short bf16_t;
typedef short bf16x8 __attribute__((ext_vector_type(8)));
typedef float f32x4 __attribute__((ext_vector_type(4)));
typedef float f32x16 __attribute__((ext_vector_type(16)));
typedef unsigned u32x4 __attribute__((ext_vector_type(4)));
typedef unsigned u32x2 __attribute__((ext_vector_type(2)));
#define DI __device__ __forceinline__
#ifndef MULTI
#define MULTI 0
#endif

constexpr int NTHR = 256;
constexpr int RTHR = 512;
constexpr int GRP_LDS = 73728;
constexpr int LDS_BYTES = 2 * GRP_LDS;
constexpr int DM = 2048, NTOK = 24576, NCTX = 8192, SLAT = 2560;
constexpr int NPROJ = 5888, NIN = 14080, FF = 5632, PQW = 3328;
constexpr float EPSV = 1e-6f, LOG2E = 1.4426950408889634f;

constexpr size_t SZ_WIN = (size_t)NIN * 2048 * 2, SZ_WBR = (size_t)4 * 2048 * 512 * 2, SZ_WO = (size_t)2048 * 2048 * 2,
                 SZ_WUP = (size_t)11264 * 2048 * 2, SZ_WDN = (size_t)2048 * 5632 * 2, SZ_WUKV = (size_t)1024 * 256 * 2;
constexpr size_t WO_IN = 0, WO_BR = WO_IN + SZ_WIN, WO_O = WO_BR + SZ_WBR, WO_UP = WO_O + SZ_WO, WO_DN = WO_UP + SZ_WUP, WO_UKV = WO_DN + SZ_WDN,
                 SZ_WL = WO_UKV + SZ_WUKV;
constexpr size_t OFF_MODP = 2 * SZ_WL, SZ_MODP = (size_t)16 * 2 * 9 * 12288 * 4;
constexpr size_t OFF_MOD = OFF_MODP + SZ_MODP, SZ_MOD = (size_t)2 * 9 * 12288 * 4;
constexpr size_t OFF_H = OFF_MOD + SZ_MOD, SZ_H = (size_t)NTOK * 2048 * 2;
constexpr size_t OFF_AR = OFF_H + SZ_H;
constexpr size_t OFF_Y = OFF_AR;
constexpr size_t OFF_PQ = OFF_Y + SZ_H, SZ_PQ = (size_t)NTOK * PQW * 2;
constexpr size_t OFF_MCKV = OFF_PQ + SZ_PQ, SZ_MCKV = (size_t)NTOK * 256 * 4;
constexpr size_t OFF_CKVA = OFF_MCKV + SZ_MCKV, SZ_CKVA = (size_t)28672 * 256 * 2;
constexpr size_t OFF_KV = OFF_CKVA + SZ_CKVA;
constexpr size_t NLROW = 8 * SLAT;
constexpr size_t OFF_KMC = OFF_KV, OFF_VMC = OFF_KMC + (size_t)NCTX * 768 * 2, OFF_KML = OFF_VMC + (size_t)NCTX * 512 * 2,
                 OFF_VML = OFF_KML + NLROW * 768 * 2, OFF_KDC = OFF_VML + NLROW * 512 * 2, OFF_VDC = OFF_KDC + (size_t)NCTX * 512 * 2,
                 OFF_KDL = OFF_VDC + (size_t)NCTX * 512 * 2, OFF_VDL = OFF_KDL + NLROW * 512 * 2, OFF_KNC = OFF_VDL + NLROW * 512 * 2,
                 OFF_VNC = OFF_KNC + (size_t)NCTX * 512 * 2, OFF_KNL = OFF_VNC + (size_t)NCTX * 512 * 2, OFF_VNL = OFF_KNL + NLROW * 512 * 2,
                 OFF_KVEND = OFF_VNL + NLROW * 512 * 2;
constexpr size_t OFF_M = OFF_KV;
static_assert(OFF_KVEND - OFF_KV >= SZ_H, "m alias");
constexpr size_t OFF_ACT = OFF_AR, SZ_ACT = (size_t)NTOK * FF * 2;
constexpr size_t OFF_U = OFF_ACT + SZ_ACT, SZ_U = (size_t)NTOK * 4352 * 2;
static_assert(OFF_U + SZ_U <= OFF_KVEND, "ffn alias");
constexpr size_t OFF_BAR = OFF_KVEND;
constexpr size_t WS_NEED = OFF_BAR + 16384;

constexpr size_t OO_Y = 0, OO_CKV = (size_t)NTOK * 2048, OO_KR = OO_CKV + 4194304, OO_DK = OO_KR + 524288, OO_DV = OO_DK + 8388608,
                 OO_NK = OO_DV + 8388608, OO_NV = OO_NK + 8388608, OO_RET = OO_NV + 8388608;

struct Params {
  const float *x_prompt, *x_sample, *c_ckv, *c_kr, *c_dk, *c_dv, *c_nk, *c_nv, *st_ret, *c, *c_ctx, *w_ada, *b_ada, *g_attn, *g_ffn, *w_in,
      *kv_norm, *w_ukv, *diff_lambda, *diff_norm, *na_bias, *ret_decay, *ret_norm, *w_branch, *w_o, *w_up, *conv_w, *conv_b, *w_down, *g_final;
  float* out;
  char* ws;
  int step_lo, step_hi;
};

typedef __attribute__((address_space(4))) const Params KP;
DI unsigned short f2bf(float f) { unsigned u = __float_as_uint(f); u += 0x7fffu + ((u >> 16) & 1u); return (unsigned short)(u >> 16); }
typedef __bf16 bf16v2_t __attribute__((ext_vector_type(2)));
typedef float f32v2_t __attribute__((ext_vector_type(2)));
DI unsigned pack2(float a, float b) { f32v2_t v = {a, b}; return __builtin_bit_cast(unsigned, __builtin_convertvector(v, bf16v2_t)); }
DI float bf2f(unsigned short h) { return __uint_as_float(((unsigned)h) << 16); }
DI float bflo(unsigned u) { return __uint_as_float(u << 16); }
DI float bfhi(unsigned u) { return __uint_as_float(u & 0xffff0000u); }
typedef __attribute__((address_space(1))) const u32x4 g_u32x4;
DI u32x4 gld16(const void* p) { return *(g_u32x4*)p; }
#define SCHED_FENCE() __builtin_amdgcn_sched_barrier(0)
DI int ltid() { int t = threadIdx.x; asm volatile("" : "+v"(t)); return t & 255; }
DI int rtid() { int t = threadIdx.x; asm volatile("" : "+v"(t)); return t; }
DI int vgrp() { return __builtin_amdgcn_readfirstlane((int)(threadIdx.x >> 8)); }
DI int VB() { return (int)blockIdx.x * 2 + vgrp(); }
DI int VG() { return (int)gridDim.x * 2; }
DI float shx(float v, int o) {
  int l = __builtin_amdgcn_mbcnt_hi(~0u, __builtin_amdgcn_mbcnt_lo(~0u, 0u));
  asm volatile("" : "+v"(l));
  return __int_as_float(__builtin_amdgcn_ds_bpermute((l ^ o) << 2, __float_as_int(v)));
}
DI float x32_max(float v) { auto r = __builtin_amdgcn_permlane32_swap(__float_as_uint(v), __float_as_uint(v), false, false); return fmaxf(__uint_as_float(r[0]), __uint_as_float(r[1])); }
DI float x32_sum(float v) { auto r = __builtin_amdgcn_permlane32_swap(__float_as_uint(v), __float_as_uint(v), false, false); return __uint_as_float(r[0]) + __uint_as_float(r[1]); }
DI float wave_sum(float v) {
#pragma unroll
  for (int o = 32; o >= 1; o >>= 1) v += shx(v, o);
  return v;
}
DI float sigmoidf_(float x) { return __builtin_amdgcn_rcpf(1.f + __builtin_amdgcn_exp2f(-1.4426950408889634f * x)); }
DI int grp_of(int r) { return r < NCTX ? 0 : 1 + ((r - NCTX) >> 11); }
DI int kvrow_of(int r) { int rr = r - NCTX; return (rr >> 11) * SLAT + (rr & 2047); }
DI const float* xrow_in(KP& p, int r) { return r < NCTX ? p.x_prompt + (size_t)r * DM : p.x_sample + (size_t)(r - NCTX) * DM; }

template <int WN>
DI void gemm_kloop(f32x4 (&acc)[4][WN], const bf16_t* __restrict__ A, int lda, const bf16_t* __restrict__ B, int ldb, int K, char* smem) {
  const int tid = ltid(), wid = tid >> 6, lane = tid & 63, wr = wid >> 1, wc = wid & 1, fr = lane & 15, fq = lane >> 4;
  const int r0 = tid >> 3, ch = tid & 7;
  const bf16_t* ap = A + (size_t)r0 * lda + ch * 8;
  const bf16_t* bp = B + (size_t)r0 * ldb + ch * 8;
  u32x4 ra0[4], rb0[WN], ra1[4], rb1[WN];
  const int nk = K >> 6;
  const int swz_w = (r0 >> 1) & 7, swz_r = (fr >> 1) & 7;
  char* sa = smem + r0 * 128 + ((ch ^ swz_w) * 16);
  char* sb = smem + 32768 + r0 * 128 + ((ch ^ swz_w) * 16);
  const char* fa = smem + (64 * wr + fr) * 128;
  const char* fb = smem + 32768 + (16 * WN * wc + fr) * 128;
  const int ko0 = ((fq ^ swz_r) * 16), ko1 = (((4 + fq) ^ swz_r) * 16);
  auto gload = [&](u32x4 (&RA)[4], u32x4 (&RB)[WN], int kt) {
#pragma unroll
    for (int i = 0; i < 4; ++i) RA[i] = gld16(ap + (size_t)(32 * i) * lda + kt * 64);
#pragma unroll
    for (int i = 0; i < WN; ++i) RB[i] = gld16(bp + (size_t)(32 * i) * ldb + kt * 64);
  };
  auto sstore = [&](const u32x4 (&RA)[4], const u32x4 (&RB)[WN], int buf) {
#pragma unroll
    for (int i = 0; i < 4; ++i) *(u32x4*)(sa + buf * 16384 + i * 32 * 128) = RA[i];
#pragma unroll
    for (int i = 0; i < WN; ++i) *(u32x4*)(sb + buf * 16384 + i * 32 * 128) = RB[i];
  };
  auto compute = [&](int buf) {
#pragma unroll
    for (int ks = 0; ks < 2; ++ks) {
      bf16x8 af[4], bfr[WN];
#pragma unroll
      for (int mi = 0; mi < 4; ++mi) af[mi] = *(const bf16x8*)(fa + buf * 16384 + mi * 16 * 128 + (ks ? ko1 : ko0));
#pragma unroll
      for (int ni = 0; ni < WN; ++ni) bfr[ni] = *(const bf16x8*)(fb + buf * 16384 + ni * 16 * 128 + (ks ? ko1 : ko0));
#pragma unroll
      for (int mi = 0; mi < 4; ++mi)
#pragma unroll
        for (int ni = 0; ni < WN; ++ni) acc[mi][ni] = __builtin_amdgcn_mfma_f32_16x16x32_bf16(bfr[ni], af[mi], acc[mi][ni], 0, 0, 0);
    }
  };
  auto step = [&](u32x4 (&RA)[4], u32x4 (&RB)[WN], int buf, int kt) {
    compute(buf);
    SCHED_FENCE();
    if (kt + 1 < nk) {
      sstore(RA, RB, buf ^ 1);
      if (kt + 3 < nk) gload(RA, RB, kt + 3);
    }
    SCHED_FENCE();
    __syncthreads();
  };
  gload(ra0, rb0, 0);
  gload(ra1, rb1, 1);
  __syncthreads();
  sstore(ra0, rb0, 0);
  gload(ra0, rb0, 2);
  SCHED_FENCE();
  __syncthreads();
#pragma unroll 1
  for (int kt = 0; kt < nk; kt += 2) {
    step(ra1, rb1, 0, kt);
    step(ra0, rb0, 1, kt + 1);
  }
}

template <int WN, class F>
DI void gemm_epilogue(const f32x4 (&acc)[4][WN], char* smem, int m0, int n0, const F& f) {
  constexpr int BN = 32 * WN, CS = BN + 4;
  const int tid = ltid(), wid = tid >> 6, lane = tid & 63, wr = wid >> 1, wc = wid & 1, fr = lane & 15, fq = lane >> 4;
  float* ct = (float*)smem;
#pragma unroll
  for (int mi = 0; mi < 4; ++mi)
#pragma unroll
    for (int ni = 0; ni < WN; ++ni) *(f32x4*)(ct + (64 * wr + 16 * mi + fr) * CS + 16 * WN * wc + 16 * ni + 4 * fq) = acc[mi][ni];
  __syncthreads();
  constexpr int CPR = BN / 32;
#pragma unroll 1
  for (int u = tid; u < 128 * CPR; u += NTHR) {
    const int row = u / CPR, chn = u % CPR;
    float v[32];
#pragma unroll
    for (int j = 0; j < 8; ++j) {
      f32x4 t = *(const f32x4*)(ct + row * CS + chn * 32 + 4 * j);
      v[4 * j] = t[0]; v[4 * j + 1] = t[1]; v[4 * j + 2] = t[2]; v[4 * j + 3] = t[3];
    }
    f(m0 + row, n0 + chn * 32, v);
  }
  __syncthreads();
}

DI void store_bf16_32(bf16_t* dst, const float (&v)[32]) {
#pragma unroll
  for (int j = 0; j < 4; ++j) {
    u32x4 t;
    t[0] = pack2(v[8 * j], v[8 * j + 1]); t[1] = pack2(v[8 * j + 2], v[8 * j + 3]);
    t[2] = pack2(v[8 * j + 4], v[8 * j + 5]); t[3] = pack2(v[8 * j + 6], v[8 * j + 7]);
    *(u32x4*)(dst + 8 * j) = t;
  }
}
DI void store_f32_32(float* dst, const float (&v)[32]) {
#pragma unroll
  for (int j = 0; j < 8; ++j) { f32x4 t = {v[4 * j], v[4 * j + 1], v[4 * j + 2], v[4 * j + 3]}; *(f32x4*)(dst + 4 * j) = t; }
}


DI bool tile_map(int t, int nM, int nN, int PMS, int& pm, int& pn) {
  if (t >= nM * nN) return false;
  const int per_g = PMS * nN, g = t / per_g, r = t % per_g, j = r / (4 * PMS), q = r - j * 4 * PMS;
  pm = PMS * g + (q % PMS); pn = 4 * j + (q / PMS);
  return true;
}
DI int vtile_slot(int i) { const int b = blockIdx.x; return (i * 8 + (b & 7)) * ((int)(gridDim.x >> 3) * 2) + (b >> 3) * 2 + vgrp(); }
DI int rtile_slot(int i) { const int b = blockIdx.x; return (i * 8 + (b & 7)) * (int)(gridDim.x >> 3) + (b >> 3); }

template <int NI>
DI void gemm256_kloop(f32x4 (&acc)[8][NI], u32x4 (&ra)[4], u32x4 (&rb)[NI], const bf16_t* __restrict__ A, int lda, const bf16_t* __restrict__ B, int ldb, int K,
                      const bf16_t* __restrict__ An, int ldan, const bf16_t* __restrict__ Bn, int ldbn, bool chained, char* smem) {
  const int tid = rtid(), wid = tid >> 6, lane = tid & 63, wr = wid >> 2, wc = wid & 3, fr = lane & 15, fq = lane >> 4;
  const int r0 = tid >> 3, ch = tid & 7;
  const bf16_t* ap = A + (size_t)r0 * lda + ch * 8;
  const bf16_t* bp = B + (size_t)r0 * ldb + ch * 8;
  const bf16_t* apn = An + (size_t)r0 * ldan + ch * 8;
  const bf16_t* bpn = Bn + (size_t)r0 * ldbn + ch * 8;
  const int nk = K >> 6;
  const int swz_w = (r0 >> 1) & 7, swz_r = (fr >> 1) & 7;
  char* sa = smem + r0 * 128 + ((ch ^ swz_w) * 16);
  char* sb = smem + 65536 + r0 * 128 + ((ch ^ swz_w) * 16);
  const char* fa = smem + (128 * wr + fr) * 128;
  const char* fb = smem + 65536 + (16 * NI * wc + fr) * 128;
  const int ko0 = ((fq ^ swz_r) * 16), ko1 = (((4 + fq) ^ swz_r) * 16);
  auto gload = [&](int kt) {
#pragma unroll
    for (int i = 0; i < 4; ++i) ra[i] = gld16(ap + (size_t)(64 * i) * lda + kt * 64);
#pragma unroll
    for (int i = 0; i < NI; ++i) rb[i] = gld16(bp + (size_t)(64 * i) * ldb + kt * 64);
  };
  auto sstore = [&](int buf) {
#pragma unroll
    for (int i = 0; i < 4; ++i) *(u32x4*)(sa + buf * 32768 + i * 64 * 128) = ra[i];
#pragma unroll
    for (int i = 0; i < NI; ++i) *(u32x4*)(sb + buf * 32768 + i * 64 * 128) = rb[i];
  };
  if (!chained) {
    gload(0);
    __syncthreads();
    sstore(0);
    gload(1);
    SCHED_FENCE();
    __syncthreads();
  }
  auto half = [&](int buf, int ks, bool refill, int ktn, bool nxt) {
    const char* pa = fa + buf * 32768 + (ks ? ko1 : ko0);
    const char* pb = fb + buf * 32768 + (ks ? ko1 : ko0);
    constexpr int RD = (NI == 4) ? 2 : 4;
    bf16x8 bfr[NI], ar[RD];
#pragma unroll
    for (int ni = 0; ni < NI; ++ni) bfr[ni] = *(const bf16x8*)(pb + ni * 2048);
#pragma unroll
    for (int d = 0; d < RD; ++d) ar[d] = *(const bf16x8*)(pa + d * 2048);
#pragma unroll
    for (int mi = 0; mi < 8; ++mi) {
#pragma unroll
      for (int ni = 0; ni < NI; ++ni) acc[mi][ni] = __builtin_amdgcn_mfma_f32_16x16x32_bf16(bfr[ni], ar[mi % RD], acc[mi][ni], 0, 0, 0);
      if (mi + RD < 8) ar[mi % RD] = *(const bf16x8*)(pa + (mi + RD) * 2048);
      if ((mi & 1) == 0) {
        const int pc = mi >> 1;
        if (ks == 0) {
          *(u32x4*)(sa + (buf ^ 1) * 32768 + pc * 64 * 128) = ra[pc];
          ra[pc] = gld16(nxt ? apn + (size_t)(64 * pc) * ldan + ktn * 64 : ap + (size_t)(64 * pc) * lda + ktn * 64);
        } else if (pc < NI) {
          *(u32x4*)(sb + (buf ^ 1) * 32768 + pc * 64 * 128) = rb[pc];
          rb[pc] = gld16(nxt ? bpn + (size_t)(64 * pc) * ldbn + ktn * 64 : bp + (size_t)(64 * pc) * ldb + ktn * 64);
        }
      }
    }
    __builtin_amdgcn_sched_group_barrier(0x100, NI + RD, 0);
#pragma unroll
    for (int mi = 0; mi < 8; ++mi) {
      __builtin_amdgcn_sched_group_barrier(0x008, NI, 0);
      if (mi + RD < 8) __builtin_amdgcn_sched_group_barrier(0x100, 1, 0);
      if ((mi & 1) == 0 && (ks == 0 || (mi >> 1) < NI)) { __builtin_amdgcn_sched_group_barrier(0x200, 1, 0); __builtin_amdgcn_sched_group_barrier(0x020, 1, 0); }
    }
  };
#pragma unroll 1
  for (int kt = 0; kt < nk; ++kt) {
    const int buf = kt & 1;
    const bool nxt = kt + 2 >= nk;
    const int ktn = nxt ? kt + 2 - nk : kt + 2;
    half(buf, 0, true, ktn, nxt);
    half(buf, 1, true, ktn, nxt);
    __syncthreads();
  }
}

template <int NI, class F>
DI void gemm256_epilogue(const f32x4 (&acc)[8][NI], char* smem, int m0, int n0, const F& f) {
  constexpr int CSB = NI * 128 + 16, CPR = NI * 2;
  const int tid = rtid(), wid = tid >> 6, lane = tid & 63, wr = wid >> 2, wc = wid & 3, fr = lane & 15, fq = lane >> 4;
#pragma unroll
  for (int mi = 0; mi < 8; ++mi)
#pragma unroll
    for (int ni = 0; ni < NI; ++ni) {
      u32x2 t = {pack2(acc[mi][ni][0], acc[mi][ni][1]), pack2(acc[mi][ni][2], acc[mi][ni][3])};
      *(u32x2*)(smem + (128 * wr + 16 * mi + fr) * CSB + (16 * NI * wc + 16 * ni + 4 * fq) * 2) = t;
    }
  __syncthreads();
#pragma unroll 1
  for (int u = tid; u < 256 * CPR; u += RTHR) {
    const int row = u / CPR, chn = u % CPR;
    float v[32];
#pragma unroll
    for (int j = 0; j < 4; ++j) {
      const u32x4 t = *(const u32x4*)(smem + row * CSB + chn * 64 + 16 * j);
#pragma unroll
      for (int e = 0; e < 4; ++e) { v[8 * j + 2 * e] = bflo(t[e]); v[8 * j + 2 * e + 1] = bfhi(t[e]); }
    }
    f(m0 + row, n0 + chn * 32, v);
  }
  __syncthreads();
}

template <class F>
DI void gemm256_phase(const bf16_t* A, int lda, const bf16_t* B, int ldb, int K, int nM, int nN, int pn_base, const F& f, char* smem) {
  for (int it = 0;; ++it) {
    int pm, pn;
    if (!tile_map(rtile_slot(it), nM, nN, 8, pm, pn)) break;
    pn += pn_base;
    f32x4 acc[8][4];
#pragma unroll
    for (int mi = 0; mi < 8; ++mi)
#pragma unroll
      for (int ni = 0; ni < 4; ++ni) acc[mi][ni] = (f32x4){0.f, 0.f, 0.f, 0.f};
    u32x4 ra[4], rb[4];
    const bf16_t* At = A + (size_t)pm * 256 * lda; const bf16_t* Bt = B + (size_t)pn * 256 * ldb;
    gemm256_kloop<4>(acc, ra, rb, At, lda, Bt, ldb, K, At, lda, Bt, ldb, false, smem);
    gemm256_epilogue<4>(acc, smem, pm * 256, pn * 256, f);
  }
}

template <int NF>
DI void rope_seg(float* v, float pos) {
#pragma unroll
  for (int f = 0; f < NF; ++f) {
    const float inv = exp2f(-(float)f / (float)NF * 13.287712379549449f) * 0.15915494309189535f;
    const float rev = pos * inv;
    const float cs = __builtin_amdgcn_cosf(rev), sn = __builtin_amdgcn_sinf(rev);
    const float a = v[f], b = v[NF + f];
    v[f] = a * cs - b * sn;
    v[NF + f] = b * cs + a * sn;
  }
}

struct ProjEpi {
  char* ws; float* out; int l;
  DI void state_out(size_t base, int W, int r, int c, const float (&v)[32]) const {
    const int b = r >> 8, t = r & 255;
    store_f32_32(out + base + ((size_t)((b * 2 + l) * 256 + t)) * W + c, v);
  }
  DI void operator()(int r, int c0, float (&v)[32]) const {
    bf16_t* const pq = (bf16_t*)(ws + OFF_PQ); bf16_t* const kmc = (bf16_t*)(ws + OFF_KMC); bf16_t* const kml = (bf16_t*)(ws + OFF_KML);
    bf16_t* const kdc = (bf16_t*)(ws + OFF_KDC); bf16_t* const vdc = (bf16_t*)(ws + OFF_VDC); bf16_t* const kdl = (bf16_t*)(ws + OFF_KDL);
    bf16_t* const vdl = (bf16_t*)(ws + OFF_VDL); bf16_t* const knc = (bf16_t*)(ws + OFF_KNC); bf16_t* const vnc = (bf16_t*)(ws + OFF_VNC);
    bf16_t* const knl = (bf16_t*)(ws + OFF_KNL); bf16_t* const vnl = (bf16_t*)(ws + OFF_VNL); float* const mckv = (float*)(ws + OFF_MCKV);
    const bool lat = r >= NCTX;
    int prow = 0, pcol = 0;
    if (lat) { const int t = (r - NCTX) & 2047; prow = t >> 6; pcol = t & 63; }
    if (c0 < 768) {
      if (lat && (c0 % 96) == 64) { rope_seg<8>(v, (float)prow); rope_seg<8>(v + 16, (float)pcol); }
      store_bf16_32(pq + (size_t)r * PQW + c0, v);
    } else if (c0 < 1024) {
      store_f32_32(mckv + (size_t)r * 256 + (c0 - 768), v);
    } else if (c0 < 1536) {
      if (lat) rope_seg<16>(v, (float)((((c0 - 1024) >> 5) & 1) ? pcol : prow));
      store_bf16_32(pq + (size_t)r * PQW + 768 + (c0 - 1024), v);
    } else if (c0 < 2048) {
      const int c = c0 - 1536;
      if (lat) { rope_seg<16>(v, (float)(((c >> 5) & 1) ? pcol : prow)); store_bf16_32(kdl + (size_t)kvrow_of(r) * 512 + c, v); }
      else { store_bf16_32(kdc + (size_t)r * 512 + c, v); state_out(OO_DK, 512, r, c, v); }
    } else if (c0 < 2560) {
      const int c = c0 - 2048;
      if (lat) store_bf16_32(vdl + (size_t)kvrow_of(r) * 512 + c, v);
      else { store_bf16_32(vdc + (size_t)r * 512 + c, v); state_out(OO_DV, 512, r, c, v); }
    } else if (c0 < 3072) {
      store_bf16_32(pq + (size_t)r * PQW + 1280 + (c0 - 2560), v);
    } else if (c0 < 3584) {
      const int c = c0 - 3072;
      if (lat) store_bf16_32(knl + (size_t)kvrow_of(r) * 512 + c, v);
      else { store_bf16_32(knc + (size_t)r * 512 + c, v); state_out(OO_NK, 512, r, c, v); }
    } else if (c0 < 4096) {
      const int c = c0 - 3584;
      if (lat) store_bf16_32(vnl + (size_t)kvrow_of(r) * 512 + c, v);
      else { store_bf16_32(vnc + (size_t)r * 512 + c, v); state_out(OO_NV, 512, r, c, v); }
    } else if (c0 < 5632) {
      store_bf16_32(pq + (size_t)r * PQW + 1792 + (c0 - 4096), v);
    } else if (c0 == 5632) {
      bf16_t* dst;
      if (lat) { rope_seg<8>(v, (float)prow); rope_seg<8>(v + 16, (float)pcol); dst = kml + (size_t)kvrow_of(r) * 768; }
      else { state_out(OO_KR, 32, r, 0, v); dst = kmc + (size_t)r * 768; }
#pragma unroll 1
      for (int h = 0; h < 8; ++h) store_bf16_32(dst + h * 96 + 64, v);
    }
  }
};

struct UkvEpi {
  char* ws;
  DI void operator()(int R, int c0, float (&v)[32]) const {
    size_t row, ko, vo;
    if (R < NCTX) { ko = OFF_KMC; vo = OFF_VMC; row = R; }
    else if (R < NTOK) { ko = OFF_KML; vo = OFF_VML; row = kvrow_of(R); }
    else { const int c = R - NTOK; ko = OFF_KML; vo = OFF_VML; row = (size_t)(c >> 9) * SLAT + 2048 + (c & 511); }
    const int hd = c0 >> 7, e = c0 & 127;
    if (e < 64) store_bf16_32((bf16_t*)(ws + ko) + row * 768 + hd * 96 + e, v);
    else store_bf16_32((bf16_t*)(ws + vo) + row * 512 + hd * 64 + (e - 64), v);
  }
};

struct StoreBf16Epi {
  bf16_t* dst; int ld; int coff;
  DI void operator()(int r, int c0, float (&v)[32]) const { store_bf16_32(dst + (size_t)r * ld + (c0 - coff), v); }
};

struct ResidEpi {
  const float* xp; const float* xs; float* out; const float* ga;
  DI void operator()(int r, int c0, float (&v)[32]) const {
    const float* xr = (r < NCTX ? xp + (size_t)r * DM : xs + (size_t)(r - NCTX) * DM) + c0;
    const float* g = ga + (size_t)grp_of(r) * 12288 + c0;
    float* o = out + (size_t)r * DM + c0;
#pragma unroll
    for (int j = 0; j < 8; ++j) {
      const f32x4 xv = *(const f32x4*)(xr + 4 * j), gv = *(const f32x4*)(g + 4 * j);
      f32x4 t = {xv[0] + gv[0] * v[4 * j], xv[1] + gv[1] * v[4 * j + 1], xv[2] + gv[2] * v[4 * j + 2], xv[3] + gv[3] * v[4 * j + 3]};
      *(f32x4*)(o + 4 * j) = t;
    }
  }
};

struct AttnArgs {
  const bf16_t *q, *k, *v; int q_ld, k_ld, v_ld; int n_keys; float sl2;
  bf16_t* y; int y_ld;
  int R0; const float* bias;
  int t0, T; float lgf, lgb; const float *s0f, *s0b; const bf16_t* rg; int rg_ld; const float* nw;
  float lam, omli;
};

constexpr int A_VT = 13312, A_BIAS = 30720, A_S0 = 32768;

template <int DQ, int DV, int MODE>
DI void attn_block(char* smem, const AttnArgs& a) {
  constexpr int KSTR = (DQ + 8) * 2, CK = DQ / 8, NKL = 64 * CK / NTHR, NVL = (32 * DV / 8) / NTHR, NKS = DQ / 16, NDB = DV / 32;
  const int tid = ltid(), w = tid >> 6, lane = tid & 63, ql = lane & 31, g = lane >> 5;
  const int qloc = 32 * w + ql;
  f32x16 O[NDB];
  float m_run = -1e30f, l_run = 0.f;
#pragma unroll
  for (int d = 0; d < NDB; ++d)
#pragma unroll
    for (int i = 0; i < 16; ++i) O[d][i] = 0.f;

  int na_r = 0, na_c = 0, na_rs = 0, na_cs = 0, rlo = 0, nloc = 0;
  if (MODE == 1) {
    na_r = a.R0 + (w >> 1); na_c = 32 * (w & 1) + ql;
    na_rs = min(max(na_r - 4, 0), 24); na_cs = min(max(na_c - 8, 0), 48);
    rlo = min(max(a.R0 - 4, 0), 24);
    nloc = 9;
    __syncthreads();
    float* bl = (float*)(smem + A_BIAS);
    for (int i = tid; i < 465; i += NTHR) bl[i] = a.bias[i] * LOG2E;
  }
  const int npass = (MODE == 3) ? 2 : 1;
  const int ntile = (MODE == 1) ? (nloc + 8) : (a.n_keys >> 6);
  const int t_q = a.t0 + qloc;

  bf16x8 qf[NKS];
  u32x4 rk[NKL], rv0[NVL], rv1[NVL];

  auto key0_of = [&](int it) -> int {
    if (MODE == 1) return it < nloc ? (rlo + it) * 64 : 2048 + 64 * (it - nloc);
    return it * 64;
  };
  auto prefetch = [&](int it, int pass) {
    const int key0 = key0_of(it);
    const bf16_t* kp = a.k + (MODE == 3 ? pass * 64 : 0);
#pragma unroll
    for (int i = 0; i < NKL; ++i) { const int idx = tid + NTHR * i, row = idx / CK, c = idx % CK; rk[i] = gld16(kp + (size_t)(key0 + row) * a.k_ld + 8 * c); }
#pragma unroll
    for (int i = 0; i < NVL; ++i) {
      const int idx = tid + NTHR * i, pr = idx & 31, c = idx >> 5;
      rv0[i] = gld16(a.v + (size_t)(key0 + 2 * pr) * a.v_ld + 8 * c);
      rv1[i] = gld16(a.v + (size_t)(key0 + 2 * pr + 1) * a.v_ld + 8 * c);
    }
  };
  auto stage = [&]() {
#pragma unroll
    for (int i = 0; i < NKL; ++i) { const int idx = tid + NTHR * i, row = idx / CK, c = idx % CK; *(u32x4*)(smem + row * KSTR + 16 * c) = rk[i]; }
#pragma unroll
    for (int i = 0; i < NVL; ++i) {
      const int idx = tid + NTHR * i, pr = idx & 31, c = idx >> 5;
      char* base = smem + A_VT + (8 * c) * 136 + 4 * pr;
#pragma unroll
      for (int e = 0; e < 4; ++e) {
        const unsigned x = rv0[i][e], y = rv1[i][e];
        *(unsigned*)(base + (2 * e) * 136) = (x & 0xffffu) | (y << 16);
        *(unsigned*)(base + (2 * e + 1) * 136) = (x >> 16) | (y & 0xffff0000u);
      }
    }
  };

#pragma unroll 1
  for (int pass = 0; pass < npass; ++pass) {
    {
      const bf16_t* qp = a.q + (MODE == 3 ? pass * 64 : 0) + (size_t)qloc * a.q_ld + 8 * g;
#pragma unroll
      for (int ks = 0; ks < NKS; ++ks) qf[ks] = *(const bf16x8*)(qp + 16 * ks);
    }
    prefetch(0, pass);
#pragma unroll 1
    for (int it = 0; it < ntile; ++it) {
      __syncthreads();
      stage();
      __syncthreads();
      if (it + 1 < ntile) prefetch(it + 1, pass);
      SCHED_FENCE();
      const int key0 = key0_of(it);
      bool active = true;
      int kr = 0;
      const bool local = (MODE == 1) && it < nloc;
      if (local) { kr = rlo + it; active = (kr >= na_rs) && (kr < na_rs + 8); }
      if (active) {
#pragma unroll
        for (int kb = 0; kb < 2; ++kb) {
          f32x16 s;
#pragma unroll
          for (int i = 0; i < 16; ++i) s[i] = 0.f;
          bf16x8 kfr[NKS];
#pragma unroll
          for (int ks = 0; ks < NKS; ++ks) kfr[ks] = *(const bf16x8*)(smem + (32 * kb + ql) * KSTR + (16 * ks + 8 * g) * 2);
          u32x4 vfr[NDB][2];
#pragma unroll
          for (int d = 0; d < NDB; ++d)
#pragma unroll
            for (int h2 = 0; h2 < 2; ++h2) {
              const char* vp = smem + A_VT + (32 * d + ql) * 136 + (32 * kb + 16 * h2 + 4 * g) * 2;
              const u32x2 lo = *(const u32x2*)vp, hi = *(const u32x2*)(vp + 16);
              vfr[d][h2] = (u32x4){lo[0], lo[1], hi[0], hi[1]};
            }
          SCHED_FENCE();
#pragma unroll
          for (int ks = 0; ks < NKS; ++ks) s = __builtin_amdgcn_mfma_f32_32x32x16_bf16(kfr[ks], qf[ks], s, 0, 0, 0);
          float p[16];
          if (MODE == 2) {
#pragma unroll
            for (int i = 0; i < 16; ++i) {
              const int j = key0 + 32 * kb + 8 * (i >> 2) + 4 * g + (i & 3);
              const int d = t_q - j;
              const float e = d >= 0 ? (float)d * a.lgf : (float)(-d) * a.lgb;
              p[i] = s[i] * a.sl2 * __builtin_amdgcn_exp2f(e);
            }
          } else {
            if (local) {
              const float* bl = (const float*)(smem + A_BIAS) + (kr - na_r + 7) * 31 + 15;
#pragma unroll
              for (int i = 0; i < 16; ++i) {
                const int kc = 32 * kb + 8 * (i >> 2) + 4 * g + (i & 3);
                const int dc = min(max(kc - na_c, -15), 15);
                const bool ok = (kc >= na_cs) && (kc < na_cs + 16);
                p[i] = ok ? (s[i] * a.sl2 + bl[dc]) : -1e30f;
              }
            }
            float mx;
            if (local) {
              mx = p[0];
#pragma unroll
              for (int i = 1; i < 16; ++i) mx = fmaxf(mx, p[i]);
            } else {
              mx = s[0];
#pragma unroll
              for (int i = 1; i < 16; ++i) mx = fmaxf(mx, s[i]);
              mx *= a.sl2;
            }
            mx = x32_max(mx);
            const float m_new = fmaxf(m_run, mx);
            const float alpha = __builtin_amdgcn_exp2f(m_run - m_new);
            m_run = m_new;
            float ls = 0.f;
            if (local) {
#pragma unroll
              for (int i = 0; i < 16; ++i) { p[i] = __builtin_amdgcn_exp2f(p[i] - m_new); ls += p[i]; }
            } else {
#pragma unroll
              for (int i = 0; i < 16; ++i) { p[i] = __builtin_amdgcn_exp2f(__builtin_fmaf(s[i], a.sl2, -m_new)); ls += p[i]; }
            }
            l_run = l_run * alpha + ls;
            if (__ballot(alpha != 1.f) != 0ull) {
#pragma unroll
              for (int d = 0; d < NDB; ++d)
#pragma unroll
                for (int i = 0; i < 16; ++i) O[d][i] *= alpha;
            }
          }
          bf16x8 pf[2];
#pragma unroll
          for (int h2 = 0; h2 < 2; ++h2) {
            u32x4 t;
#pragma unroll
            for (int e = 0; e < 4; ++e) t[e] = pack2(p[8 * h2 + 2 * e], p[8 * h2 + 2 * e + 1]);
            pf[h2] = __builtin_bit_cast(bf16x8, t);
          }
#pragma unroll
          for (int d = 0; d < NDB; ++d)
#pragma unroll
            for (int h2 = 0; h2 < 2; ++h2) {
              O[d] = __builtin_amdgcn_mfma_f32_32x32x16_bf16(__builtin_bit_cast(bf16x8, vfr[d][h2]), pf[h2], O[d], 0, 0, 0);
            }
        }
      }
    }
    if (MODE == 3 && pass == 0) {
      const float lt = x32_sum(l_run);
      const float inv = 1.f / lt;
#pragma unroll
      for (int d = 0; d < NDB; ++d)
#pragma unroll
        for (int i4 = 0; i4 < 4; ++i4) {
          u32x2 t = {pack2(O[d][4 * i4] * inv, O[d][4 * i4 + 1] * inv), pack2(O[d][4 * i4 + 2] * inv, O[d][4 * i4 + 3] * inv)};
          *(u32x2*)(smem + A_S0 + qloc * 264 + (32 * d + 8 * i4 + 4 * g) * 2) = t;
          O[d][4 * i4] = 0.f; O[d][4 * i4 + 1] = 0.f; O[d][4 * i4 + 2] = 0.f; O[d][4 * i4 + 3] = 0.f;
        }
      m_run = -1e30f; l_run = 0.f;
    }
  }

  if (MODE == 2 && a.s0f != nullptr) {
#pragma unroll 1
    for (int dir = 0; dir < 2; ++dir) {
      const float* s0 = dir ? a.s0b : a.s0f;
      __syncthreads();
      for (int idx = tid; idx < 64 * 32; idx += NTHR) {
        const int dk = idx >> 5, dv4 = (idx & 31) * 4;
        const f32x4 t = *(const f32x4*)(s0 + dk * 128 + dv4);
#pragma unroll
        for (int e = 0; e < 4; ++e) *(bf16_t*)(smem + A_S0 + (dv4 + e) * 144 + dk * 2) = f2bf(t[e]);
      }
      __syncthreads();
      const float sc = dir ? __builtin_amdgcn_exp2f((float)(a.T - t_q) * a.lgb) : __builtin_amdgcn_exp2f((float)(t_q + 1) * a.lgf);
#pragma unroll
      for (int d = 0; d < NDB; ++d) {
        f32x16 tacc;
#pragma unroll
        for (int i = 0; i < 16; ++i) tacc[i] = 0.f;
#pragma unroll
        for (int ks = 0; ks < NKS; ++ks) {
          const bf16x8 sf = *(const bf16x8*)(smem + A_S0 + (32 * d + ql) * 144 + (16 * ks + 8 * g) * 2);
          tacc = __builtin_amdgcn_mfma_f32_32x32x16_bf16(sf, qf[ks], tacc, 0, 0, 0);
        }
#pragma unroll
        for (int i = 0; i < 16; ++i) O[d][i] += sc * tacc[i];
      }
    }
  }

  if (MODE == 0 || MODE == 1) {
    const float lt = x32_sum(l_run);
    const float inv = 1.f / lt;
#pragma unroll
    for (int d = 0; d < NDB; ++d)
#pragma unroll
      for (int i = 0; i < 16; ++i) O[d][i] *= inv;
  } else if (MODE == 3) {
    const float lt = x32_sum(l_run);
    const float inv = a.lam / lt;
    float ss = 0.f;
#pragma unroll
    for (int d = 0; d < NDB; ++d)
#pragma unroll
      for (int i4 = 0; i4 < 4; ++i4) {
        const u32x2 t = *(const u32x2*)(smem + A_S0 + qloc * 264 + (32 * d + 8 * i4 + 4 * g) * 2);
        const float o0[4] = {bflo(t[0]), bfhi(t[0]), bflo(t[1]), bfhi(t[1])};
#pragma unroll
        for (int e = 0; e < 4; ++e) { const float o = o0[e] - O[d][4 * i4 + e] * inv; O[d][4 * i4 + e] = o; ss += o * o; }
      }
    ss = x32_sum(ss);
    const float rstd = rsqrtf(ss * (1.f / DV) + EPSV) * a.omli;
#pragma unroll
    for (int d = 0; d < NDB; ++d)
#pragma unroll
      for (int i4 = 0; i4 < 4; ++i4) {
        const f32x4 wv = *(const f32x4*)(a.nw + 32 * d + 8 * i4 + 4 * g);
#pragma unroll
        for (int e = 0; e < 4; ++e) O[d][4 * i4 + e] *= rstd * wv[e];
      }
  } else {
    float sm = 0.f;
#pragma unroll
    for (int d = 0; d < NDB; ++d)
#pragma unroll
      for (int i = 0; i < 16; ++i) sm += O[d][i];
    sm = x32_sum(sm);
    const float mu = sm * (1.f / DV);
    float ss = 0.f;
#pragma unroll
    for (int d = 0; d < NDB; ++d)
#pragma unroll
      for (int i = 0; i < 16; ++i) { const float o = O[d][i] - mu; O[d][i] = o; ss += o * o; }
    ss = x32_sum(ss);
    const float rstd = rsqrtf(ss * (1.f / DV) + EPSV);
#pragma unroll
    for (int d = 0; d < NDB; ++d)
#pragma unroll
      for (int i4 = 0; i4 < 4; ++i4) {
        const int dv0 = 32 * d + 8 * i4 + 4 * g;
        const f32x4 wv = *(const f32x4*)(a.nw + dv0);
        const u32x2 gq = *(const u32x2*)(a.rg + (size_t)qloc * a.rg_ld + dv0);
        const float gg[4] = {bflo(gq[0]), bfhi(gq[0]), bflo(gq[1]), bfhi(gq[1])};
#pragma unroll
        for (int e = 0; e < 4; ++e) O[d][4 * i4 + e] *= rstd * wv[e] * (gg[e] * sigmoidf_(gg[e]));
      }
  }
#pragma unroll
  for (int d = 0; d < NDB; ++d)
#pragma unroll
    for (int i4 = 0; i4 < 4; ++i4) {
      u32x2 t = {pack2(O[d][4 * i4], O[d][4 * i4 + 1]), pack2(O[d][4 * i4 + 2], O[d][4 * i4 + 3])};
      *(u32x2*)(a.y + (size_t)qloc * a.y_ld + 32 * d + 8 * i4 + 4 * g) = t;
    }
}

DI void ret_state_job(char* smem, const bf16_t* kp, const bf16_t* vp, int ld, float lg, int dir, float* outp) {
  float* kw = (float*)smem;
  const int tid = ltid();
  __syncthreads();
  for (int idx = tid; idx < 256 * 8; idx += NTHR) {
    const int j = idx >> 3, c = idx & 7;
    const u32x4 t = *(const u32x4*)(kp + (size_t)j * ld + 8 * c);
    const float wj = exp2f((float)(dir ? j : 255 - j) * lg) * 0.125f;
#pragma unroll
    for (int e = 0; e < 4; ++e) { kw[j * 64 + 8 * c + 2 * e] = bflo(t[e]) * wj; kw[j * 64 + 8 * c + 2 * e + 1] = bfhi(t[e]) * wj; }
  }
  __syncthreads();
  const int dv = tid & 127, dkh = tid >> 7;
  float acc[32];
#pragma unroll
  for (int e = 0; e < 32; ++e) acc[e] = 0.f;
#pragma unroll 2
  for (int j = 0; j < 256; ++j) {
    const float vj = bf2f(vp[(size_t)j * ld + dv]);
#pragma unroll
    for (int e4 = 0; e4 < 8; ++e4) {
      const f32x4 kk = *(const f32x4*)(kw + j * 64 + 32 * dkh + 4 * e4);
#pragma unroll
      for (int e = 0; e < 4; ++e) acc[4 * e4 + e] += kk[e] * vj;
    }
  }
#pragma unroll
  for (int e = 0; e < 32; ++e) outp[(32 * dkh + e) * 128 + dv] = acc[e];
}

DI float log2_sigmoid(float x) { return -log1pf(__expf(-x)) * LOG2E; }

#ifndef AM
#define AM 0xFFu
#endif
#define AEN(k) ((AM >> (k)) & 1u)
DI void attention_phase(KP& p, int l, char* smem) {
  char* ws = p.ws;
  bf16_t* pq = (bf16_t*)(ws + OFF_PQ);
  bf16_t* Y = (bf16_t*)(ws + OFF_Y);
  const float lam_init = 0.8f - 0.6f * expf(-0.3f * (float)l);
  float lam;
  {
    const float* lp = p.diff_lambda + l * 256;
    float s1 = 0.f, s2 = 0.f;
    for (int i = 0; i < 64; ++i) { s1 += lp[i] * lp[64 + i]; s2 += lp[128 + i] * lp[192 + i]; }
    lam = expf(s1) - expf(s2) + lam_init;
  }
  const int G = VG();
  auto init = [&](AttnArgs& a) {
    a.R0 = 0; a.bias = nullptr; a.t0 = 0; a.T = 0; a.lgf = 0.f; a.lgb = 0.f; a.s0f = nullptr; a.s0b = nullptr; a.rg = nullptr; a.rg_ld = 0; a.nw = nullptr;
    a.lam = lam; a.omli = 1.f - lam_init; a.q_ld = PQW; a.y_ld = DM;
  };
  int rot = 0;
  auto first = [&](int n) { int f = VB() - rot; if (f < 0) f += G; rot = (rot + n) % G; return f; };
  if (AEN(3)) for (int it = first(512); it < 512; it += G) {
    AttnArgs a; init(a);
    const int b = it >> 6, h = (it >> 4) & 3, qb = it & 15;
    const size_t row = NCTX + (size_t)b * 2048 + qb * 128;
    a.q = pq + row * PQW + 768 + h * 128; a.k = (bf16_t*)(ws + OFF_KDL) + (size_t)b * SLAT * 512 + h * 128; a.k_ld = 512;
    a.v = (bf16_t*)(ws + OFF_VDL) + (size_t)b * SLAT * 512 + h * 128; a.v_ld = 512; a.n_keys = SLAT; a.sl2 = 0.125f * LOG2E;
    a.y = Y + row * DM + 512 + h * 128; a.nw = p.diff_norm + l * 512 + h * 128;
    attn_block<64, 128, 3>(smem, a);
  }
  if (AEN(0)) for (int i = first(1024); i < 1024; i += G) {
    AttnArgs a; init(a);
    const int b = i >> 7, h = (i >> 4) & 7, qb = i & 15;
    const size_t row = NCTX + (size_t)b * 2048 + qb * 128;
    a.q = pq + row * PQW + h * 96; a.k = (bf16_t*)(ws + OFF_KML) + (size_t)b * SLAT * 768 + h * 96; a.k_ld = 768;
    a.v = (bf16_t*)(ws + OFF_VML) + (size_t)b * SLAT * 512 + h * 64; a.v_ld = 512; a.n_keys = SLAT; a.sl2 = 0.10206207261596577f * LOG2E;
    a.y = Y + row * DM + h * 64;
    attn_block<96, 64, 0>(smem, a);
  }
  if (AEN(2)) for (int i = first(512); i < 512; i += G) {
    AttnArgs a; init(a);
    const int b = i >> 6, h = (i >> 4) & 3, qb = i & 15;
    const size_t row0 = NCTX + (size_t)b * 2048, row = row0 + qb * 128;
    a.q = pq + row * PQW + 1792 + h * 64; a.k = pq + row0 * PQW + 2048 + h * 64; a.k_ld = PQW; a.v = pq + row0 * PQW + 2304 + h * 128; a.v_ld = PQW;
    a.n_keys = 2048; a.sl2 = 0.125f; a.y = Y + row * DM + 1536 + h * 128; a.t0 = qb * 128; a.T = 2048;
    a.lgf = log2_sigmoid(p.ret_decay[l * 8 + h]); a.lgb = log2_sigmoid(p.ret_decay[l * 8 + 4 + h]);
    a.s0f = p.st_ret + ((size_t)((b * 2 + l) * 2 + 0) * 4 + h) * 8192; a.s0b = p.st_ret + ((size_t)((b * 2 + l) * 2 + 1) * 4 + h) * 8192;
    a.rg = pq + row * PQW + 2816 + h * 128; a.rg_ld = PQW; a.nw = p.ret_norm + l * 512 + h * 128;
    attn_block<64, 128, 2>(smem, a);
  }
  if (AEN(1)) for (int i = first(1024); i < 1024; i += G) {
    AttnArgs a; init(a);
    const int b = i >> 7, h = (i >> 4) & 7, qb = i & 15;
    const size_t row = NCTX + (size_t)b * 2048 + qb * 128;
    a.q = pq + row * PQW + 1280 + h * 64; a.k = (bf16_t*)(ws + OFF_KNL) + (size_t)b * SLAT * 512 + h * 64; a.k_ld = 512;
    a.v = (bf16_t*)(ws + OFF_VNL) + (size_t)b * SLAT * 512 + h * 64; a.v_ld = 512; a.n_keys = SLAT; a.sl2 = 0.125f * LOG2E;
    a.y = Y + row * DM + 1024 + h * 64; a.R0 = 2 * qb; a.bias = p.na_bias + (size_t)(l * 8 + h) * 465;
    attn_block<64, 64, 1>(smem, a);
  }
  if (AEN(3)) for (int i = first(256); i < 256; i += G) {
    AttnArgs a; init(a);
    const int b = i >> 3, h = (i >> 1) & 3, qb = i & 1;
    const size_t row0 = (size_t)b * 256, row = row0 + qb * 128;
    a.q = pq + row * PQW + 768 + h * 128; a.k = (bf16_t*)(ws + OFF_KDC) + row0 * 512 + h * 128; a.k_ld = 512;
    a.v = (bf16_t*)(ws + OFF_VDC) + row0 * 512 + h * 128; a.v_ld = 512; a.n_keys = 256; a.sl2 = 0.125f * LOG2E;
    a.y = Y + row * DM + 512 + h * 128; a.nw = p.diff_norm + l * 512 + h * 128;
    attn_block<64, 128, 3>(smem, a);
  }
  if (AEN(0)) for (int i = first(512); i < 512; i += G) {
    AttnArgs a; init(a);
    const int b = i >> 4, h = (i >> 1) & 7, qb = i & 1;
    const size_t row0 = (size_t)b * 256, row = row0 + qb * 128;
    a.q = pq + row * PQW + h * 96; a.k = (bf16_t*)(ws + OFF_KMC) + row0 * 768 + h * 96; a.k_ld = 768;
    a.v = (bf16_t*)(ws + OFF_VMC) + row0 * 512 + h * 64; a.v_ld = 512; a.n_keys = 256; a.sl2 = 0.10206207261596577f * LOG2E;
    a.y = Y + row * DM + h * 64;
    attn_block<96, 64, 0>(smem, a);
  }
  if (AEN(4)) for (int i = first(512); i < 512; i += G) {
    AttnArgs a; init(a);
    const int b = i >> 4, h = (i >> 1) & 7, qb = i & 1;
    const size_t row0 = (size_t)b * 256, row = row0 + qb * 128;
    a.q = pq + row * PQW + 1280 + h * 64; a.k = (bf16_t*)(ws + OFF_KNC) + row0 * 512 + h * 64; a.k_ld = 512;
    a.v = (bf16_t*)(ws + OFF_VNC) + row0 * 512 + h * 64; a.v_ld = 512; a.n_keys = 256; a.sl2 = 0.125f * LOG2E;
    a.y = Y + row * DM + 1024 + h * 64;
    attn_block<64, 64, 0>(smem, a);
  }
  if (AEN(2)) for (int i = first(256); i < 256; i += G) {
    AttnArgs a; init(a);
    const int b = i >> 3, h = (i >> 1) & 3, qb = i & 1;
    const size_t row0 = (size_t)b * 256, row = row0 + qb * 128;
    a.q = pq + row * PQW + 1792 + h * 64; a.k = pq + row0 * PQW + 2048 + h * 64; a.k_ld = PQW; a.v = pq + row0 * PQW + 2304 + h * 128; a.v_ld = PQW;
    a.n_keys = 256; a.sl2 = 0.125f; a.y = Y + row * DM + 1536 + h * 128; a.t0 = qb * 128; a.T = 256;
    a.lgf = log2_sigmoid(p.ret_decay[l * 8 + h]); a.lgb = log2_sigmoid(p.ret_decay[l * 8 + 4 + h]);
    a.rg = pq + row * PQW + 2816 + h * 128; a.rg_ld = PQW; a.nw = p.ret_norm + l * 512 + h * 128;
    attn_block<64, 128, 2>(smem, a);
  }
  if (AEN(5)) for (int i = first(256); i < 256; i += G) {
    const int b = i >> 3, h = (i >> 1) & 3, dir = i & 1;
    const size_t row0 = (size_t)b * 256;
    const float lg = log2_sigmoid(p.ret_decay[l * 8 + dir * 4 + h]);
    ret_state_job(smem, pq + row0 * PQW + 2048 + h * 64, pq + row0 * PQW + 2304 + h * 128, PQW, lg, dir,
                  p.out + OO_RET + ((size_t)((b * 2 + l) * 2 + dir) * 4 + h) * 8192);
  }
}

DI void convT_unit(char* smem, const float* src, int ld, int srccol, int k0, bf16_t* dst  , int K) {
  float* T = (float*)smem;
  const int tid = ltid();
  __syncthreads();
  {
    const int n4 = tid & 7, kr = tid >> 3;
#pragma unroll
    for (int i = 0; i < 8; ++i) {
      const int k = kr + 32 * i;
      f32x4 v = {0.f, 0.f, 0.f, 0.f};
      if (srccol >= 0) v = *(const f32x4*)(src + (size_t)(k0 + k) * ld + srccol + 4 * n4);
      T[k * 33 + 4 * n4] = v[0]; T[k * 33 + 4 * n4 + 1] = v[1]; T[k * 33 + 4 * n4 + 2] = v[2]; T[k * 33 + 4 * n4 + 3] = v[3];
    }
  }
  __syncthreads();
  {
    const int k2 = tid & 127, nh = tid >> 7;
#pragma unroll
    for (int i = 0; i < 16; ++i) {
      const int n = nh + 2 * i;
      *(unsigned*)(dst + (size_t)n * K + 2 * k2) = pack2(T[(2 * k2) * 33 + n], T[(2 * k2 + 1) * 33 + n]);
    }
  }
}

DI void prep_phase(KP& p, char* smem) {
  constexpr int NADA = 2 * 16 * 12;
  constexpr int U_IN = 440 * 8, U_BR = 512, U_O = 512, U_UP = 352 * 8, U_DN = 64 * 22, U_UKV = 32, U_L = U_IN + U_BR + U_O + U_UP + U_DN + U_UKV;
  const int tid = ltid();
  const int n_units = NADA + 2 * U_L, trips = (n_units + VG() - 1) / VG();
  for (int tr = 0; tr < trips; ++tr) {
    const int u = VB() + tr * VG();
    if (u >= n_units) { __syncthreads(); __syncthreads(); continue; }
    if (u < NADA) {
      const int l = u / 192, kc = (u % 192) / 12, nc = u % 12;
      float* cs = (float*)smem;
      __syncthreads();
      for (int i = tid; i < 9 * 128; i += NTHR) {
        const int g = i >> 7, k = kc * 128 + (i & 127);
        const float cv = g == 0 ? p.c_ctx[k] : p.c[(g - 1) * DM + k];
        cs[i] = cv * sigmoidf_(cv);
      }
      __syncthreads();
      f32x4 acc[9];
#pragma unroll
      for (int g = 0; g < 9; ++g) acc[g] = (f32x4){0.f, 0.f, 0.f, 0.f};
      const float* wp = p.w_ada + ((size_t)l * DM + kc * 128) * 12288 + nc * 1024 + 4 * tid;
#pragma unroll 4
      for (int k = 0; k < 128; ++k) {
        const f32x4 wv = *(const f32x4*)(wp + (size_t)k * 12288);
#pragma unroll
        for (int g = 0; g < 9; ++g) { const float s = cs[g * 128 + k]; acc[g] += wv * s; }
      }
      float* pp = (float*)(p.ws + OFF_MODP) + ((size_t)(kc * 2 + l) * 9) * 12288 + nc * 1024 + 4 * tid;
#pragma unroll
      for (int g = 0; g < 9; ++g) *(f32x4*)(pp + (size_t)g * 12288) = acc[g];
    } else {
      const int uu = u - NADA, l = uu / U_L;
      int r = uu % U_L;
      char* wl = p.ws + l * SZ_WL;
      if (r < U_IN) {
        const int cn = r >> 3, kt = r & 7, n = cn * 32;
        int sc;
        if (n < 1024) sc = n; else if (n < 5632) sc = n + 32; else if (n < 5664) sc = n - 5632 + 1024; else if (n < NPROJ) sc = -1; else sc = n - 224;
        convT_unit(smem, p.w_in + (size_t)l * DM * 13856, 13856, sc, kt * 256, (bf16_t*)(wl + WO_IN) + (size_t)n * 2048 + kt * 256, 2048);
      } else if ((r -= U_IN) < U_BR) {
        const int cn = r >> 1, kt = r & 1, i = cn >> 6, n = (cn & 63) * 32;
        convT_unit(smem, p.w_branch + ((size_t)(l * 4 + i) * 512) * 2048, 2048, n, kt * 256, (bf16_t*)(wl + WO_BR) + ((size_t)i * 2048 + n) * 512 + kt * 256, 512);
      } else if ((r -= U_BR) < U_O) {
        const int cn = r >> 3, kt = r & 7, n = cn * 32;
        convT_unit(smem, p.w_o + (size_t)l * DM * DM, 2048, n, kt * 256, (bf16_t*)(wl + WO_O) + (size_t)n * 2048 + kt * 256, 2048);
      } else if ((r -= U_O) < U_UP) {
        const int cn = r >> 3, kt = r & 7, n = cn * 32, J = n >> 7, w = n & 127, chn = 64 * J + (w & 63), sc = (w < 64) ? chn : FF + chn;
        convT_unit(smem, p.w_up + (size_t)l * DM * 11264, 11264, sc, kt * 256, (bf16_t*)(wl + WO_UP) + (size_t)n * 2048 + kt * 256, 2048);
      } else if ((r -= U_UP) < U_DN) {
        const int cn = r / 22, kt = r % 22, n = cn * 32;
        convT_unit(smem, p.w_down + (size_t)l * FF * DM, 2048, n, kt * 256, (bf16_t*)(wl + WO_DN) + (size_t)n * FF + kt * 256, FF);
      } else {
        r -= U_DN;
        const int n = r * 32;
        convT_unit(smem, p.w_ukv + (size_t)l * 256 * 1024, 1024, n, 0, (bf16_t*)(wl + WO_UKV) + (size_t)n * 256, 256);
      }
    }
  }
}

DI void ada_reduce_phase(KP& p) {
  const float* pp = (const float*)(p.ws + OFF_MODP);
  float* mod = (float*)(p.ws + OFF_MOD);
  constexpr int NE = 2 * 9 * 12288;
  for (int e = VB() * NTHR + ltid(); e < NE; e += VG() * NTHR) {
    const int l = e / (9 * 12288), n = e % 12288;
    float s = p.b_ada[l * 12288 + n];
    for (int kc = 0; kc < 16; ++kc) s += pp[(size_t)kc * NE + e];
    mod[e] = s;
  }
}

DI void modulate_phase(KP& p, int l, int which  , bool x_from_input) {
  const int vt_ = ltid(), lane = vt_ & 63, wv = vt_ >> 6;
  const float* gvec = (which ? p.g_ffn : p.g_attn) + l * DM;
  const float* mod = (const float*)(p.ws + OFF_MOD) + (size_t)l * 9 * 12288;
  bf16_t* h = (bf16_t*)(p.ws + OFF_H);
  const int nwv = VG() * 4, per = (NTOK + nwv - 1) / nwv, r0 = (VB() * 4 + wv) * per, r1 = min(r0 + per, NTOK);
  f32x4 av[8], bv[8], xn[8];
  int curg = -1;
  auto ldrow = [&](int r) {
    const float* xr = x_from_input ? xrow_in(p, r) : p.out + (size_t)r * DM;
#pragma unroll
    for (int i = 0; i < 8; ++i) xn[i] = *(const f32x4*)(xr + 4 * (lane + 64 * i));
  };
  if (r0 < r1) ldrow(r0);
  for (int r = r0; r < r1; ++r) {
    f32x4 xv[8];
    float ss = 0.f;
#pragma unroll
    for (int i = 0; i < 8; ++i) { xv[i] = xn[i]; ss += xv[i][0] * xv[i][0] + xv[i][1] * xv[i][1] + xv[i][2] * xv[i][2] + xv[i][3] * xv[i][3]; }
    if (r + 1 < r1) ldrow(r + 1);
    const int g = grp_of(r);
    if (g != curg) {
      curg = g;
      const float* sh = mod + (size_t)g * 12288 + (which ? 3 : 0) * DM;
      const float* sc = sh + DM;
#pragma unroll
      for (int i = 0; i < 8; ++i) {
        const int c = 4 * (lane + 64 * i);
        const f32x4 gv = *(const f32x4*)(gvec + c), sv = *(const f32x4*)(sc + c);
        bv[i] = *(const f32x4*)(sh + c);
#pragma unroll
        for (int e = 0; e < 4; ++e) av[i][e] = gv[e] * (1.f + sv[e]);
      }
    }
    ss = wave_sum(ss);
    const float rstd = rsqrtf(ss * (1.f / DM) + EPSV);
#pragma unroll
    for (int i = 0; i < 8; ++i) {
      const int c = 4 * (lane + 64 * i);
      float o[4];
#pragma unroll
      for (int e = 0; e < 4; ++e) o[e] = xv[i][e] * rstd * av[i][e] + bv[i][e];
      u32x2 t = {pack2(o[0], o[1]), pack2(o[2], o[3])};
      *(u32x2*)(h + (size_t)r * DM + c) = t;
    }
  }
}

DI void cache_prep(KP& p, int l) {
  char* ws = p.ws;
  const int total = 4096 * 292;
  for (int u = VB() * NTHR + ltid(); u < total; u += VG() * NTHR) {
    const int cr = u / 292, w = u % 292, b = cr >> 9, j = cr & 511;
    const size_t srow = (size_t)(b * 2 + l) * 512 + j;
    const size_t drow = (size_t)b * SLAT + 2048 + j;
    const float* src; bf16_t* dst; bool rep = false;
    if (w < 32) { src = p.c_ckv + srow * 256 + 8 * w; dst = (bf16_t*)(ws + OFF_CKVA) + ((size_t)NTOK + cr) * 256 + 8 * w; }
    else if (w < 36) { src = p.c_kr + srow * 32 + 8 * (w - 32); dst = (bf16_t*)(ws + OFF_KML) + drow * 768 + 64 + 8 * (w - 32); rep = true; }
    else {
      const int ww = w - 36, which = ww >> 6, c = 8 * (ww & 63);
      const float* sb = which == 0 ? p.c_dk : which == 1 ? p.c_dv : which == 2 ? p.c_nk : p.c_nv;
      const size_t off = which == 0 ? OFF_KDL : which == 1 ? OFF_VDL : which == 2 ? OFF_KNL : OFF_VNL;
      src = sb + srow * 512 + c; dst = (bf16_t*)(ws + off) + drow * 512 + c;
    }
    const f32x4 a = *(const f32x4*)src, bq = *(const f32x4*)(src + 4);
    u32x4 t = {pack2(a[0], a[1]), pack2(a[2], a[3]), pack2(bq[0], bq[1]), pack2(bq[2], bq[3])};
    if (rep) { for (int h = 0; h < 8; ++h) *(u32x4*)(dst + h * 96) = t; }
    else *(u32x4*)dst = t;
  }
}

DI void ckv_phase(KP& p, int l) {
  const int vt_ = ltid(), lane = vt_ & 63, wv = vt_ >> 6;
  const float* mck = (const float*)(p.ws + OFF_MCKV);
  bf16_t* ca = (bf16_t*)(p.ws + OFF_CKVA);
  const f32x4 wn = *(const f32x4*)(p.kv_norm + l * 256 + 4 * lane);
  for (int r = VB() * 4 + wv; r < NTOK; r += VG() * 4) {
    const f32x4 v = *(const f32x4*)(mck + (size_t)r * 256 + 4 * lane);
    float ss = wave_sum(v[0] * v[0] + v[1] * v[1] + v[2] * v[2] + v[3] * v[3]);
    const float rstd = rsqrtf(ss * (1.f / 256.f) + EPSV);
    f32x4 o = {v[0] * rstd * wn[0], v[1] * rstd * wn[1], v[2] * rstd * wn[2], v[3] * rstd * wn[3]};
    u32x2 t = {pack2(o[0], o[1]), pack2(o[2], o[3])};
    *(u32x2*)(ca + (size_t)r * 256 + 4 * lane) = t;
    if (r < NCTX) { const int b = r >> 8, tt = r & 255; *(f32x4*)(p.out + OO_CKV + ((size_t)((b * 2 + l) * 256 + tt)) * 256 + 4 * lane) = o; }
  }
}

DI void merge_phase(KP& p, int l, char* smem) {
  char* wl = p.ws + l * SZ_WL;
  const bf16_t* h = (const bf16_t*)(p.ws + OFF_H);
  const bf16_t* Y = (const bf16_t*)(p.ws + OFF_Y);
  const bf16_t* wg = (const bf16_t*)(wl + WO_IN) + (size_t)NPROJ * 2048;
  const bf16_t* wb = (const bf16_t*)(wl + WO_BR);
  StoreBf16Epi epi{(bf16_t*)(p.ws + OFF_M), DM, 0};
  constexpr int nM = 96, nN = 16;
  for (int it = 0;; ++it) {
    int pm, pn;
    if (!tile_map(rtile_slot(it), nM, nN, 8, pm, pn)) break;
    f32x4 tot[8][2];
#pragma unroll
    for (int mi = 0; mi < 8; ++mi)
#pragma unroll
      for (int ni = 0; ni < 2; ++ni) tot[mi][ni] = (f32x4){0.f, 0.f, 0.f, 0.f};
 u32x4 ra[4], rb[2];
#pragma unroll 1
    for (int i = 0; i < 4; ++i) {
      const bf16_t* Ag = h + (size_t)pm * 256 * DM; const bf16_t* Bg = wg + ((size_t)i * 2048 + pn * 128) * 2048;
      const bf16_t* Ab = Y + (size_t)pm * 256 * DM + 512 * i; const bf16_t* Bb = wb + ((size_t)i * 2048 + pn * 128) * 512;
      const bf16_t* Bg2 = wg + ((size_t)(i < 3 ? i + 1 : i) * 2048 + pn * 128) * 2048;
      unsigned gp[4][2][2];
      char* park = smem + 114688 + rtid() * 64;
      {
        f32x4 ga[8][2];
#pragma unroll
        for (int mi = 0; mi < 8; ++mi)
#pragma unroll
          for (int ni = 0; ni < 2; ++ni) ga[mi][ni] = (f32x4){0.f, 0.f, 0.f, 0.f};
        gemm256_kloop<2>(ga, ra, rb, Ag, DM, Bg, 2048, 2048, Ab, DM, Bb, 512, i > 0, smem);
#pragma unroll
        for (int mi = 0; mi < 8; ++mi)
#pragma unroll
          for (int ni = 0; ni < 2; ++ni) {
            const unsigned g0 = pack2(sigmoidf_(ga[mi][ni][0]), sigmoidf_(ga[mi][ni][1]));
            const unsigned g1 = pack2(sigmoidf_(ga[mi][ni][2]), sigmoidf_(ga[mi][ni][3]));
            if (mi < 4) { u32x2 t = {g0, g1}; *(u32x2*)(park + (mi * 2 + ni) * 8) = t; }
            else { gp[mi - 4][ni][0] = g0; gp[mi - 4][ni][1] = g1; }
          }
      }
      f32x4 ba[8][2];
#pragma unroll
      for (int mi = 0; mi < 8; ++mi)
#pragma unroll
        for (int ni = 0; ni < 2; ++ni) ba[mi][ni] = (f32x4){0.f, 0.f, 0.f, 0.f};
      gemm256_kloop<2>(ba, ra, rb, Ab, DM, Bb, 512, 512, Ag, DM, Bg2, 2048, true, smem);
#pragma unroll
      for (int mi = 0; mi < 8; ++mi)
#pragma unroll
        for (int ni = 0; ni < 2; ++ni) {
          unsigned g0, g1;
          if (mi < 4) { const u32x2 t = *(const u32x2*)(park + (mi * 2 + ni) * 8); g0 = t[0]; g1 = t[1]; }
          else { g0 = gp[mi - 4][ni][0]; g1 = gp[mi - 4][ni][1]; }
          tot[mi][ni][0] += bflo(g0) * ba[mi][ni][0]; tot[mi][ni][1] += bfhi(g0) * ba[mi][ni][1];
          tot[mi][ni][2] += bflo(g1) * ba[mi][ni][2]; tot[mi][ni][3] += bfhi(g1) * ba[mi][ni][3];
        }
    }
    gemm256_epilogue<2>(tot, smem, pm * 256, pn * 128, epi);
  }
}

struct ConvW { float wa[3][8], wb[3][8], ba[8], bb[8]; };
DI void load_convw(ConvW& c, const float* cw, const float* cb, int chn) {
#pragma unroll
  for (int j = 0; j < 3; ++j)
#pragma unroll
    for (int e4 = 0; e4 < 2; ++e4) {
      const f32x4 x = *(const f32x4*)(cw + j * 11264 + chn + 4 * e4), y = *(const f32x4*)(cw + j * 11264 + FF + chn + 4 * e4);
#pragma unroll
      for (int e = 0; e < 4; ++e) { c.wa[j][4 * e4 + e] = x[e]; c.wb[j][4 * e4 + e] = y[e]; }
    }
#pragma unroll
  for (int e4 = 0; e4 < 2; ++e4) {
    const f32x4 x = *(const f32x4*)(cb + chn + 4 * e4), y = *(const f32x4*)(cb + FF + chn + 4 * e4);
#pragma unroll
    for (int e = 0; e < 4; ++e) { c.ba[4 * e4 + e] = x[e]; c.bb[4 * e4 + e] = y[e]; }
  }
}
DI void unpack8(const u32x4& v, float (&x)[8]) {
#pragma unroll
  for (int e = 0; e < 4; ++e) { x[2 * e] = bflo(v[e]); x[2 * e + 1] = bfhi(v[e]); }
}
DI u32x4 conv_out(const ConvW& c, const float (&pa)[8], const float (&pb)[8], const float (&ca)[8], const float (&cb_)[8],
                  const float (&na)[8], const float (&nb)[8]) {
  u32x4 o;
#pragma unroll
  for (int e = 0; e < 4; ++e) {
    float s[2];
#pragma unroll
    for (int q = 0; q < 2; ++q) {
      const int k = 2 * e + q;
      const float sa = c.ba[k] + c.wa[0][k] * pa[k] + c.wa[1][k] * ca[k] + c.wa[2][k] * na[k];
      const float sb = c.bb[k] + c.wb[0][k] * pb[k] + c.wb[1][k] * cb_[k] + c.wb[2][k] * nb[k];
      s[q] = sa * sigmoidf_(sa) * sb;
    }
    o[e] = pack2(s[0], s[1]);
  }
  return o;
}

constexpr size_t OFF_HALO = OFF_ACT + SZ_ACT;
static_assert(OFF_HALO + (size_t)96 * 4 * 11264 * 2 <= OFF_KVEND, "halo alias");

DI void up_phase(KP& p, int l, char* smem) {
  char* wl = p.ws + l * SZ_WL;
  const bf16_t* h = (const bf16_t*)(p.ws + OFF_H);
  const bf16_t* W = (const bf16_t*)(wl + WO_UP);
  bf16_t* act = (bf16_t*)(p.ws + OFF_ACT);
  bf16_t* halo = (bf16_t*)(p.ws + OFF_HALO);
  const float* cw = p.conv_w + (size_t)l * 3 * 11264;
  const float* cb = p.conv_b + (size_t)l * 11264;
  constexpr int CSB = 528;
  for (int it = 0;; ++it) {
    int pm, pn;
    if (!tile_map(rtile_slot(it), 96, 44, 8, pm, pn)) break;
    ConvW cwv;
    {
      f32x4 acc[8][4];
#pragma unroll
      for (int mi = 0; mi < 8; ++mi)
#pragma unroll
        for (int ni = 0; ni < 4; ++ni) acc[mi][ni] = (f32x4){0.f, 0.f, 0.f, 0.f};
      u32x4 ra[4], rb[4];
      const bf16_t* At = h + (size_t)pm * 256 * DM; const bf16_t* Bt = W + (size_t)pn * 256 * 2048;
      gemm256_kloop<4>(acc, ra, rb, At, DM, Bt, 2048, 2048, At, DM, Bt, 2048, false, smem);
      const int tid = rtid(), wid = tid >> 6, lane = tid & 63, wr = wid >> 2, wc = wid & 3, fr = lane & 15, fq = lane >> 4;
      load_convw(cwv, cw, cb, 64 * (2 * pn + ((tid & 15) >> 3)) + (tid & 7) * 8);
#pragma unroll
      for (int mi = 0; mi < 8; ++mi)
#pragma unroll
        for (int ni = 0; ni < 4; ++ni) {
          u32x2 t = {pack2(acc[mi][ni][0], acc[mi][ni][1]), pack2(acc[mi][ni][2], acc[mi][ni][3])};
          *(u32x2*)(smem + (128 * wr + 16 * mi + fr) * CSB + (64 * wc + 16 * ni + 4 * fq) * 2) = t;
        }
    }
    __syncthreads();
    const int tid = rtid();
    const bool top_edge = (pm < 32) || (((pm - 32) & 7) == 0), bot_edge = (pm < 32) || (((pm - 32) & 7) == 7);
    if (tid < 128) {
      const int hr = tid >> 5, c16 = tid & 31, row = hr < 2 ? hr : 252 + hr;
      *(u32x4*)(halo + ((size_t)(pm * 4 + hr)) * 11264 + pn * 256 + c16 * 8) = *(const u32x4*)(smem + row * CSB + c16 * 16);
    }
    {
      const int cu = tid & 15, rb = tid >> 4, g2 = cu >> 3, c8 = (cu & 7) * 8;
      const int chn = 64 * (2 * pn + g2) + c8;
      const ConvW& c = cwv;
      const char* col = smem + (128 * g2 + c8) * 2;
      float pa[8], pb[8], ca[8], cb_[8], na[8], nb[8];
      auto ldrow = [&](int r, float (&xa)[8], float (&xb)[8]) {
        if (r < 0 || r > 255) {
#pragma unroll
          for (int e = 0; e < 8; ++e) { xa[e] = 0.f; xb[e] = 0.f; }
        } else {
          unpack8(*(const u32x4*)(col + r * CSB), xa);
          unpack8(*(const u32x4*)(col + r * CSB + 128), xb);
        }
      };
      const int r0 = rb * 8;
      ldrow(r0 - 1, pa, pb);
      ldrow(r0, ca, cb_);
#pragma unroll
      for (int i = 0; i < 8; ++i) {
        const int r = r0 + i;
        ldrow(r + 1, na, nb);
        const bool defer = (r == 0 && !top_edge) || (r == 255 && !bot_edge);
        if (!defer) *(u32x4*)(act + ((size_t)pm * 256 + r) * FF + chn) = conv_out(c, pa, pb, ca, cb_, na, nb);
#pragma unroll
        for (int e = 0; e < 8; ++e) { pa[e] = ca[e]; pb[e] = cb_[e]; ca[e] = na[e]; cb_[e] = nb[e]; }
      }
    }
    __syncthreads();
  }
}

DI void fixup_phase(KP& p, int l) {
  const bf16_t* halo = (const bf16_t*)(p.ws + OFF_HALO);
  bf16_t* act = (bf16_t*)(p.ws + OFF_ACT);
  const float* cw = p.conv_w + (size_t)l * 3 * 11264;
  const float* cb = p.conv_b + (size_t)l * 11264;
  const int total = 56 * 2 * 704;
  for (int u = VB() * NTHR + ltid(); u < total; u += VG() * NTHR) {
    const int cu = u % 704, br = u / 704, which = br & 1, bd = br >> 1, seq = bd / 7, ti = bd % 7;
    const int pm = 32 + seq * 8 + ti;
    const int chn = cu * 8, g = chn >> 6, c = chn & 63;
    ConvW cwv; load_convw(cwv, cw, cb, chn);
    const bf16_t* rp = halo + ((size_t)(pm * 4 + (which ? 3 : 2))) * 11264 + 128 * g + c;
    const bf16_t* rc = halo + ((size_t)(which ? (pm + 1) * 4 + 0 : pm * 4 + 3)) * 11264 + 128 * g + c;
    const bf16_t* rn = halo + ((size_t)((pm + 1) * 4 + (which ? 1 : 0))) * 11264 + 128 * g + c;
    float pa[8], pb[8], ca[8], cb_[8], na[8], nb[8];
    unpack8(*(const u32x4*)rp, pa); unpack8(*(const u32x4*)(rp + 64), pb);
    unpack8(*(const u32x4*)rc, ca); unpack8(*(const u32x4*)(rc + 64), cb_);
    unpack8(*(const u32x4*)rn, na); unpack8(*(const u32x4*)(rn + 64), nb);
    const size_t row = which ? (size_t)(pm + 1) * 256 : (size_t)pm * 256 + 255;
    *(u32x4*)(act + row * FF + chn) = conv_out(cwv, pa, pb, ca, cb_, na, nb);
  }
}

DI void conv_phase(KP& p, int l, int g0, int ng) {
  const bf16_t* U = (const bf16_t*)(p.ws + OFF_U);
  bf16_t* act = (bf16_t*)(p.ws + OFF_ACT);
  const float* cw = p.conv_w + (size_t)l * 3 * 11264;
  const float* cb = p.conv_b + (size_t)l * 11264;
  const int upr = ng * 8, uw = ng * 128;
  const int total = (NTOK / 8) * upr;
  for (int u = VB() * NTHR + ltid(); u < total; u += VG() * NTHR) {
    const int rb = u / upr, w = u % upr, J = w >> 3, c8 = (w & 7) * 8;
    const int chn = 64 * (g0 + J) + c8, r0 = rb * 8;
    int t0, T;
    if (r0 < NCTX) { t0 = r0 & 255; T = 256; } else { t0 = (r0 - NCTX) & 2047; T = 2048; }
    float wa[3][8], wb[3][8], ba[8], bb[8];
#pragma unroll
    for (int j = 0; j < 3; ++j)
#pragma unroll
      for (int e4 = 0; e4 < 2; ++e4) {
        const f32x4 x = *(const f32x4*)(cw + j * 11264 + chn + 4 * e4), y = *(const f32x4*)(cw + j * 11264 + FF + chn + 4 * e4);
#pragma unroll
        for (int e = 0; e < 4; ++e) { wa[j][4 * e4 + e] = x[e]; wb[j][4 * e4 + e] = y[e]; }
      }
#pragma unroll
    for (int e4 = 0; e4 < 2; ++e4) {
      const f32x4 x = *(const f32x4*)(cb + chn + 4 * e4), y = *(const f32x4*)(cb + FF + chn + 4 * e4);
#pragma unroll
      for (int e = 0; e < 4; ++e) { ba[4 * e4 + e] = x[e]; bb[4 * e4 + e] = y[e]; }
    }
    const bf16_t* ua = U + (size_t)r0 * uw + 128 * J + c8;
    float pa[8], pb[8], ca[8], cb_[8], na[8], nb[8];
    auto ldrow = [&](int i, float (&xa)[8], float (&xb)[8]) {
      const int tt = t0 + i;
      if (tt < 0 || tt >= T) {
#pragma unroll
        for (int e = 0; e < 8; ++e) { xa[e] = 0.f; xb[e] = 0.f; }
      } else {
        const u32x4 av = *(const u32x4*)(ua + (ptrdiff_t)i * uw), bv = *(const u32x4*)(ua + (ptrdiff_t)i * uw + 64);
#pragma unroll
        for (int e = 0; e < 4; ++e) { xa[2 * e] = bflo(av[e]); xa[2 * e + 1] = bfhi(av[e]); xb[2 * e] = bflo(bv[e]); xb[2 * e + 1] = bfhi(bv[e]); }
      }
    };
    ldrow(-1, pa, pb);
    ldrow(0, ca, cb_);
#pragma unroll
    for (int i = 0; i < 8; ++i) {
      ldrow(i + 1, na, nb);
      u32x4 o;
#pragma unroll
      for (int e = 0; e < 4; ++e) {
        float s[2];
#pragma unroll
        for (int q = 0; q < 2; ++q) {
          const int c = 2 * e + q;
          const float sa = ba[c] + wa[0][c] * pa[c] + wa[1][c] * ca[c] + wa[2][c] * na[c];
          const float sb = bb[c] + wb[0][c] * pb[c] + wb[1][c] * cb_[c] + wb[2][c] * nb[c];
          s[q] = sa * sigmoidf_(sa) * sb;
        }
        o[e] = pack2(s[0], s[1]);
      }
      *(u32x4*)(act + (size_t)(r0 + i) * FF + chn) = o;
#pragma unroll
      for (int e = 0; e < 8; ++e) { pa[e] = ca[e]; pb[e] = cb_[e]; ca[e] = na[e]; cb_[e] = nb[e]; }
    }
  }
}

DI void final_phase(KP& p) {
  const int vt_ = ltid(), lane = vt_ & 63, wv = vt_ >> 6;
  for (int r = VB() * 4 + wv; r < NTOK; r += VG() * 4) {
    float* xr = p.out + (size_t)r * DM;
    f32x4 xv[8];
    float ss = 0.f;
#pragma unroll
    for (int i = 0; i < 8; ++i) { xv[i] = *(const f32x4*)(xr + 4 * (lane + 64 * i)); ss += xv[i][0] * xv[i][0] + xv[i][1] * xv[i][1] + xv[i][2] * xv[i][2] + xv[i][3] * xv[i][3]; }
    ss = wave_sum(ss);
    const float rstd = rsqrtf(ss * (1.f / DM) + EPSV);
#pragma unroll
    for (int i = 0; i < 8; ++i) {
      const int c = 4 * (lane + 64 * i);
      const f32x4 gv = *(const f32x4*)(p.g_final + c);
      f32x4 o = {xv[i][0] * rstd * gv[0], xv[i][1] * rstd * gv[1], xv[i][2] * rstd * gv[2], xv[i][3] * rstd * gv[3]};
      *(f32x4*)(xr + c) = o;
    }
  }
}

constexpr int LSTEPS = 11, NSTEPS = 2 + 2 * LSTEPS + 1;

DI void run_step(KP& p, int step, char* smem) {
  char* ws = p.ws;
  asm volatile("" : "+s"(ws));
  char* gsm = smem + vgrp() * GRP_LDS;
  if (step == 0) { prep_phase(p, gsm); return; }
  if (step == 1) { ada_reduce_phase(p); return; }
  if (step == NSTEPS - 1) { final_phase(p); return; }
  const int l = (step - 2) / LSTEPS, s = (step - 2) % LSTEPS;
  char* wl = ws + l * SZ_WL;
  const float* mod = (const float*)(ws + OFF_MOD) + (size_t)l * 9 * 12288;
  const bf16_t* h = (const bf16_t*)(ws + OFF_H);
  switch (s) {
    case 0: modulate_phase(p, l, 0, l == 0); cache_prep(p, l); break;
    case 1: {
      ProjEpi e; e.ws = ws; e.out = p.out; e.l = l;
      gemm256_phase(h, DM, (const bf16_t*)(wl + WO_IN), 2048, 2048, 96, 23, 0, e, smem);
    } break;
    case 2: ckv_phase(p, l); break;
    case 3: {
      UkvEpi e{ws};
      gemm256_phase((const bf16_t*)(ws + OFF_CKVA), 256, (const bf16_t*)(wl + WO_UKV), 256, 256, 112, 4, 0, e, smem);
    } break;
    case 4: attention_phase(p, l, gsm); break;
    case 5: merge_phase(p, l, smem); break;
    case 6: {
      ResidEpi e{l == 0 ? p.x_prompt : p.out, l == 0 ? p.x_sample : p.out + (size_t)NCTX * DM, p.out, mod + 2 * DM};
      gemm256_phase((const bf16_t*)(ws + OFF_M), DM, (const bf16_t*)(wl + WO_O), 2048, 2048, 96, 8, 0, e, smem);
    } break;
    case 7: modulate_phase(p, l, 1, false); break;
    case 8: up_phase(p, l, smem); break;
    case 9: fixup_phase(p, l); break;
    case 10: {
      ResidEpi e{p.out, p.out + (size_t)NCTX * DM, p.out, mod + 5 * DM};
      gemm256_phase((const bf16_t*)(ws + OFF_ACT), FF, (const bf16_t*)(wl + WO_DN), FF, FF, 96, 8, 0, e, smem);
    } break;
  }
}

#define XB_TMO      128
#define XB_XCNT(j)  (256  + 64 * (j))
#define XB_XSUB(j)  (1280 + 64 * (j))
#define XB_XGEN(j)  (2304 + 64 * (j))
#define XB_TOP      3328
#define XB_TOPGEN   3392
#define XCD_BAR_WORDS 3456
#define XB_SPIN_CAP (1u << 18)
#define LAS __attribute__((address_space(3)))

__device__ __forceinline__ unsigned xb_ld(unsigned* p)              { return __hip_atomic_load(p, __ATOMIC_RELAXED, __HIP_MEMORY_SCOPE_AGENT); }
__device__ __forceinline__ unsigned xb_add(unsigned* p, unsigned v) { return __hip_atomic_fetch_add(p, v, __ATOMIC_RELAXED, __HIP_MEMORY_SCOPE_AGENT); }
__device__ __forceinline__ unsigned xb_xcc_id() { return (unsigned)__builtin_amdgcn_s_getreg((3 << 11) | 20) & 0xFu; }
#define XB_SPIN(cond, bar) do { unsigned _sp = 0; while (cond) { __builtin_amdgcn_s_sleep(1); \
    if ((++_sp & 255u) == 0u) { if (xb_ld(&(bar)[XB_TMO])) break; if (_sp > XB_SPIN_CAP) { atomicAdd(&(bar)[XB_TMO], 1u); break; } } } } while (0)

struct XcdBarrier {
    unsigned* bar; unsigned x;
    volatile LAS unsigned* st;
};

__device__ __forceinline__ XcdBarrier xcd_barrier_post(unsigned* bar, volatile LAS unsigned* st) {
    XcdBarrier b; b.bar = bar; b.x = xb_xcc_id(); b.st = st;
    if (threadIdx.x == 0) (void)xb_add(&bar[XB_XCNT(b.x)], 1u);
    return b;
}
__device__ __forceinline__ void xcd_barrier_complete(unsigned* bar, unsigned x, unsigned& nloc, unsigned& nx) {
    const unsigned G = gridDim.x * gridDim.y * gridDim.z;
    unsigned sum, cnt, mine, sp = 0u;
    for (;;) {
        sum = 0u; cnt = 0u; mine = 0u;
#pragma unroll
        for (unsigned j = 0; j < 16; ++j) { const unsigned c = xb_ld(&bar[XB_XCNT(j)]); sum += c; cnt += (c > 0u) ? 1u : 0u; mine = (j == x) ? c : mine; }
        if (sum == G) break;
        __builtin_amdgcn_s_sleep(1);
        if ((++sp & 255u) == 0u) { if (xb_ld(&bar[XB_TMO])) break; if (sp > XB_SPIN_CAP) { atomicAdd(&bar[XB_TMO], 1u); break; } }
    }
    nloc = mine > 0u ? mine : 1u; nx = cnt > 0u ? cnt : 1u;
}

__device__ __forceinline__ void xcd_barrier(const XcdBarrier& b) {
    asm volatile("s_waitcnt vmcnt(0)" ::: "memory");
    __syncthreads();
    if (threadIdx.x == 0) {
        unsigned* bar = b.bar;
        __builtin_amdgcn_s_waitcnt(0);
        unsigned nloc = b.st[0], nx = b.st[1];
        if (nloc == 0u) { xcd_barrier_complete(bar, b.x, nloc, nx); b.st[0] = nloc; b.st[1] = nx; }
        const unsigned old = xb_add(&bar[XB_XSUB(b.x)], 1u);
        const unsigned gen = old / nloc;
        if (old + 1u == (gen + 1u) * nloc) {
            __builtin_amdgcn_fence(__ATOMIC_RELEASE, "agent");
            asm volatile("s_waitcnt vmcnt(0)" ::: "memory");
            const unsigned og = xb_add(&bar[XB_TOP], 1u);
            const unsigned tg = og / nx;
            if (og + 1u == (tg + 1u) * nx) xb_add(&bar[XB_TOPGEN], 1u);
            else XB_SPIN(xb_ld(&bar[XB_TOPGEN]) == tg, bar);
            __builtin_amdgcn_fence(__ATOMIC_ACQUIRE, "agent");
            xb_add(&bar[XB_XGEN(b.x)], 1u);
            asm volatile("s_waitcnt vmcnt(0)" ::: "memory");
        } else {
            XB_SPIN(xb_ld(&bar[XB_XGEN(b.x)]) == gen, bar);
            __builtin_amdgcn_fence(__ATOMIC_ACQUIRE, "agent");
            asm volatile("s_waitcnt vmcnt(0)" ::: "memory");
        }
    }
    __syncthreads();
}

extern "C" __global__ void __launch_bounds__(RTHR, 2) mega_kernel(Params p) {
  extern __shared__ __attribute__((aligned(16))) char smem[];
  __shared__ unsigned xb_words[4];
  cg::grid_group grid = cg::this_grid();
  if (threadIdx.x < 4) xb_words[threadIdx.x] = 0u;
  __syncthreads();
  XcdBarrier xb = xcd_barrier_post((unsigned*)(p.ws + OFF_BAR), (volatile LAS unsigned*)&xb_words);
  for (int s = p.step_lo; s < p.step_hi; ++s) {
    KP* pp = (KP*)__builtin_amdgcn_kernarg_segment_ptr();
    asm volatile("" : "+s"(pp));
    run_step(*pp, s, smem);
    if (s + 1 < p.step_hi) { if (s == p.step_lo) grid.sync(); else xcd_barrier(xb); }
  }
}

extern "C" void kernel_launch(void* const* d_in, const int* in_sizes, int n_in, void* d_out, int out_size, void* d_ws, size_t ws_size,
                              hipStream_t stream) {
  static int grid_blocks = 0;
  if (!grid_blocks) {
    int dev = 0, cus = 0, per_cu = 0;
    hipGetDevice(&dev);
    hipDeviceGetAttribute(&cus, hipDeviceAttributeMultiprocessorCount, dev);
    hipFuncSetAttribute((const void*)mega_kernel, hipFuncAttributeMaxDynamicSharedMemorySize, LDS_BYTES);
    hipOccupancyMaxActiveBlocksPerMultiprocessor(&per_cu, mega_kernel, RTHR, LDS_BYTES);
    if (per_cu != 1) per_cu = 1;
    grid_blocks = cus * per_cu;
  }
  if (ws_size < WS_NEED) { fprintf(stderr, "workspace too small: %zu < %zu\n", ws_size, (size_t)WS_NEED); return; }
  Params p{};
  const float** pf = (const float**)&p;
  for (int i = 0; i < 30; ++i) pf[i] = (const float*)d_in[i];
  p.out = (float*)d_out;
  p.ws = (char*)d_ws;
#if MULTI
  for (int s = 0; s < NSTEPS; ++s) {
    p.step_lo = s; p.step_hi = s + 1;
    hipLaunchKernelGGL(mega_kernel, dim3(grid_blocks), dim3(RTHR), LDS_BYTES, stream, p);
  }
#else
  p.step_lo = 0; p.step_hi = NSTEPS;
  (void)hipMemsetAsync((char*)d_ws + OFF_BAR, 0, 16384, stream);
  void* args[] = {&p};
  hipError_t e = hipLaunchCooperativeKernel((const void*)mega_kernel, dim3(grid_blocks), dim3(RTHR), args, LDS_BYTES, stream);
  if (e != hipSuccess) fprintf(stderr, "cooperative launch failed: %s (grid %d)\n", hipGetErrorString(e), grid_blocks);
#endif
}
```

```cpp
#include <hip/hip_runtime.h>
#include <hip/hip_cooperative_groups.h>
#include <cstdio>
namespace cg = cooperative_groups;

typedef unsigned short bf16_t;
typedef short bf16x8 __attribute__((ext_vector_type(8)));
typedef float f32x4 __attribute__((ext_vector_type(4)));
typedef float f32x16 __attribute__((ext_vector_type(16)));
typedef unsigned u32x4 __attribute__((ext_vector_type(4)));
typedef unsigned u32x2 __attribute__((ext_vector_type(2)));
#define DI __device__ __forceinline__
#ifndef MULTI
#define MULTI 0
#endif

constexpr int NTHR = 256;
constexpr int RTHR = 512;
constexpr int GRP_LDS = 73728;
constexpr int LDS_BYTES = 2 * GRP_LDS;
constexpr int DM = 2048, NTOK = 24576, NCTX = 8192, SLAT = 2560;
constexpr int NPROJ = 5888, NIN = 14080, FF = 5632, PQW = 3328;
constexpr float EPSV = 1e-6f, LOG2E = 1.4426950408889634f;

constexpr size_t SZ_WIN = (size_t)NIN * 2048 * 2, SZ_WBR = (size_t)4 * 2048 * 512 * 2, SZ_WO = (size_t)2048 * 2048 * 2,
                 SZ_WUP = (size_t)11264 * 2048 * 2, SZ_WDN = (size_t)2048 * 5632 * 2, SZ_WUKV = (size_t)1024 * 256 * 2;
constexpr size_t WO_IN = 0, WO_BR = WO_IN + SZ_WIN, WO_O = WO_BR + SZ_WBR, WO_UP = WO_O + SZ_WO, WO_DN = WO_UP + SZ_WUP, WO_UKV = WO_DN + SZ_WDN,
                 SZ_WL = WO_UKV + SZ_WUKV;
constexpr size_t OFF_MODP = 2 * SZ_WL, SZ_MODP = (size_t)16 * 2 * 9 * 12288 * 4;
constexpr size_t OFF_MOD = OFF_MODP + SZ_MODP, SZ_MOD = (size_t)2 * 9 * 12288 * 4;
constexpr size_t OFF_H = OFF_MOD + SZ_MOD, SZ_H = (size_t)NTOK * 2048 * 2;
constexpr size_t OFF_AR = OFF_H + SZ_H;
constexpr size_t OFF_Y = OFF_AR;
constexpr size_t OFF_PQ = OFF_Y + SZ_H, SZ_PQ = (size_t)NTOK * PQW * 2;
constexpr size_t OFF_MCKV = OFF_PQ + SZ_PQ, SZ_MCKV = (size_t)NTOK * 256 * 4;
constexpr size_t OFF_CKVA = OFF_MCKV + SZ_MCKV, SZ_CKVA = (size_t)28672 * 256 * 2;
constexpr size_t OFF_KV = OFF_CKVA + SZ_CKVA;
constexpr size_t NLROW = 8 * SLAT;
constexpr size_t OFF_KMC = OFF_KV, OFF_VMC = OFF_KMC + (size_t)NCTX * 768 * 2, OFF_KML = OFF_VMC + (size_t)NCTX * 512 * 2,
                 OFF_VML = OFF_KML + NLROW * 768 * 2, OFF_KDC = OFF_VML + NLROW * 512 * 2, OFF_VDC = OFF_KDC + (size_t)NCTX * 512 * 2,
                 OFF_KDL = OFF_VDC + (size_t)NCTX * 512 * 2, OFF_VDL = OFF_KDL + NLROW * 512 * 2, OFF_KNC = OFF_VDL + NLROW * 512 * 2,
                 OFF_VNC = OFF_KNC + (size_t)NCTX * 512 * 2, OFF_KNL = OFF_VNC + (size_t)NCTX * 512 * 2, OFF_VNL = OFF_KNL + NLROW * 512 * 2,
                 OFF_KVEND = OFF_VNL + NLROW * 512 * 2;
constexpr size_t OFF_M = OFF_KV;
static_assert(OFF_KVEND - OFF_KV >= SZ_H, "m alias");
constexpr size_t OFF_ACT = OFF_AR, SZ_ACT = (size_t)NTOK * FF * 2;
constexpr size_t OFF_U = OFF_ACT + SZ_ACT, SZ_U = (size_t)NTOK * 4352 * 2;
static_assert(OFF_U + SZ_U <= OFF_KVEND, "ffn alias");
constexpr size_t OFF_BAR = OFF_KVEND;
constexpr size_t WS_NEED = OFF_BAR + 16384;

constexpr size_t OO_Y = 0, OO_CKV = (size_t)NTOK * 2048, OO_KR = OO_CKV + 4194304, OO_DK = OO_KR + 524288, OO_DV = OO_DK + 8388608,
                 OO_NK = OO_DV + 8388608, OO_NV = OO_NK + 8388608, OO_RET = OO_NV + 8388608;

struct Params {
  const float *x_prompt, *x_sample, *c_ckv, *c_kr, *c_dk, *c_dv, *c_nk, *c_nv, *st_ret, *c, *c_ctx, *w_ada, *b_ada, *g_attn, *g_ffn, *w_in,
      *kv_norm, *w_ukv, *diff_lambda, *diff_norm, *na_bias, *ret_decay, *ret_norm, *w_branch, *w_o, *w_up, *conv_w, *conv_b, *w_down, *g_final;
  float* out;
  char* ws;
  int step_lo, step_hi;
};

typedef __attribute__((address_space(4))) const Params KP;
DI unsigned short f2bf(float f) { unsigned u = __float_as_uint(f); u += 0x7fffu + ((u >> 16) & 1u); return (unsigned short)(u >> 16); }
typedef __bf16 bf16v2_t __attribute__((ext_vector_type(2)));
typedef float f32v2_t __attribute__((ext_vector_type(2)));
DI unsigned pack2(float a, float b) { f32v2_t v = {a, b}; return __builtin_bit_cast(unsigned, __builtin_convertvector(v, bf16v2_t)); }
DI float bf2f(unsigned short h) { return __uint_as_float(((unsigned)h) << 16); }
DI float bflo(unsigned u) { return __uint_as_float(u << 16); }
DI float bfhi(unsigned u) { return __uint_as_float(u & 0xffff0000u); }
typedef __attribute__((address_space(1))) const u32x4 g_u32x4;
DI u32x4 gld16(const void* p) { return *(g_u32x4*)p; }
#define SCHED_FENCE() __builtin_amdgcn_sched_barrier(0)
DI int ltid() { int t = threadIdx.x; asm volatile("" : "+v"(t)); return t & 255; }
DI int rtid() { int t = threadIdx.x; asm volatile("" : "+v"(t)); return t; }
DI int vgrp() { return __builtin_amdgcn_readfirstlane((int)(threadIdx.x >> 8)); }
DI int VB() { return (int)blockIdx.x * 2 + vgrp(); }
DI int VG() { return (int)gridDim.x * 2; }
DI float shx(float v, int o) {
  int l = __builtin_amdgcn_mbcnt_hi(~0u, __builtin_amdgcn_mbcnt_lo(~0u, 0u));
  asm volatile("" : "+v"(l));
  return __int_as_float(__builtin_amdgcn_ds_bpermute((l ^ o) << 2, __float_as_int(v)));
}
DI float x32_max(float v) { auto r = __builtin_amdgcn_permlane32_swap(__float_as_uint(v), __float_as_uint(v), false, false); return fmaxf(__uint_as_float(r[0]), __uint_as_float(r[1])); }
DI float x32_sum(float v) { auto r = __builtin_amdgcn_permlane32_swap(__float_as_uint(v), __float_as_uint(v), false, false); return __uint_as_float(r[0]) + __uint_as_float(r[1]); }
DI float wave_sum(float v) {
#pragma unroll
  for (int o = 32; o >= 1; o >>= 1) v += shx(v, o);
  return v;
}
DI float sigmoidf_(float x) { return __builtin_amdgcn_rcpf(1.f + __builtin_amdgcn_exp2f(-1.4426950408889634f * x)); }
DI int grp_of(int r) { return r < NCTX ? 0 : 1 + ((r - NCTX) >> 11); }
DI int kvrow_of(int r) { int rr = r - NCTX; return (rr >> 11) * SLAT + (rr & 2047); }
DI const float* xrow_in(KP& p, int r) { return r < NCTX ? p.x_prompt + (size_t)r * DM : p.x_sample + (size_t)(r - NCTX) * DM; }

template <int WN>
DI void gemm_kloop(f32x4 (&acc)[4][WN], const bf16_t* __restrict__ A, int lda, const bf16_t* __restrict__ B, int ldb, int K, char* smem) {
  const int tid = ltid(), wid = tid >> 6, lane = tid & 63, wr = wid >> 1, wc = wid & 1, fr = lane & 15, fq = lane >> 4;
  const int r0 = tid >> 3, ch = tid & 7;
  const bf16_t* ap = A + (size_t)r0 * lda + ch * 8;
  const bf16_t* bp = B + (size_t)r0 * ldb + ch * 8;
  u32x4 ra0[4], rb0[WN], ra1[4], rb1[WN];
  const int nk = K >> 6;
  const int swz_w = (r0 >> 1) & 7, swz_r = (fr >> 1) & 7;
  char* sa = smem + r0 * 128 + ((ch ^ swz_w) * 16);
  char* sb = smem + 32768 + r0 * 128 + ((ch ^ swz_w) * 16);
  const char* fa = smem + (64 * wr + fr) * 128;
  const char* fb = smem + 32768 + (16 * WN * wc + fr) * 128;
  const int ko0 = ((fq ^ swz_r) * 16), ko1 = (((4 + fq) ^ swz_r) * 16);
  auto gload = [&](u32x4 (&RA)[4], u32x4 (&RB)[WN], int kt) {
#pragma unroll
    for (int i = 0; i < 4; ++i) RA[i] = gld16(ap + (size_t)(32 * i) * lda + kt * 64);
#pragma unroll
    for (int i = 0; i < WN; ++i) RB[i] = gld16(bp + (size_t)(32 * i) * ldb + kt * 64);
  };
  auto sstore = [&](const u32x4 (&RA)[4], const u32x4 (&RB)[WN], int buf) {
#pragma unroll
    for (int i = 0; i < 4; ++i) *(u32x4*)(sa + buf * 16384 + i * 32 * 128) = RA[i];
#pragma unroll
    for (int i = 0; i < WN; ++i) *(u32x4*)(sb + buf * 16384 + i * 32 * 128) = RB[i];
  };
  auto compute = [&](int buf) {
#pragma unroll
    for (int ks = 0; ks < 2; ++ks) {
      bf16x8 af[4], bfr[WN];
#pragma unroll
      for (int mi = 0; mi < 4; ++mi) af[mi] = *(const bf16x8*)(fa + buf * 16384 + mi * 16 * 128 + (ks ? ko1 : ko0));
#pragma unroll
      for (int ni = 0; ni < WN; ++ni) bfr[ni] = *(const bf16x8*)(fb + buf * 16384 + ni * 16 * 128 + (ks ? ko1 : ko0));
#pragma unroll
      for (int mi = 0; mi < 4; ++mi)
#pragma unroll
        for (int ni = 0; ni < WN; ++ni) acc[mi][ni] = __builtin_amdgcn_mfma_f32_16x16x32_bf16(bfr[ni], af[mi], acc[mi][ni], 0, 0, 0);
    }
  };
  auto step = [&](u32x4 (&RA)[4], u32x4 (&RB)[WN], int buf, int kt) {
    compute(buf);
    SCHED_FENCE();
    if (kt + 1 < nk) {
      sstore(RA, RB, buf ^ 1);
      if (kt + 3 < nk) gload(RA, RB, kt + 3);
    }
    SCHED_FENCE();
    __syncthreads();
  };
  gload(ra0, rb0, 0);
  gload(ra1, rb1, 1);
  __syncthreads();
  sstore(ra0, rb0, 0);
  gload(ra0, rb0, 2);
  SCHED_FENCE();
  __syncthreads();
#pragma unroll 1
  for (int kt = 0; kt < nk; kt += 2) {
    step(ra1, rb1, 0, kt);
    step(ra0, rb0, 1, kt + 1);
  }
}

template <int WN, class F>
DI void gemm_epilogue(const f32x4 (&acc)[4][WN], char* smem, int m0, int n0, const F& f) {
  constexpr int BN = 32 * WN, CS = BN + 4;
  const int tid = ltid(), wid = tid >> 6, lane = tid & 63, wr = wid >> 1, wc = wid & 1, fr = lane & 15, fq = lane >> 4;
  float* ct = (float*)smem;
#pragma unroll
  for (int mi = 0; mi < 4; ++mi)
#pragma unroll
    for (int ni = 0; ni < WN; ++ni) *(f32x4*)(ct + (64 * wr + 16 * mi + fr) * CS + 16 * WN * wc + 16 * ni + 4 * fq) = acc[mi][ni];
  __syncthreads();
  constexpr int CPR = BN / 32;
#pragma unroll 1
  for (int u = tid; u < 128 * CPR; u += NTHR) {
    const int row = u / CPR, chn = u % CPR;
    float v[32];
#pragma unroll
    for (int j = 0; j < 8; ++j) {
      f32x4 t = *(const f32x4*)(ct + row * CS + chn * 32 + 4 * j);
      v[4 * j] = t[0]; v[4 * j + 1] = t[1]; v[4 * j + 2] = t[2]; v[4 * j + 3] = t[3];
    }
    f(m0 + row, n0 + chn * 32, v);
  }
  __syncthreads();
}

DI void store_bf16_32(bf16_t* dst, const float (&v)[32]) {
#pragma unroll
  for (int j = 0; j < 4; ++j) {
    u32x4 t;
    t[0] = pack2(v[8 * j], v[8 * j + 1]); t[1] = pack2(v[8 * j + 2], v[8 * j + 3]);
    t[2] = pack2(v[8 * j + 4], v[8 * j + 5]); t[3] = pack2(v[8 * j + 6], v[8 * j + 7]);
    *(u32x4*)(dst + 8 * j) = t;
  }
}
DI void store_f32_32(float* dst, const float (&v)[32]) {
#pragma unroll
  for (int j = 0; j < 8; ++j) { f32x4 t = {v[4 * j], v[4 * j + 1], v[4 * j + 2], v[4 * j + 3]}; *(f32x4*)(dst + 4 * j) = t; }
}


DI bool tile_map(int t, int nM, int nN, int PMS, int& pm, int& pn) {
  if (t >= nM * nN) return false;
  const int per_g = PMS * nN, g = t / per_g, r = t % per_g, j = r / (4 * PMS), q = r - j * 4 * PMS;
  pm = PMS * g + (q % PMS); pn = 4 * j + (q / PMS);
  return true;
}
DI int vtile_slot(int i) { const int b = blockIdx.x; return (i * 8 + (b & 7)) * ((int)(gridDim.x >> 3) * 2) + (b >> 3) * 2 + vgrp(); }
DI int rtile_slot(int i) { const int b = blockIdx.x; return (i * 8 + (b & 7)) * (int)(gridDim.x >> 3) + (b >> 3); }

template <int NI>
DI void gemm256_kloop(f32x4 (&acc)[8][NI], u32x4 (&ra)[4], u32x4 (&rb)[NI], const bf16_t* __restrict__ A, int lda, const bf16_t* __restrict__ B, int ldb, int K,
                      const bf16_t* __restrict__ An, int ldan, const bf16_t* __restrict__ Bn, int ldbn, bool chained, char* smem) {
  const int tid = rtid(), wid = tid >> 6, lane = tid & 63, wr = wid >> 2, wc = wid & 3, fr = lane & 15, fq = lane >> 4;
  const int r0 = tid >> 3, ch = tid & 7;
  const bf16_t* ap = A + (size_t)r0 * lda + ch * 8;
  const bf16_t* bp = B + (size_t)r0 * ldb + ch * 8;
  const bf16_t* apn = An + (size_t)r0 * ldan + ch * 8;
  const bf16_t* bpn = Bn + (size_t)r0 * ldbn + ch * 8;
  const int nk = K >> 6;
  const int swz_w = (r0 >> 1) & 7, swz_r = (fr >> 1) & 7;
  char* sa = smem + r0 * 128 + ((ch ^ swz_w) * 16);
  char* sb = smem + 65536 + r0 * 128 + ((ch ^ swz_w) * 16);
  const char* fa = smem + (128 * wr + fr) * 128;
  const char* fb = smem + 65536 + (16 * NI * wc + fr) * 128;
  const int ko0 = ((fq ^ swz_r) * 16), ko1 = (((4 + fq) ^ swz_r) * 16);
  auto gload = [&](int kt) {
#pragma unroll
    for (int i = 0; i < 4; ++i) ra[i] = gld16(ap + (size_t)(64 * i) * lda + kt * 64);
#pragma unroll
    for (int i = 0; i < NI; ++i) rb[i] = gld16(bp + (size_t)(64 * i) * ldb + kt * 64);
  };
  auto sstore = [&](int buf) {
#pragma unroll
    for (int i = 0; i < 4; ++i) *(u32x4*)(sa + buf * 32768 + i * 64 * 128) = ra[i];
#pragma unroll
    for (int i = 0; i < NI; ++i) *(u32x4*)(sb + buf * 32768 + i * 64 * 128) = rb[i];
  };
  if (!chained) {
    gload(0);
    __syncthreads();
    sstore(0);
    gload(1);
    SCHED_FENCE();
    __syncthreads();
  }
  auto half = [&](int buf, int ks, bool refill, int ktn, bool nxt) {
    const char* pa = fa + buf * 32768 + (ks ? ko1 : ko0);
    const char* pb = fb + buf * 32768 + (ks ? ko1 : ko0);
    constexpr int RD = (NI == 4) ? 2 : 4;
    bf16x8 bfr[NI], ar[RD];
#pragma unroll
    for (int ni = 0; ni < NI; ++ni) bfr[ni] = *(const bf16x8*)(pb + ni * 2048);
#pragma unroll
    for (int d = 0; d < RD; ++d) ar[d] = *(const bf16x8*)(pa + d * 2048);
#pragma unroll
    for (int mi = 0; mi < 8; ++mi) {
#pragma unroll
      for (int ni = 0; ni < NI; ++ni) acc[mi][ni] = __builtin_amdgcn_mfma_f32_16x16x32_bf16(bfr[ni], ar[mi % RD], acc[mi][ni], 0, 0, 0);
      if (mi + RD < 8) ar[mi % RD] = *(const bf16x8*)(pa + (mi + RD) * 2048);
      if ((mi & 1) == 0) {
        const int pc = mi >> 1;
        if (ks == 0) {
          *(u32x4*)(sa + (buf ^ 1) * 32768 + pc * 64 * 128) = ra[pc];
          ra[pc] = gld16(nxt ? apn + (size_t)(64 * pc) * ldan + ktn * 64 : ap + (size_t)(64 * pc) * lda + ktn * 64);
        } else if (pc < NI) {
          *(u32x4*)(sb + (buf ^ 1) * 32768 + pc * 64 * 128) = rb[pc];
          rb[pc] = gld16(nxt ? bpn + (size_t)(64 * pc) * ldbn + ktn * 64 : bp + (size_t)(64 * pc) * ldb + ktn * 64);
        }
      }
    }
    __builtin_amdgcn_sched_group_barrier(0x100, NI + RD, 0);
#pragma unroll
    for (int mi = 0; mi < 8; ++mi) {
      __builtin_amdgcn_sched_group_barrier(0x008, NI, 0);
      if (mi + RD < 8) __builtin_amdgcn_sched_group_barrier(0x100, 1, 0);
      if ((mi & 1) == 0 && (ks == 0 || (mi >> 1) < NI)) { __builtin_amdgcn_sched_group_barrier(0x200, 1, 0); __builtin_amdgcn_sched_group_barrier(0x020, 1, 0); }
    }
  };
#pragma unroll 1
  for (int kt = 0; kt < nk; ++kt) {
    const int buf = kt & 1;
    const bool nxt = kt + 2 >= nk;
    const int ktn = nxt ? kt + 2 - nk : kt + 2;
    half(buf, 0, true, ktn, nxt);
    half(buf, 1, true, ktn, nxt);
    __syncthreads();
  }
}

template <int NI, class F>
DI void gemm256_epilogue(const f32x4 (&acc)[8][NI], char* smem, int m0, int n0, const F& f) {
  constexpr int CSB = NI * 128 + 16, CPR = NI * 2;
  const int tid = rtid(), wid = tid >> 6, lane = tid & 63, wr = wid >> 2, wc = wid & 3, fr = lane & 15, fq = lane >> 4;
#pragma unroll
  for (int mi = 0; mi < 8; ++mi)
#pragma unroll
    for (int ni = 0; ni < NI; ++ni) {
      u32x2 t = {pack2(acc[mi][ni][0], acc[mi][ni][1]), pack2(acc[mi][ni][2], acc[mi][ni][3])};
      *(u32x2*)(smem + (128 * wr + 16 * mi + fr) * CSB + (16 * NI * wc + 16 * ni + 4 * fq) * 2) = t;
    }
  __syncthreads();
#pragma unroll 1
  for (int u = tid; u < 256 * CPR; u += RTHR) {
    const int row = u / CPR, chn = u % CPR;
    float v[32];
#pragma unroll
    for (int j = 0; j < 4; ++j) {
      const u32x4 t = *(const u32x4*)(smem + row * CSB + chn * 64 + 16 * j);
#pragma unroll
      for (int e = 0; e < 4; ++e) { v[8 * j + 2 * e] = bflo(t[e]); v[8 * j + 2 * e + 1] = bfhi(t[e]); }
    }
    f(m0 + row, n0 + chn * 32, v);
  }
  __syncthreads();
}

struct ResidEpi;
template <int NI>
DI void gemm256_epilogue(const f32x4 (&acc)[8][NI], char* smem, int m0, int n0, const ResidEpi& f);

template <class F>
DI void gemm256_phase(const bf16_t* A, int lda, const bf16_t* B, int ldb, int K, int nM, int nN, int pn_base, const F& f, char* smem) {
  for (int it = 0;; ++it) {
    int pm, pn;
    if (!tile_map(rtile_slot(it), nM, nN, 8, pm, pn)) break;
    pn += pn_base;
    f32x4 acc[8][4];
#pragma unroll
    for (int mi = 0; mi < 8; ++mi)
#pragma unroll
      for (int ni = 0; ni < 4; ++ni) acc[mi][ni] = (f32x4){0.f, 0.f, 0.f, 0.f};
    u32x4 ra[4], rb[4];
    const bf16_t* At = A + (size_t)pm * 256 * lda; const bf16_t* Bt = B + (size_t)pn * 256 * ldb;
    gemm256_kloop<4>(acc, ra, rb, At, lda, Bt, ldb, K, At, lda, Bt, ldb, false, smem);
    gemm256_epilogue<4>(acc, smem, pm * 256, pn * 256, f);
  }
}

template <int NF>
DI void rope_seg(float* v, float pos) {
#pragma unroll
  for (int f = 0; f < NF; ++f) {
    const float inv = exp2f(-(float)f / (float)NF * 13.287712379549449f) * 0.15915494309189535f;
    const float rev = pos * inv;
    const float cs = __builtin_amdgcn_cosf(rev), sn = __builtin_amdgcn_sinf(rev);
    const float a = v[f], b = v[NF + f];
    v[f] = a * cs - b * sn;
    v[NF + f] = b * cs + a * sn;
  }
}

struct ProjEpi {
  char* ws; float* out; int l;
  DI void state_out(size_t base, int W, int r, int c, const float (&v)[32]) const {
    const int b = r >> 8, t = r & 255;
    store_f32_32(out + base + ((size_t)((b * 2 + l) * 256 + t)) * W + c, v);
  }
  DI void operator()(int r, int c0, float (&v)[32]) const {
    bf16_t* const pq = (bf16_t*)(ws + OFF_PQ); bf16_t* const kmc = (bf16_t*)(ws + OFF_KMC); bf16_t* const kml = (bf16_t*)(ws + OFF_KML);
    bf16_t* const kdc = (bf16_t*)(ws + OFF_KDC); bf16_t* const vdc = (bf16_t*)(ws + OFF_VDC); bf16_t* const kdl = (bf16_t*)(ws + OFF_KDL);
    bf16_t* const vdl = (bf16_t*)(ws + OFF_VDL); bf16_t* const knc = (bf16_t*)(ws + OFF_KNC); bf16_t* const vnc = (bf16_t*)(ws + OFF_VNC);
    bf16_t* const knl = (bf16_t*)(ws + OFF_KNL); bf16_t* const vnl = (bf16_t*)(ws + OFF_VNL); float* const mckv = (float*)(ws + OFF_MCKV);
    const bool lat = r >= NCTX;
    int prow = 0, pcol = 0;
    if (lat) { const int t = (r - NCTX) & 2047; prow = t >> 6; pcol = t & 63; }
    if (c0 < 768) {
      if (lat && (c0 % 96) == 64) { rope_seg<8>(v, (float)prow); rope_seg<8>(v + 16, (float)pcol); }
      store_bf16_32(pq + (size_t)r * PQW + c0, v);
    } else if (c0 < 1024) {
      store_f32_32(mckv + (size_t)r * 256 + (c0 - 768), v);
    } else if (c0 < 1536) {
      if (lat) rope_seg<16>(v, (float)((((c0 - 1024) >> 5) & 1) ? pcol : prow));
      store_bf16_32(pq + (size_t)r * PQW + 768 + (c0 - 1024), v);
    } else if (c0 < 2048) {
      const int c = c0 - 1536;
      if (lat) { rope_seg<16>(v, (float)(((c >> 5) & 1) ? pcol : prow)); store_bf16_32(kdl + (size_t)kvrow_of(r) * 512 + c, v); }
      else { store_bf16_32(kdc + (size_t)r * 512 + c, v); state_out(OO_DK, 512, r, c, v); }
    } else if (c0 < 2560) {
      const int c = c0 - 2048;
      if (lat) store_bf16_32(vdl + (size_t)kvrow_of(r) * 512 + c, v);
      else { store_bf16_32(vdc + (size_t)r * 512 + c, v); state_out(OO_DV, 512, r, c, v); }
    } else if (c0 < 3072) {
      store_bf16_32(pq + (size_t)r * PQW + 1280 + (c0 - 2560), v);
    } else if (c0 < 3584) {
      const int c = c0 - 3072;
      if (lat) store_bf16_32(knl + (size_t)kvrow_of(r) * 512 + c, v);
      else { store_bf16_32(knc + (size_t)r * 512 + c, v); state_out(OO_NK, 512, r, c, v); }
    } else if (c0 < 4096) {
      const int c = c0 - 3584;
      if (lat) store_bf16_32(vnl + (size_t)kvrow_of(r) * 512 + c, v);
      else { store_bf16_32(vnc + (size_t)r * 512 + c, v); state_out(OO_NV, 512, r, c, v); }
    } else if (c0 < 5632) {
      store_bf16_32(pq + (size_t)r * PQW + 1792 + (c0 - 4096), v);
    } else if (c0 == 5632) {
      bf16_t* dst;
      if (lat) { rope_seg<8>(v, (float)prow); rope_seg<8>(v + 16, (float)pcol); dst = kml + (size_t)kvrow_of(r) * 768; }
      else { state_out(OO_KR, 32, r, 0, v); dst = kmc + (size_t)r * 768; }
#pragma unroll 1
      for (int h = 0; h < 8; ++h) store_bf16_32(dst + h * 96 + 64, v);
    }
  }
};

struct UkvEpi {
  char* ws;
  DI void operator()(int R, int c0, float (&v)[32]) const {
    size_t row, ko, vo;
    if (R < NCTX) { ko = OFF_KMC; vo = OFF_VMC; row = R; }
    else if (R < NTOK) { ko = OFF_KML; vo = OFF_VML; row = kvrow_of(R); }
    else { const int c = R - NTOK; ko = OFF_KML; vo = OFF_VML; row = (size_t)(c >> 9) * SLAT + 2048 + (c & 511); }
    const int hd = c0 >> 7, e = c0 & 127;
    if (e < 64) store_bf16_32((bf16_t*)(ws + ko) + row * 768 + hd * 96 + e, v);
    else store_bf16_32((bf16_t*)(ws + vo) + row * 512 + hd * 64 + (e - 64), v);
  }
};

struct StoreBf16Epi {
  bf16_t* dst; int ld; int coff;
  DI void operator()(int r, int c0, float (&v)[32]) const { store_bf16_32(dst + (size_t)r * ld + (c0 - coff), v); }
};

struct ResidEpi {
  const float* xp; const float* xs; float* out; const float* ga;
  DI void operator()(int r, int c0, float (&v)[32]) const {
    const float* xr = (r < NCTX ? xp + (size_t)r * DM : xs + (size_t)(r - NCTX) * DM) + c0;
    const float* g = ga + (size_t)grp_of(r) * 12288 + c0;
    float* o = out + (size_t)r * DM + c0;
#pragma unroll
    for (int j = 0; j < 8; ++j) {
      const f32x4 xv = *(const f32x4*)(xr + 4 * j), gv = *(const f32x4*)(g + 4 * j);
      f32x4 t = {xv[0] + gv[0] * v[4 * j], xv[1] + gv[1] * v[4 * j + 1], xv[2] + gv[2] * v[4 * j + 2], xv[3] + gv[3] * v[4 * j + 3]};
      *(f32x4*)(o + 4 * j) = t;
    }
  }
};

template <int NI>
DI void gemm256_epilogue(const f32x4 (&acc)[8][NI], char* smem, int m0, int n0, const ResidEpi& f) {
  constexpr int CSB = NI * 128 + 16, CPR = NI * 2, NU = 256 * CPR / RTHR;
  const int tid = rtid(), wid = tid >> 6, lane = tid & 63, wr = wid >> 2, wc = wid & 3, fr = lane & 15, fq = lane >> 4;
#pragma unroll
  for (int mi = 0; mi < 8; ++mi)
#pragma unroll
    for (int ni = 0; ni < NI; ++ni) {
      u32x2 t = {pack2(acc[mi][ni][0], acc[mi][ni][1]), pack2(acc[mi][ni][2], acc[mi][ni][3])};
      *(u32x2*)(smem + (128 * wr + 16 * mi + fr) * CSB + (16 * NI * wc + 16 * ni + 4 * fq) * 2) = t;
    }
  f32x4 xv[NU][8];
#pragma unroll
  for (int ui = 0; ui < NU; ++ui) {
    const int u = tid + ui * RTHR, r = m0 + u / CPR, c0 = n0 + (u % CPR) * 32;
    const float* xr = (r < NCTX ? f.xp + (size_t)r * DM : f.xs + (size_t)(r - NCTX) * DM) + c0;
#pragma unroll
    for (int j = 0; j < 8; ++j) xv[ui][j] = *(const f32x4*)(xr + 4 * j);
  }
  __syncthreads();
#pragma unroll
  for (int ui = 0; ui < NU; ++ui) {
    const int u = tid + ui * RTHR, row = u / CPR, chn = u % CPR, r = m0 + row, c0 = n0 + chn * 32;
    const float* g = f.ga + (size_t)grp_of(r) * 12288 + c0;
    float* o = f.out + (size_t)r * DM + c0;
#pragma unroll
    for (int j = 0; j < 4; ++j) {
      const u32x4 t = *(const u32x4*)(smem + row * CSB + chn * 64 + 16 * j);
      const f32x4 g0 = *(const f32x4*)(g + 8 * j), g1 = *(const f32x4*)(g + 8 * j + 4);
      const f32x4 x0 = xv[ui][2 * j], x1 = xv[ui][2 * j + 1];
      f32x4 o0 = {x0[0] + g0[0] * bflo(t[0]), x0[1] + g0[1] * bfhi(t[0]), x0[2] + g0[2] * bflo(t[1]), x0[3] + g0[3] * bfhi(t[1])};
      f32x4 o1 = {x1[0] + g1[0] * bflo(t[2]), x1[1] + g1[1] * bfhi(t[2]), x1[2] + g1[2] * bflo(t[3]), x1[3] + g1[3] * bfhi(t[3])};
      *(f32x4*)(o + 8 * j) = o0;
      *(f32x4*)(o + 8 * j + 4) = o1;
    }
  }
  __syncthreads();
}

struct AttnArgs {
  const bf16_t *q, *k, *v; int q_ld, k_ld, v_ld; int n_keys; float sl2;
  bf16_t* y; int y_ld;
  int R0; const float* bias;
  int t0, T; float lgf, lgb; const float *s0f, *s0b; const bf16_t* rg; int rg_ld; const float* nw;
  float lam, omli;
};

constexpr int A_VT = 13312, A_BIAS = 30720, A_S0 = 32768;

template <int DQ, int DV, int MODE>
DI void attn_block(char* smem, const AttnArgs& a) {
  constexpr int KSTR = (DQ + 8) * 2, CK = DQ / 8, NKL = 64 * CK / NTHR, NVL = (32 * DV / 8) / NTHR, NKS = DQ / 16, NDB = DV / 32;
  const int tid = ltid(), w = tid >> 6, lane = tid & 63, ql = lane & 31, g = lane >> 5;
  const int qloc = 32 * w + ql;
  f32x16 O[NDB];
  float m_run = -1e30f, l_run = 0.f;
#pragma unroll
  for (int d = 0; d < NDB; ++d)
#pragma unroll
    for (int i = 0; i < 16; ++i) O[d][i] = 0.f;

  int na_r = 0, na_c = 0, na_rs = 0, na_cs = 0, rlo = 0, nloc = 0;
  if (MODE == 1) {
    na_r = a.R0 + (w >> 1); na_c = 32 * (w & 1) + ql;
    na_rs = min(max(na_r - 4, 0), 24); na_cs = min(max(na_c - 8, 0), 48);
    rlo = min(max(a.R0 - 4, 0), 24);
    nloc = 9;
    __syncthreads();
    float* bl = (float*)(smem + A_BIAS);
    for (int i = tid; i < 465; i += NTHR) bl[i] = a.bias[i] * LOG2E;
  }
  const int npass = (MODE == 3) ? 2 : 1;
  const int ntile = (MODE == 1) ? (nloc + 8) : (a.n_keys >> 6);
  const int t_q = a.t0 + qloc;

  bf16x8 qf[NKS];
  u32x4 rk[NKL], rv0[NVL], rv1[NVL];

  auto key0_of = [&](int it) -> int {
    if (MODE == 1) return it < nloc ? (rlo + it) * 64 : 2048 + 64 * (it - nloc);
    return it * 64;
  };
  auto prefetch = [&](int it, int pass) {
    const int key0 = key0_of(it);
    const bf16_t* kp = a.k + (MODE == 3 ? pass * 64 : 0);
#pragma unroll
    for (int i = 0; i < NKL; ++i) { const int idx = tid + NTHR * i, row = idx / CK, c = idx % CK; rk[i] = gld16(kp + (size_t)(key0 + row) * a.k_ld + 8 * c); }
#pragma unroll
    for (int i = 0; i < NVL; ++i) {
      const int idx = tid + NTHR * i, pr = idx & 31, c = idx >> 5;
      rv0[i] = gld16(a.v + (size_t)(key0 + 2 * pr) * a.v_ld + 8 * c);
      rv1[i] = gld16(a.v + (size_t)(key0 + 2 * pr + 1) * a.v_ld + 8 * c);
    }
  };
  auto stage = [&]() {
#pragma unroll
    for (int i = 0; i < NKL; ++i) { const int idx = tid + NTHR * i, row = idx / CK, c = idx % CK; *(u32x4*)(smem + row * KSTR + 16 * c) = rk[i]; }
#pragma unroll
    for (int i = 0; i < NVL; ++i) {
      const int idx = tid + NTHR * i, pr = idx & 31, c = idx >> 5;
      char* base = smem + A_VT + (8 * c) * 136 + 4 * pr;
#pragma unroll
      for (int e = 0; e < 4; ++e) {
        const unsigned x = rv0[i][e], y = rv1[i][e];
        *(unsigned*)(base + (2 * e) * 136) = (x & 0xffffu) | (y << 16);
        *(unsigned*)(base + (2 * e + 1) * 136) = (x >> 16) | (y & 0xffff0000u);
      }
    }
  };

#pragma unroll 1
  for (int pass = 0; pass < npass; ++pass) {
    {
      const bf16_t* qp = a.q + (MODE == 3 ? pass * 64 : 0) + (size_t)qloc * a.q_ld + 8 * g;
#pragma unroll
      for (int ks = 0; ks < NKS; ++ks) qf[ks] = *(const bf16x8*)(qp + 16 * ks);
    }
    prefetch(0, pass);
#pragma unroll 1
    for (int it = 0; it < ntile; ++it) {
      __syncthreads();
      stage();
      __syncthreads();
      if (it + 1 < ntile) prefetch(it + 1, pass);
      SCHED_FENCE();
      const int key0 = key0_of(it);
      bool active = true;
      int kr = 0;
      const bool local = (MODE == 1) && it < nloc;
      if (local) { kr = rlo + it; active = (kr >= na_rs) && (kr < na_rs + 8); }
      if (active) {
#pragma unroll
        for (int kb = 0; kb < 2; ++kb) {
          f32x16 s;
#pragma unroll
          for (int i = 0; i < 16; ++i) s[i] = 0.f;
          bf16x8 kfr[NKS];
#pragma unroll
          for (int ks = 0; ks < NKS; ++ks) kfr[ks] = *(const bf16x8*)(smem + (32 * kb + ql) * KSTR + (16 * ks + 8 * g) * 2);
          u32x4 vfr[NDB][2];
#pragma unroll
          for (int d = 0; d < NDB; ++d)
#pragma unroll
            for (int h2 = 0; h2 < 2; ++h2) {
              const char* vp = smem + A_VT + (32 * d + ql) * 136 + (32 * kb + 16 * h2 + 4 * g) * 2;
              const u32x2 lo = *(const u32x2*)vp, hi = *(const u32x2*)(vp + 16);
              vfr[d][h2] = (u32x4){lo[0], lo[1], hi[0], hi[1]};
            }
          SCHED_FENCE();
#pragma unroll
          for (int ks = 0; ks < NKS; ++ks) s = __builtin_amdgcn_mfma_f32_32x32x16_bf16(kfr[ks], qf[ks], s, 0, 0, 0);
          float p[16];
          if (MODE == 2) {
#pragma unroll
            for (int i = 0; i < 16; ++i) {
              const int j = key0 + 32 * kb + 8 * (i >> 2) + 4 * g + (i & 3);
              const int d = t_q - j;
              const float e = d >= 0 ? (float)d * a.lgf : (float)(-d) * a.lgb;
              p[i] = s[i] * a.sl2 * __builtin_amdgcn_exp2f(e);
            }
          } else {
            if (local) {
              const float* bl = (const float*)(smem + A_BIAS) + (kr - na_r + 7) * 31 + 15;
#pragma unroll
              for (int i = 0; i < 16; ++i) {
                const int kc = 32 * kb + 8 * (i >> 2) + 4 * g + (i & 3);
                const int dc = min(max(kc - na_c, -15), 15);
                const bool ok = (kc >= na_cs) && (kc < na_cs + 16);
                p[i] = ok ? (s[i] * a.sl2 + bl[dc]) : -1e30f;
              }
            }
            float mx;
            if (local) {
              mx = p[0];
#pragma unroll
              for (int i = 1; i < 16; ++i) mx = fmaxf(mx, p[i]);
            } else {
              mx = s[0];
#pragma unroll
              for (int i = 1; i < 16; ++i) mx = fmaxf(mx, s[i]);
              mx *= a.sl2;
            }
            mx = x32_max(mx);
            const float m_new = fmaxf(m_run, mx);
            const float alpha = __builtin_amdgcn_exp2f(m_run - m_new);
            m_run = m_new;
            float ls = 0.f;
            if (local) {
#pragma unroll
              for (int i = 0; i < 16; ++i) { p[i] = __builtin_amdgcn_exp2f(p[i] - m_new); ls += p[i]; }
            } else {
#pragma unroll
              for (int i = 0; i < 16; ++i) { p[i] = __builtin_amdgcn_exp2f(__builtin_fmaf(s[i], a.sl2, -m_new)); ls += p[i]; }
            }
            l_run = l_run * alpha + ls;
            if (__ballot(alpha != 1.f) != 0ull) {
#pragma unroll
              for (int d = 0; d < NDB; ++d)
#pragma unroll
                for (int i = 0; i < 16; ++i) O[d][i] *= alpha;
            }
          }
          bf16x8 pf[2];
#pragma unroll
          for (int h2 = 0; h2 < 2; ++h2) {
            u32x4 t;
#pragma unroll
            for (int e = 0; e < 4; ++e) t[e] = pack2(p[8 * h2 + 2 * e], p[8 * h2 + 2 * e + 1]);
            pf[h2] = __builtin_bit_cast(bf16x8, t);
          }
#pragma unroll
          for (int d = 0; d < NDB; ++d)
#pragma unroll
            for (int h2 = 0; h2 < 2; ++h2) {
              O[d] = __builtin_amdgcn_mfma_f32_32x32x16_bf16(__builtin_bit_cast(bf16x8, vfr[d][h2]), pf[h2], O[d], 0, 0, 0);
            }
        }
      }
    }
    if (MODE == 3 && pass == 0) {
      const float lt = x32_sum(l_run);
      const float inv = 1.f / lt;
#pragma unroll
      for (int d = 0; d < NDB; ++d)
#pragma unroll
        for (int i4 = 0; i4 < 4; ++i4) {
          u32x2 t = {pack2(O[d][4 * i4] * inv, O[d][4 * i4 + 1] * inv), pack2(O[d][4 * i4 + 2] * inv, O[d][4 * i4 + 3] * inv)};
          *(u32x2*)(smem + A_S0 + qloc * 264 + (32 * d + 8 * i4 + 4 * g) * 2) = t;
          O[d][4 * i4] = 0.f; O[d][4 * i4 + 1] = 0.f; O[d][4 * i4 + 2] = 0.f; O[d][4 * i4 + 3] = 0.f;
        }
      m_run = -1e30f; l_run = 0.f;
    }
  }

  if (MODE == 2 && a.s0f != nullptr) {
#pragma unroll 1
    for (int dir = 0; dir < 2; ++dir) {
      const float* s0 = dir ? a.s0b : a.s0f;
      __syncthreads();
      for (int idx = tid; idx < 64 * 32; idx += NTHR) {
        const int dk = idx >> 5, dv4 = (idx & 31) * 4;
        const f32x4 t = *(const f32x4*)(s0 + dk * 128 + dv4);
#pragma unroll
        for (int e = 0; e < 4; ++e) *(bf16_t*)(smem + A_S0 + (dv4 + e) * 144 + dk * 2) = f2bf(t[e]);
      }
      __syncthreads();
      const float sc = dir ? __builtin_amdgcn_exp2f((float)(a.T - t_q) * a.lgb) : __builtin_amdgcn_exp2f((float)(t_q + 1) * a.lgf);
#pragma unroll
      for (int d = 0; d < NDB; ++d) {
        f32x16 tacc;
#pragma unroll
        for (int i = 0; i < 16; ++i) tacc[i] = 0.f;
#pragma unroll
        for (int ks = 0; ks < NKS; ++ks) {
          const bf16x8 sf = *(const bf16x8*)(smem + A_S0 + (32 * d + ql) * 144 + (16 * ks + 8 * g) * 2);
          tacc = __builtin_amdgcn_mfma_f32_32x32x16_bf16(sf, qf[ks], tacc, 0, 0, 0);
        }
#pragma unroll
        for (int i = 0; i < 16; ++i) O[d][i] += sc * tacc[i];
      }
    }
  }

  if (MODE == 0 || MODE == 1) {
    const float lt = x32_sum(l_run);
    const float inv = 1.f / lt;
#pragma unroll
    for (int d = 0; d < NDB; ++d)
#pragma unroll
      for (int i = 0; i < 16; ++i) O[d][i] *= inv;
  } else if (MODE == 3) {
    const float lt = x32_sum(l_run);
    const float inv = a.lam / lt;
    float ss = 0.f;
#pragma unroll
    for (int d = 0; d < NDB; ++d)
#pragma unroll
      for (int i4 = 0; i4 < 4; ++i4) {
        const u32x2 t = *(const u32x2*)(smem + A_S0 + qloc * 264 + (32 * d + 8 * i4 + 4 * g) * 2);
        const float o0[4] = {bflo(t[0]), bfhi(t[0]), bflo(t[1]), bfhi(t[1])};
#pragma unroll
        for (int e = 0; e < 4; ++e) { const float o = o0[e] - O[d][4 * i4 + e] * inv; O[d][4 * i4 + e] = o; ss += o * o; }
      }
    ss = x32_sum(ss);
    const float rstd = rsqrtf(ss * (1.f / DV) + EPSV) * a.omli;
#pragma unroll
    for (int d = 0; d < NDB; ++d)
#pragma unroll
      for (int i4 = 0; i4 < 4; ++i4) {
        const f32x4 wv = *(const f32x4*)(a.nw + 32 * d + 8 * i4 + 4 * g);
#pragma unroll
        for (int e = 0; e < 4; ++e) O[d][4 * i4 + e] *= rstd * wv[e];
      }
  } else {
    float sm = 0.f;
#pragma unroll
    for (int d = 0; d < NDB; ++d)
#pragma unroll
      for (int i = 0; i < 16; ++i) sm += O[d][i];
    sm = x32_sum(sm);
    const float mu = sm * (1.f / DV);
    float ss = 0.f;
#pragma unroll
    for (int d = 0; d < NDB; ++d)
#pragma unroll
      for (int i = 0; i < 16; ++i) { const float o = O[d][i] - mu; O[d][i] = o; ss += o * o; }
    ss = x32_sum(ss);
    const float rstd = rsqrtf(ss * (1.f / DV) + EPSV);
#pragma unroll
    for (int d = 0; d < NDB; ++d)
#pragma unroll
      for (int i4 = 0; i4 < 4; ++i4) {
        const int dv0 = 32 * d + 8 * i4 + 4 * g;
        const f32x4 wv = *(const f32x4*)(a.nw + dv0);
        const u32x2 gq = *(const u32x2*)(a.rg + (size_t)qloc * a.rg_ld + dv0);
        const float gg[4] = {bflo(gq[0]), bfhi(gq[0]), bflo(gq[1]), bfhi(gq[1])};
#pragma unroll
        for (int e = 0; e < 4; ++e) O[d][4 * i4 + e] *= rstd * wv[e] * (gg[e] * sigmoidf_(gg[e]));
      }
  }
#pragma unroll
  for (int d = 0; d < NDB; ++d)
#pragma unroll
    for (int i4 = 0; i4 < 4; ++i4) {
      u32x2 t = {pack2(O[d][4 * i4], O[d][4 * i4 + 1]), pack2(O[d][4 * i4 + 2], O[d][4 * i4 + 3])};
      *(u32x2*)(a.y + (size_t)qloc * a.y_ld + 32 * d + 8 * i4 + 4 * g) = t;
    }
}

DI void ret_state_job(char* smem, const bf16_t* kp, const bf16_t* vp, int ld, float lg, int dir, float* outp) {
  float* kw = (float*)smem;
  const int tid = ltid();
  __syncthreads();
  for (int idx = tid; idx < 256 * 8; idx += NTHR) {
    const int j = idx >> 3, c = idx & 7;
    const u32x4 t = *(const u32x4*)(kp + (size_t)j * ld + 8 * c);
    const float wj = exp2f((float)(dir ? j : 255 - j) * lg) * 0.125f;
#pragma unroll
    for (int e = 0; e < 4; ++e) { kw[j * 64 + 8 * c + 2 * e] = bflo(t[e]) * wj; kw[j * 64 + 8 * c + 2 * e + 1] = bfhi(t[e]) * wj; }
  }
  __syncthreads();
  const int dv = tid & 127, dkh = tid >> 7;
  float acc[32];
#pragma unroll
  for (int e = 0; e < 32; ++e) acc[e] = 0.f;
#pragma unroll 2
  for (int j = 0; j < 256; ++j) {
    const float vj = bf2f(vp[(size_t)j * ld + dv]);
#pragma unroll
    for (int e4 = 0; e4 < 8; ++e4) {
      const f32x4 kk = *(const f32x4*)(kw + j * 64 + 32 * dkh + 4 * e4);
#pragma unroll
      for (int e = 0; e < 4; ++e) acc[4 * e4 + e] += kk[e] * vj;
    }
  }
#pragma unroll
  for (int e = 0; e < 32; ++e) outp[(32 * dkh + e) * 128 + dv] = acc[e];
}

DI float log2_sigmoid(float x) { return -log1pf(__expf(-x)) * LOG2E; }

#ifndef AM
#define AM 0xFFu
#endif
#define AEN(k) ((AM >> (k)) & 1u)
DI void attention_phase(KP& p, int l, char* smem) {
  char* ws = p.ws;
  bf16_t* pq = (bf16_t*)(ws + OFF_PQ);
  bf16_t* Y = (bf16_t*)(ws + OFF_Y);
  const float lam_init = 0.8f - 0.6f * expf(-0.3f * (float)l);
  float lam;
  {
    const float* lp = p.diff_lambda + l * 256;
    float s1 = 0.f, s2 = 0.f;
    for (int i = 0; i < 64; ++i) { s1 += lp[i] * lp[64 + i]; s2 += lp[128 + i] * lp[192 + i]; }
    lam = expf(s1) - expf(s2) + lam_init;
  }
  const int G = VG();
  auto init = [&](AttnArgs& a) {
    a.R0 = 0; a.bias = nullptr; a.t0 = 0; a.T = 0; a.lgf = 0.f; a.lgb = 0.f; a.s0f = nullptr; a.s0b = nullptr; a.rg = nullptr; a.rg_ld = 0; a.nw = nullptr;
    a.lam = lam; a.omli = 1.f - lam_init; a.q_ld = PQW; a.y_ld = DM;
  };
  int rot = 0;
  auto first = [&](int n) { int f = VB() - rot; if (f < 0) f += G; rot = (rot + n) % G; return f; };
  if (AEN(3)) for (int it = first(512); it < 512; it += G) {
    AttnArgs a; init(a);
    const int b = it >> 6, h = (it >> 4) & 3, qb = it & 15;
    const size_t row = NCTX + (size_t)b * 2048 + qb * 128;
    a.q = pq + row * PQW + 768 + h * 128; a.k = (bf16_t*)(ws + OFF_KDL) + (size_t)b * SLAT * 512 + h * 128; a.k_ld = 512;
    a.v = (bf16_t*)(ws + OFF_VDL) + (size_t)b * SLAT * 512 + h * 128; a.v_ld = 512; a.n_keys = SLAT; a.sl2 = 0.125f * LOG2E;
    a.y = Y + row * DM + 512 + h * 128; a.nw = p.diff_norm + l * 512 + h * 128;
    attn_block<64, 128, 3>(smem, a);
  }
  if (AEN(0)) for (int i = first(1024); i < 1024; i += G) {
    AttnArgs a; init(a);
    const int b = i >> 7, h = (i >> 4) & 7, qb = i & 15;
    const size_t row = NCTX + (size_t)b * 2048 + qb * 128;
    a.q = pq + row * PQW + h * 96; a.k = (bf16_t*)(ws + OFF_KML) + (size_t)b * SLAT * 768 + h * 96; a.k_ld = 768;
    a.v = (bf16_t*)(ws + OFF_VML) + (size_t)b * SLAT * 512 + h * 64; a.v_ld = 512; a.n_keys = SLAT; a.sl2 = 0.10206207261596577f * LOG2E;
    a.y = Y + row * DM + h * 64;
    attn_block<96, 64, 0>(smem, a);
  }
  if (AEN(2)) for (int i = first(512); i < 512; i += G) {
    AttnArgs a; init(a);
    const int b = i >> 6, h = (i >> 4) & 3, qb = i & 15;
    const size_t row0 = NCTX + (size_t)b * 2048, row = row0 + qb * 128;
    a.q = pq + row * PQW + 1792 + h * 64; a.k = pq + row0 * PQW + 2048 + h * 64; a.k_ld = PQW; a.v = pq + row0 * PQW + 2304 + h * 128; a.v_ld = PQW;
    a.n_keys = 2048; a.sl2 = 0.125f; a.y = Y + row * DM + 1536 + h * 128; a.t0 = qb * 128; a.T = 2048;
    a.lgf = log2_sigmoid(p.ret_decay[l * 8 + h]); a.lgb = log2_sigmoid(p.ret_decay[l * 8 + 4 + h]);
    a.s0f = p.st_ret + ((size_t)((b * 2 + l) * 2 + 0) * 4 + h) * 8192; a.s0b = p.st_ret + ((size_t)((b * 2 + l) * 2 + 1) * 4 + h) * 8192;
    a.rg = pq + row * PQW + 2816 + h * 128; a.rg_ld = PQW; a.nw = p.ret_norm + l * 512 + h * 128;
    attn_block<64, 128, 2>(smem, a);
  }
  if (AEN(1)) for (int i = first(1024); i < 1024; i += G) {
    AttnArgs a; init(a);
    const int b = i >> 7, h = (i >> 4) & 7, qb = i & 15;
    const size_t row = NCTX + (size_t)b * 2048 + qb * 128;
    a.q = pq + row * PQW + 1280 + h * 64; a.k = (bf16_t*)(ws + OFF_KNL) + (size_t)b * SLAT * 512 + h * 64; a.k_ld = 512;
    a.v = (bf16_t*)(ws + OFF_VNL) + (size_t)b * SLAT * 512 + h * 64; a.v_ld = 512; a.n_keys = SLAT; a.sl2 = 0.125f * LOG2E;
    a.y = Y + row * DM + 1024 + h * 64; a.R0 = 2 * qb; a.bias = p.na_bias + (size_t)(l * 8 + h) * 465;
    attn_block<64, 64, 1>(smem, a);
  }
  if (AEN(3)) for (int i = first(256); i < 256; i += G) {
    AttnArgs a; init(a);
    const int b = i >> 3, h = (i >> 1) & 3, qb = i & 1;
    const size_t row0 = (size_t)b * 256, row = row0 + qb * 128;
    a.q = pq + row * PQW + 768 + h * 128; a.k = (bf16_t*)(ws + OFF_KDC) + row0 * 512 + h * 128; a.k_ld = 512;
    a.v = (bf16_t*)(ws + OFF_VDC) + row0 * 512 + h * 128; a.v_ld = 512; a.n_keys = 256; a.sl2 = 0.125f * LOG2E;
    a.y = Y + row * DM + 512 + h * 128; a.nw = p.diff_norm + l * 512 + h * 128;
    attn_block<64, 128, 3>(smem, a);
  }
  if (AEN(0)) for (int i = first(512); i < 512; i += G) {
    AttnArgs a; init(a);
    const int b = i >> 4, h = (i >> 1) & 7, qb = i & 1;
    const size_t row0 = (size_t)b * 256, row = row0 + qb * 128;
    a.q = pq + row * PQW + h * 96; a.k = (bf16_t*)(ws + OFF_KMC) + row0 * 768 + h * 96; a.k_ld = 768;
    a.v = (bf16_t*)(ws + OFF_VMC) + row0 * 512 + h * 64; a.v_ld = 512; a.n_keys = 256; a.sl2 = 0.10206207261596577f * LOG2E;
    a.y = Y + row * DM + h * 64;
    attn_block<96, 64, 0>(smem, a);
  }
  if (AEN(4)) for (int i = first(512); i < 512; i += G) {
    AttnArgs a; init(a);
    const int b = i >> 4, h = (i >> 1) & 7, qb = i & 1;
    const size_t row0 = (size_t)b * 256, row = row0 + qb * 128;
    a.q = pq + row * PQW + 1280 + h * 64; a.k = (bf16_t*)(ws + OFF_KNC) + row0 * 512 + h * 64; a.k_ld = 512;
    a.v = (bf16_t*)(ws + OFF_VNC) + row0 * 512 + h * 64; a.v_ld = 512; a.n_keys = 256; a.sl2 = 0.125f * LOG2E;
    a.y = Y + row * DM + 1024 + h * 64;
    attn_block<64, 64, 0>(smem, a);
  }
  if (AEN(2)) for (int i = first(256); i < 256; i += G) {
    AttnArgs a; init(a);
    const int b = i >> 3, h = (i >> 1) & 3, qb = i & 1;
    const size_t row0 = (size_t)b * 256, row = row0 + qb * 128;
    a.q = pq + row * PQW + 1792 + h * 64; a.k = pq + row0 * PQW + 2048 + h * 64; a.k_ld = PQW; a.v = pq + row0 * PQW + 2304 + h * 128; a.v_ld = PQW;
    a.n_keys = 256; a.sl2 = 0.125f; a.y = Y + row * DM + 1536 + h * 128; a.t0 = qb * 128; a.T = 256;
    a.lgf = log2_sigmoid(p.ret_decay[l * 8 + h]); a.lgb = log2_sigmoid(p.ret_decay[l * 8 + 4 + h]);
    a.rg = pq + row * PQW + 2816 + h * 128; a.rg_ld = PQW; a.nw = p.ret_norm + l * 512 + h * 128;
    attn_block<64, 128, 2>(smem, a);
  }
  if (AEN(5)) for (int i = first(256); i < 256; i += G) {
    const int b = i >> 3, h = (i >> 1) & 3, dir = i & 1;
    const size_t row0 = (size_t)b * 256;
    const float lg = log2_sigmoid(p.ret_decay[l * 8 + dir * 4 + h]);
    ret_state_job(smem, pq + row0 * PQW + 2048 + h * 64, pq + row0 * PQW + 2304 + h * 128, PQW, lg, dir,
                  p.out + OO_RET + ((size_t)((b * 2 + l) * 2 + dir) * 4 + h) * 8192);
  }
}

DI void convT_unit(char* smem, const float* src, int ld, int srccol, int k0, bf16_t* dst  , int K) {
  float* T = (float*)smem;
  const int tid = ltid();
  __syncthreads();
  {
    const int n4 = tid & 7, kr = tid >> 3;
#pragma unroll
    for (int i = 0; i < 8; ++i) {
      const int k = kr + 32 * i;
      f32x4 v = {0.f, 0.f, 0.f, 0.f};
      if (srccol >= 0) v = *(const f32x4*)(src + (size_t)(k0 + k) * ld + srccol + 4 * n4);
      T[k * 33 + 4 * n4] = v[0]; T[k * 33 + 4 * n4 + 1] = v[1]; T[k * 33 + 4 * n4 + 2] = v[2]; T[k * 33 + 4 * n4 + 3] = v[3];
    }
  }
  __syncthreads();
  {
    const int k2 = tid & 127, nh = tid >> 7;
#pragma unroll
    for (int i = 0; i < 16; ++i) {
      const int n = nh + 2 * i;
      *(unsigned*)(dst + (size_t)n * K + 2 * k2) = pack2(T[(2 * k2) * 33 + n], T[(2 * k2 + 1) * 33 + n]);
    }
  }
}

DI void prep_phase(KP& p, char* smem) {
  constexpr int NADA = 2 * 16 * 12;
  constexpr int U_IN = 440 * 8, U_BR = 512, U_O = 512, U_UP = 352 * 8, U_DN = 64 * 22, U_UKV = 32, U_L = U_IN + U_BR + U_O + U_UP + U_DN + U_UKV;
  const int tid = ltid();
  const int n_units = NADA + 2 * U_L, trips = (n_units + VG() - 1) / VG();
  for (int tr = 0; tr < trips; ++tr) {
    const int u = VB() + tr * VG();
    if (u >= n_units) { __syncthreads(); __syncthreads(); continue; }
    if (u < NADA) {
      const int l = u / 192, kc = (u % 192) / 12, nc = u % 12;
      float* cs = (float*)smem;
      __syncthreads();
      for (int i = tid; i < 9 * 128; i += NTHR) {
        const int g = i >> 7, k = kc * 128 + (i & 127);
        const float cv = g == 0 ? p.c_ctx[k] : p.c[(g - 1) * DM + k];
        cs[i] = cv * sigmoidf_(cv);
      }
      __syncthreads();
      f32x4 acc[9];
#pragma unroll
      for (int g = 0; g < 9; ++g) acc[g] = (f32x4){0.f, 0.f, 0.f, 0.f};
      const float* wp = p.w_ada + ((size_t)l * DM + kc * 128) * 12288 + nc * 1024 + 4 * tid;
#pragma unroll 4
      for (int k = 0; k < 128; ++k) {
        const f32x4 wv = *(const f32x4*)(wp + (size_t)k * 12288);
#pragma unroll
        for (int g = 0; g < 9; ++g) { const float s = cs[g * 128 + k]; acc[g] += wv * s; }
      }
      float* pp = (float*)(p.ws + OFF_MODP) + ((size_t)(kc * 2 + l) * 9) * 12288 + nc * 1024 + 4 * tid;
#pragma unroll
      for (int g = 0; g < 9; ++g) *(f32x4*)(pp + (size_t)g * 12288) = acc[g];
    } else {
      const int uu = u - NADA, l = uu / U_L;
      int r = uu % U_L;
      char* wl = p.ws + l * SZ_WL;
      if (r < U_IN) {
        const int cn = r >> 3, kt = r & 7, n = cn * 32;
        int sc;
        if (n < 1024) sc = n; else if (n < 5632) sc = n + 32; else if (n < 5664) sc = n - 5632 + 1024; else if (n < NPROJ) sc = -1; else sc = n - 224;
        convT_unit(smem, p.w_in + (size_t)l * DM * 13856, 13856, sc, kt * 256, (bf16_t*)(wl + WO_IN) + (size_t)n * 2048 + kt * 256, 2048);
      } else if ((r -= U_IN) < U_BR) {
        const int cn = r >> 1, kt = r & 1, i = cn >> 6, n = (cn & 63) * 32;
        convT_unit(smem, p.w_branch + ((size_t)(l * 4 + i) * 512) * 2048, 2048, n, kt * 256, (bf16_t*)(wl + WO_BR) + ((size_t)i * 2048 + n) * 512 + kt * 256, 512);
      } else if ((r -= U_BR) < U_O) {
        const int cn = r >> 3, kt = r & 7, n = cn * 32;
        convT_unit(smem, p.w_o + (size_t)l * DM * DM, 2048, n, kt * 256, (bf16_t*)(wl + WO_O) + (size_t)n * 2048 + kt * 256, 2048);
      } else if ((r -= U_O) < U_UP) {
        const int cn = r >> 3, kt = r & 7, n = cn * 32, J = n >> 7, w = n & 127, chn = 64 * J + (w & 63), sc = (w < 64) ? chn : FF + chn;
        convT_unit(smem, p.w_up + (size_t)l * DM * 11264, 11264, sc, kt * 256, (bf16_t*)(wl + WO_UP) + (size_t)n * 2048 + kt * 256, 2048);
      } else if ((r -= U_UP) < U_DN) {
        const int cn = r / 22, kt = r % 22, n = cn * 32;
        convT_unit(smem, p.w_down + (size_t)l * FF * DM, 2048, n, kt * 256, (bf16_t*)(wl + WO_DN) + (size_t)n * FF + kt * 256, FF);
      } else {
        r -= U_DN;
        const int n = r * 32;
        convT_unit(smem, p.w_ukv + (size_t)l * 256 * 1024, 1024, n, 0, (bf16_t*)(wl + WO_UKV) + (size_t)n * 256, 256);
      }
    }
  }
}

DI void ada_reduce_phase(KP& p) {
  const float* pp = (const float*)(p.ws + OFF_MODP);
  float* mod = (float*)(p.ws + OFF_MOD);
  constexpr int NE = 2 * 9 * 12288;
  for (int e = VB() * NTHR + ltid(); e < NE; e += VG() * NTHR) {
    const int l = e / (9 * 12288), n = e % 12288;
    float s = p.b_ada[l * 12288 + n];
    for (int kc = 0; kc < 16; ++kc) s += pp[(size_t)kc * NE + e];
    mod[e] = s;
  }
}

DI void modulate_phase(KP& p, int l, int which  , bool x_from_input) {
  const int vt_ = ltid(), lane = vt_ & 63, wv = vt_ >> 6;
  const float* gvec = (which ? p.g_ffn : p.g_attn) + l * DM;
  const float* mod = (const float*)(p.ws + OFF_MOD) + (size_t)l * 9 * 12288;
  bf16_t* h = (bf16_t*)(p.ws + OFF_H);
  const int nwv = VG() * 4, per = (NTOK + nwv - 1) / nwv, r0 = (VB() * 4 + wv) * per, r1 = min(r0 + per, NTOK);
  f32x4 av[8], bv[8], xn[8];
  int curg = -1;
  auto ldrow = [&](int r) {
    const float* xr = x_from_input ? xrow_in(p, r) : p.out + (size_t)r * DM;
#pragma unroll
    for (int i = 0; i < 8; ++i) xn[i] = *(const f32x4*)(xr + 4 * (lane + 64 * i));
  };
  if (r0 < r1) ldrow(r0);
  for (int r = r0; r < r1; ++r) {
    f32x4 xv[8];
    float ss = 0.f;
#pragma unroll
    for (int i = 0; i < 8; ++i) { xv[i] = xn[i]; ss += xv[i][0] * xv[i][0] + xv[i][1] * xv[i][1] + xv[i][2] * xv[i][2] + xv[i][3] * xv[i][3]; }
    if (r + 1 < r1) ldrow(r + 1);
    const int g = grp_of(r);
    if (g != curg) {
      curg = g;
      const float* sh = mod + (size_t)g * 12288 + (which ? 3 : 0) * DM;
      const float* sc = sh + DM;
#pragma unroll
      for (int i = 0; i < 8; ++i) {
        const int c = 4 * (lane + 64 * i);
        const f32x4 gv = *(const f32x4*)(gvec + c), sv = *(const f32x4*)(sc + c);
        bv[i] = *(const f32x4*)(sh + c);
#pragma unroll
        for (int e = 0; e < 4; ++e) av[i][e] = gv[e] * (1.f + sv[e]);
      }
    }
    ss = wave_sum(ss);
    const float rstd = rsqrtf(ss * (1.f / DM) + EPSV);
#pragma unroll
    for (int i = 0; i < 8; ++i) {
      const int c = 4 * (lane + 64 * i);
      float o[4];
#pragma unroll
      for (int e = 0; e < 4; ++e) o[e] = xv[i][e] * rstd * av[i][e] + bv[i][e];
      u32x2 t = {pack2(o[0], o[1]), pack2(o[2], o[3])};
      *(u32x2*)(h + (size_t)r * DM + c) = t;
    }
  }
}

DI void cache_prep(KP& p, int l) {
  char* ws = p.ws;
  const int total = 4096 * 292;
  for (int u = VB() * NTHR + ltid(); u < total; u += VG() * NTHR) {
    const int cr = u / 292, w = u % 292, b = cr >> 9, j = cr & 511;
    const size_t srow = (size_t)(b * 2 + l) * 512 + j;
    const size_t drow = (size_t)b * SLAT + 2048 + j;
    const float* src; bf16_t* dst; bool rep = false;
    if (w < 32) { src = p.c_ckv + srow * 256 + 8 * w; dst = (bf16_t*)(ws + OFF_CKVA) + ((size_t)NTOK + cr) * 256 + 8 * w; }
    else if (w < 36) { src = p.c_kr + srow * 32 + 8 * (w - 32); dst = (bf16_t*)(ws + OFF_KML) + drow * 768 + 64 + 8 * (w - 32); rep = true; }
    else {
      const int ww = w - 36, which = ww >> 6, c = 8 * (ww & 63);
      const float* sb = which == 0 ? p.c_dk : which == 1 ? p.c_dv : which == 2 ? p.c_nk : p.c_nv;
      const size_t off = which == 0 ? OFF_KDL : which == 1 ? OFF_VDL : which == 2 ? OFF_KNL : OFF_VNL;
      src = sb + srow * 512 + c; dst = (bf16_t*)(ws + off) + drow * 512 + c;
    }
    const f32x4 a = *(const f32x4*)src, bq = *(const f32x4*)(src + 4);
    u32x4 t = {pack2(a[0], a[1]), pack2(a[2], a[3]), pack2(bq[0], bq[1]), pack2(bq[2], bq[3])};
    if (rep) { for (int h = 0; h < 8; ++h) *(u32x4*)(dst + h * 96) = t; }
    else *(u32x4*)dst = t;
  }
}

DI void ckv_phase(KP& p, int l) {
  const int vt_ = ltid(), lane = vt_ & 63, wv = vt_ >> 6;
  const float* mck = (const float*)(p.ws + OFF_MCKV);
  bf16_t* ca = (bf16_t*)(p.ws + OFF_CKVA);
  const f32x4 wn = *(const f32x4*)(p.kv_norm + l * 256 + 4 * lane);
  for (int r = VB() * 4 + wv; r < NTOK; r += VG() * 4) {
    const f32x4 v = *(const f32x4*)(mck + (size_t)r * 256 + 4 * lane);
    float ss = wave_sum(v[0] * v[0] + v[1] * v[1] + v[2] * v[2] + v[3] * v[3]);
    const float rstd = rsqrtf(ss * (1.f / 256.f) + EPSV);
    f32x4 o = {v[0] * rstd * wn[0], v[1] * rstd * wn[1], v[2] * rstd * wn[2], v[3] * rstd * wn[3]};
    u32x2 t = {pack2(o[0], o[1]), pack2(o[2], o[3])};
    *(u32x2*)(ca + (size_t)r * 256 + 4 * lane) = t;
    if (r < NCTX) { const int b = r >> 8, tt = r & 255; *(f32x4*)(p.out + OO_CKV + ((size_t)((b * 2 + l) * 256 + tt)) * 256 + 4 * lane) = o; }
  }
}

DI void merge_phase(KP& p, int l, char* smem) {
  char* wl = p.ws + l * SZ_WL;
  const bf16_t* h = (const bf16_t*)(p.ws + OFF_H);
  const bf16_t* Y = (const bf16_t*)(p.ws + OFF_Y);
  const bf16_t* wg = (const bf16_t*)(wl + WO_IN) + (size_t)NPROJ * 2048;
  const bf16_t* wb = (const bf16_t*)(wl + WO_BR);
  StoreBf16Epi epi{(bf16_t*)(p.ws + OFF_M), DM, 0};
  constexpr int nM = 96, nN = 16;
  for (int it = 0;; ++it) {
    int pm, pn;
    if (!tile_map(rtile_slot(it), nM, nN, 8, pm, pn)) break;
    f32x4 tot[8][2];
#pragma unroll
    for (int mi = 0; mi < 8; ++mi)
#pragma unroll
      for (int ni = 0; ni < 2; ++ni) tot[mi][ni] = (f32x4){0.f, 0.f, 0.f, 0.f};
 u32x4 ra[4], rb[2];
#pragma unroll 1
    for (int i = 0; i < 4; ++i) {
      const bf16_t* Ag = h + (size_t)pm * 256 * DM; const bf16_t* Bg = wg + ((size_t)i * 2048 + pn * 128) * 2048;
      const bf16_t* Ab = Y + (size_t)pm * 256 * DM + 512 * i; const bf16_t* Bb = wb + ((size_t)i * 2048 + pn * 128) * 512;
      const bf16_t* Bg2 = wg + ((size_t)(i < 3 ? i + 1 : i) * 2048 + pn * 128) * 2048;
      unsigned gp[4][2][2];
      char* park = smem + 114688 + rtid() * 64;
      {
        f32x4 ga[8][2];
#pragma unroll
        for (int mi = 0; mi < 8; ++mi)
#pragma unroll
          for (int ni = 0; ni < 2; ++ni) ga[mi][ni] = (f32x4){0.f, 0.f, 0.f, 0.f};
        gemm256_kloop<2>(ga, ra, rb, Ag, DM, Bg, 2048, 2048, Ab, DM, Bb, 512, i > 0, smem);
#pragma unroll
        for (int mi = 0; mi < 8; ++mi)
#pragma unroll
          for (int ni = 0; ni < 2; ++ni) {
            const unsigned g0 = pack2(sigmoidf_(ga[mi][ni][0]), sigmoidf_(ga[mi][ni][1]));
            const unsigned g1 = pack2(sigmoidf_(ga[mi][ni][2]), sigmoidf_(ga[mi][ni][3]));
            if (mi < 4) { u32x2 t = {g0, g1}; *(u32x2*)(park + (mi * 2 + ni) * 8) = t; }
            else { gp[mi - 4][ni][0] = g0; gp[mi - 4][ni][1] = g1; }
          }
      }
      f32x4 ba[8][2];
#pragma unroll
      for (int mi = 0; mi < 8; ++mi)
#pragma unroll
        for (int ni = 0; ni < 2; ++ni) ba[mi][ni] = (f32x4){0.f, 0.f, 0.f, 0.f};
      gemm256_kloop<2>(ba, ra, rb, Ab, DM, Bb, 512, 512, Ag, DM, Bg2, 2048, true, smem);
#pragma unroll
      for (int mi = 0; mi < 8; ++mi)
#pragma unroll
        for (int ni = 0; ni < 2; ++ni) {
          unsigned g0, g1;
          if (mi < 4) { const u32x2 t = *(const u32x2*)(park + (mi * 2 + ni) * 8); g0 = t[0]; g1 = t[1]; }
          else { g0 = gp[mi - 4][ni][0]; g1 = gp[mi - 4][ni][1]; }
          tot[mi][ni][0] += bflo(g0) * ba[mi][ni][0]; tot[mi][ni][1] += bfhi(g0) * ba[mi][ni][1];
          tot[mi][ni][2] += bflo(g1) * ba[mi][ni][2]; tot[mi][ni][3] += bfhi(g1) * ba[mi][ni][3];
        }
    }
    gemm256_epilogue<2>(tot, smem, pm * 256, pn * 128, epi);
  }
}

struct ConvW { float wa[3][8], wb[3][8], ba[8], bb[8]; };
DI void load_convw(ConvW& c, const float* cw, const float* cb, int chn) {
#pragma unroll
  for (int j = 0; j < 3; ++j)
#pragma unroll
    for (int e4 = 0; e4 < 2; ++e4) {
      const f32x4 x = *(const f32x4*)(cw + j * 11264 + chn + 4 * e4), y = *(const f32x4*)(cw + j * 11264 + FF + chn + 4 * e4);
#pragma unroll
      for (int e = 0; e < 4; ++e) { c.wa[j][4 * e4 + e] = x[e]; c.wb[j][4 * e4 + e] = y[e]; }
    }
#pragma unroll
  for (int e4 = 0; e4 < 2; ++e4) {
    const f32x4 x = *(const f32x4*)(cb + chn + 4 * e4), y = *(const f32x4*)(cb + FF + chn + 4 * e4);
#pragma unroll
    for (int e = 0; e < 4; ++e) { c.ba[4 * e4 + e] = x[e]; c.bb[4 * e4 + e] = y[e]; }
  }
}
DI void unpack8(const u32x4& v, float (&x)[8]) {
#pragma unroll
  for (int e = 0; e < 4; ++e) { x[2 * e] = bflo(v[e]); x[2 * e + 1] = bfhi(v[e]); }
}
DI u32x4 conv_out(const ConvW& c, const float (&pa)[8], const float (&pb)[8], const float (&ca)[8], const float (&cb_)[8],
                  const float (&na)[8], const float (&nb)[8]) {
  u32x4 o;
#pragma unroll
  for (int e = 0; e < 4; ++e) {
    float s[2];
#pragma unroll
    for (int q = 0; q < 2; ++q) {
      const int k = 2 * e + q;
      const float sa = c.ba[k] + c.wa[0][k] * pa[k] + c.wa[1][k] * ca[k] + c.wa[2][k] * na[k];
      const float sb = c.bb[k] + c.wb[0][k] * pb[k] + c.wb[1][k] * cb_[k] + c.wb[2][k] * nb[k];
      s[q] = sa * sigmoidf_(sa) * sb;
    }
    o[e] = pack2(s[0], s[1]);
  }
  return o;
}

constexpr size_t OFF_HALO = OFF_ACT + SZ_ACT;
static_assert(OFF_HALO + (size_t)96 * 4 * 11264 * 2 <= OFF_KVEND, "halo alias");

DI void up_phase(KP& p, int l, char* smem) {
  char* wl = p.ws + l * SZ_WL;
  const bf16_t* h = (const bf16_t*)(p.ws + OFF_H);
  const bf16_t* W = (const bf16_t*)(wl + WO_UP);
  bf16_t* act = (bf16_t*)(p.ws + OFF_ACT);
  bf16_t* halo = (bf16_t*)(p.ws + OFF_HALO);
  const float* cw = p.conv_w + (size_t)l * 3 * 11264;
  const float* cb = p.conv_b + (size_t)l * 11264;
  constexpr int CSB = 528;
  for (int it = 0;; ++it) {
    int pm, pn;
    if (!tile_map(rtile_slot(it), 96, 44, 8, pm, pn)) break;
    ConvW cwv;
    {
      f32x4 acc[8][4];
#pragma unroll
      for (int mi = 0; mi < 8; ++mi)
#pragma unroll
        for (int ni = 0; ni < 4; ++ni) acc[mi][ni] = (f32x4){0.f, 0.f, 0.f, 0.f};
      u32x4 ra[4], rb[4];
      const bf16_t* At = h + (size_t)pm * 256 * DM; const bf16_t* Bt = W + (size_t)pn * 256 * 2048;
      gemm256_kloop<4>(acc, ra, rb, At, DM, Bt, 2048, 2048, At, DM, Bt, 2048, false, smem);
      const int tid = rtid(), wid = tid >> 6, lane = tid & 63, wr = wid >> 2, wc = wid & 3, fr = lane & 15, fq = lane >> 4;
      load_convw(cwv, cw, cb, 64 * (2 * pn + ((tid & 15) >> 3)) + (tid & 7) * 8);
#pragma unroll
      for (int mi = 0; mi < 8; ++mi)
#pragma unroll
        for (int ni = 0; ni < 4; ++ni) {
          u32x2 t = {pack2(acc[mi][ni][0], acc[mi][ni][1]), pack2(acc[mi][ni][2], acc[mi][ni][3])};
          *(u32x2*)(smem + (128 * wr + 16 * mi + fr) * CSB + (64 * wc + 16 * ni + 4 * fq) * 2) = t;
        }
    }
    __syncthreads();
    const int tid = rtid();
    const bool top_edge = (pm < 32) || (((pm - 32) & 7) == 0), bot_edge = (pm < 32) || (((pm - 32) & 7) == 7);
    if (tid < 128) {
      const int hr = tid >> 5, c16 = tid & 31, row = hr < 2 ? hr : 252 + hr;
      *(u32x4*)(halo + ((size_t)(pm * 4 + hr)) * 11264 + pn * 256 + c16 * 8) = *(const u32x4*)(smem + row * CSB + c16 * 16);
    }
    {
      const int cu = tid & 15, rb = tid >> 4, g2 = cu >> 3, c8 = (cu & 7) * 8;
      const int chn = 64 * (2 * pn + g2) + c8;
      const ConvW& c = cwv;
      const char* col = smem + (128 * g2 + c8) * 2;
      float pa[8], pb[8], ca[8], cb_[8], na[8], nb[8];
      auto ldrow = [&](int r, float (&xa)[8], float (&xb)[8]) {
        if (r < 0 || r > 255) {
#pragma unroll
          for (int e = 0; e < 8; ++e) { xa[e] = 0.f; xb[e] = 0.f; }
        } else {
          unpack8(*(const u32x4*)(col + r * CSB), xa);
          unpack8(*(const u32x4*)(col + r * CSB + 128), xb);
        }
      };
      const int r0 = rb * 8;
      ldrow(r0 - 1, pa, pb);
      ldrow(r0, ca, cb_);
#pragma unroll
      for (int i = 0; i < 8; ++i) {
        const int r = r0 + i;
        ldrow(r + 1, na, nb);
        const bool defer = (r == 0 && !top_edge) || (r == 255 && !bot_edge);
        if (!defer) *(u32x4*)(act + ((size_t)pm * 256 + r) * FF + chn) = conv_out(c, pa, pb, ca, cb_, na, nb);
#pragma unroll
        for (int e = 0; e < 8; ++e) { pa[e] = ca[e]; pb[e] = cb_[e]; ca[e] = na[e]; cb_[e] = nb[e]; }
      }
    }
    __syncthreads();
  }
}

DI void fixup_phase(KP& p, int l) {
  const bf16_t* halo = (const bf16_t*)(p.ws + OFF_HALO);
  bf16_t* act = (bf16_t*)(p.ws + OFF_ACT);
  const float* cw = p.conv_w + (size_t)l * 3 * 11264;
  const float* cb = p.conv_b + (size_t)l * 11264;
  const int total = 56 * 2 * 704;
  for (int u = VB() * NTHR + ltid(); u < total; u += VG() * NTHR) {
    const int cu = u % 704, br = u / 704, which = br & 1, bd = br >> 1, seq = bd / 7, ti = bd % 7;
    const int pm = 32 + seq * 8 + ti;
    const int chn = cu * 8, g = chn >> 6, c = chn & 63;
    ConvW cwv; load_convw(cwv, cw, cb, chn);
    const bf16_t* rp = halo + ((size_t)(pm * 4 + (which ? 3 : 2))) * 11264 + 128 * g + c;
    const bf16_t* rc = halo + ((size_t)(which ? (pm + 1) * 4 + 0 : pm * 4 + 3)) * 11264 + 128 * g + c;
    const bf16_t* rn = halo + ((size_t)((pm + 1) * 4 + (which ? 1 : 0))) * 11264 + 128 * g + c;
    float pa[8], pb[8], ca[8], cb_[8], na[8], nb[8];
    unpack8(*(const u32x4*)rp, pa); unpack8(*(const u32x4*)(rp + 64), pb);
    unpack8(*(const u32x4*)rc, ca); unpack8(*(const u32x4*)(rc + 64), cb_);
    unpack8(*(const u32x4*)rn, na); unpack8(*(const u32x4*)(rn + 64), nb);
    const size_t row = which ? (size_t)(pm + 1) * 256 : (size_t)pm * 256 + 255;
    *(u32x4*)(act + row * FF + chn) = conv_out(cwv, pa, pb, ca, cb_, na, nb);
  }
}

DI void conv_phase(KP& p, int l, int g0, int ng) {
  const bf16_t* U = (const bf16_t*)(p.ws + OFF_U);
  bf16_t* act = (bf16_t*)(p.ws + OFF_ACT);
  const float* cw = p.conv_w + (size_t)l * 3 * 11264;
  const float* cb = p.conv_b + (size_t)l * 11264;
  const int upr = ng * 8, uw = ng * 128;
  const int total = (NTOK / 8) * upr;
  for (int u = VB() * NTHR + ltid(); u < total; u += VG() * NTHR) {
    const int rb = u / upr, w = u % upr, J = w >> 3, c8 = (w & 7) * 8;
    const int chn = 64 * (g0 + J) + c8, r0 = rb * 8;
    int t0, T;
    if (r0 < NCTX) { t0 = r0 & 255; T = 256; } else { t0 = (r0 - NCTX) & 2047; T = 2048; }
    float wa[3][8], wb[3][8], ba[8], bb[8];
#pragma unroll
    for (int j = 0; j < 3; ++j)
#pragma unroll
      for (int e4 = 0; e4 < 2; ++e4) {
        const f32x4 x = *(const f32x4*)(cw + j * 11264 + chn + 4 * e4), y = *(const f32x4*)(cw + j * 11264 + FF + chn + 4 * e4);
#pragma unroll
        for (int e = 0; e < 4; ++e) { wa[j][4 * e4 + e] = x[e]; wb[j][4 * e4 + e] = y[e]; }
      }
#pragma unroll
    for (int e4 = 0; e4 < 2; ++e4) {
      const f32x4 x = *(const f32x4*)(cb + chn + 4 * e4), y = *(const f32x4*)(cb + FF + chn + 4 * e4);
#pragma unroll
      for (int e = 0; e < 4; ++e) { ba[4 * e4 + e] = x[e]; bb[4 * e4 + e] = y[e]; }
    }
    const bf16_t* ua = U + (size_t)r0 * uw + 128 * J + c8;
    float pa[8], pb[8], ca[8], cb_[8], na[8], nb[8];
    auto ldrow = [&](int i, float (&xa)[8], float (&xb)[8]) {
      const int tt = t0 + i;
      if (tt < 0 || tt >= T) {
#pragma unroll
        for (int e = 0; e < 8; ++e) { xa[e] = 0.f; xb[e] = 0.f; }
      } else {
        const u32x4 av = *(const u32x4*)(ua + (ptrdiff_t)i * uw), bv = *(const u32x4*)(ua + (ptrdiff_t)i * uw + 64);
#pragma unroll
        for (int e = 0; e < 4; ++e) { xa[2 * e] = bflo(av[e]); xa[2 * e + 1] = bfhi(av[e]); xb[2 * e] = bflo(bv[e]); xb[2 * e + 1] = bfhi(bv[e]); }
      }
    };
    ldrow(-1, pa, pb);
    ldrow(0, ca, cb_);
#pragma unroll
    for (int i = 0; i < 8; ++i) {
      ldrow(i + 1, na, nb);
      u32x4 o;
#pragma unroll
      for (int e = 0; e < 4; ++e) {
        float s[2];
#pragma unroll
        for (int q = 0; q < 2; ++q) {
          const int c = 2 * e + q;
          const float sa = ba[c] + wa[0][c] * pa[c] + wa[1][c] * ca[c] + wa[2][c] * na[c];
          const float sb = bb[c] + wb[0][c] * pb[c] + wb[1][c] * cb_[c] + wb[2][c] * nb[c];
          s[q] = sa * sigmoidf_(sa) * sb;
        }
        o[e] = pack2(s[0], s[1]);
      }
      *(u32x4*)(act + (size_t)(r0 + i) * FF + chn) = o;
#pragma unroll
      for (int e = 0; e < 8; ++e) { pa[e] = ca[e]; pb[e] = cb_[e]; ca[e] = na[e]; cb_[e] = nb[e]; }
    }
  }
}

DI void final_phase(KP& p) {
  const int vt_ = ltid(), lane = vt_ & 63, wv = vt_ >> 6;
  for (int r = VB() * 4 + wv; r < NTOK; r += VG() * 4) {
    float* xr = p.out + (size_t)r * DM;
    f32x4 xv[8];
    float ss = 0.f;
#pragma unroll
    for (int i = 0; i < 8; ++i) { xv[i] = *(const f32x4*)(xr + 4 * (lane + 64 * i)); ss += xv[i][0] * xv[i][0] + xv[i][1] * xv[i][1] + xv[i][2] * xv[i][2] + xv[i][3] * xv[i][3]; }
    ss = wave_sum(ss);
    const float rstd = rsqrtf(ss * (1.f / DM) + EPSV);
#pragma unroll
    for (int i = 0; i < 8; ++i) {
      const int c = 4 * (lane + 64 * i);
      const f32x4 gv = *(const f32x4*)(p.g_final + c);
      f32x4 o = {xv[i][0] * rstd * gv[0], xv[i][1] * rstd * gv[1], xv[i][2] * rstd * gv[2], xv[i][3] * rstd * gv[3]};
      *(f32x4*)(xr + c) = o;
    }
  }
}

constexpr int LSTEPS = 11, NSTEPS = 2 + 2 * LSTEPS + 1;

DI void run_step(KP& p, int step, char* smem) {
  char* ws = p.ws;
  asm volatile("" : "+s"(ws));
  char* gsm = smem + vgrp() * GRP_LDS;
  if (step == 0) { prep_phase(p, gsm); return; }
  if (step == 1) { ada_reduce_phase(p); return; }
  if (step == NSTEPS - 1) { final_phase(p); return; }
  const int l = (step - 2) / LSTEPS, s = (step - 2) % LSTEPS;
  char* wl = ws + l * SZ_WL;
  const float* mod = (const float*)(ws + OFF_MOD) + (size_t)l * 9 * 12288;
  const bf16_t* h = (const bf16_t*)(ws + OFF_H);
  switch (s) {
    case 0: modulate_phase(p, l, 0, l == 0); cache_prep(p, l); break;
    case 1: {
      ProjEpi e; e.ws = ws; e.out = p.out; e.l = l;
      gemm256_phase(h, DM, (const bf16_t*)(wl + WO_IN), 2048, 2048, 96, 23, 0, e, smem);
    } break;
    case 2: ckv_phase(p, l); break;
    case 3: {
      UkvEpi e{ws};
      gemm256_phase((const bf16_t*)(ws + OFF_CKVA), 256, (const bf16_t*)(wl + WO_UKV), 256, 256, 112, 4, 0, e, smem);
    } break;
    case 4: attention_phase(p, l, gsm); break;
    case 5: merge_phase(p, l, smem); break;
    case 6: {
      ResidEpi e{l == 0 ? p.x_prompt : p.out, l == 0 ? p.x_sample : p.out + (size_t)NCTX * DM, p.out, mod + 2 * DM};
      gemm256_phase((const bf16_t*)(ws + OFF_M), DM, (const bf16_t*)(wl + WO_O), 2048, 2048, 96, 8, 0, e, smem);
    } break;
    case 7: modulate_phase(p, l, 1, false); break;
    case 8: up_phase(p, l, smem); break;
    case 9: fixup_phase(p, l); break;
    case 10: {
      ResidEpi e{p.out, p.out + (size_t)NCTX * DM, p.out, mod + 5 * DM};
      gemm256_phase((const bf16_t*)(ws + OFF_ACT), FF, (const bf16_t*)(wl + WO_DN), FF, FF, 96, 8, 0, e, smem);
    } break;
  }
}

#define XB_TMO      128
#define XB_XCNT(j)  (256  + 64 * (j))
#define XB_XSUB(j)  (1280 + 64 * (j))
#define XB_XGEN(j)  (2304 + 64 * (j))
#define XB_TOP      3328
#define XB_TOPGEN   3392
#define XCD_BAR_WORDS 3456
#define XB_SPIN_CAP (1u << 18)
#define LAS __attribute__((address_space(3)))

__device__ __forceinline__ unsigned xb_ld(unsigned* p)              { return __hip_atomic_load(p, __ATOMIC_RELAXED, __HIP_MEMORY_SCOPE_AGENT); }
__device__ __forceinline__ unsigned xb_add(unsigned* p, unsigned v) { return __hip_atomic_fetch_add(p, v, __ATOMIC_RELAXED, __HIP_MEMORY_SCOPE_AGENT); }
__device__ __forceinline__ unsigned xb_xcc_id() { return (unsigned)__builtin_amdgcn_s_getreg((3 << 11) | 20) & 0xFu; }
#define XB_SPIN(cond, bar) do { unsigned _sp = 0; while (cond) { __builtin_amdgcn_s_sleep(1); \
    if ((++_sp & 255u) == 0u) { if (xb_ld(&(bar)[XB_TMO])) break; if (_sp > XB_SPIN_CAP) { atomicAdd(&(bar)[XB_TMO], 1u); break; } } } } while (0)

struct XcdBarrier {
    unsigned* bar; unsigned x;
    volatile LAS unsigned* st;
};

__device__ __forceinline__ XcdBarrier xcd_barrier_post(unsigned* bar, volatile LAS unsigned* st) {
    XcdBarrier b; b.bar = bar; b.x = xb_xcc_id(); b.st = st;
    if (threadIdx.x == 0) (void)xb_add(&bar[XB_XCNT(b.x)], 1u);
    return b;
}
__device__ __forceinline__ void xcd_barrier_complete(unsigned* bar, unsigned x, unsigned& nloc, unsigned& nx) {
    const unsigned G = gridDim.x * gridDim.y * gridDim.z;
    unsigned sum, cnt, mine, sp = 0u;
    for (;;) {
        sum = 0u; cnt = 0u; mine = 0u;
#pragma unroll
        for (unsigned j = 0; j < 16; ++j) { const unsigned c = xb_ld(&bar[XB_XCNT(j)]); sum += c; cnt += (c > 0u) ? 1u : 0u; mine = (j == x) ? c : mine; }
        if (sum == G) break;
        __builtin_amdgcn_s_sleep(1);
        if ((++sp & 255u) == 0u) { if (xb_ld(&bar[XB_TMO])) break; if (sp > XB_SPIN_CAP) { atomicAdd(&bar[XB_TMO], 1u); break; } }
    }
    nloc = mine > 0u ? mine : 1u; nx = cnt > 0u ? cnt : 1u;
}

__device__ __forceinline__ void xcd_barrier(const XcdBarrier& b) {
    asm volatile("s_waitcnt vmcnt(0)" ::: "memory");
    __syncthreads();
    if (threadIdx.x == 0) {
        unsigned* bar = b.bar;
        __builtin_amdgcn_s_waitcnt(0);
        unsigned nloc = b.st[0], nx = b.st[1];
        if (nloc == 0u) { xcd_barrier_complete(bar, b.x, nloc, nx); b.st[0] = nloc; b.st[1] = nx; }
        const unsigned old = xb_add(&bar[XB_XSUB(b.x)], 1u);
        const unsigned gen = old / nloc;
        if (old + 1u == (gen + 1u) * nloc) {
            __builtin_amdgcn_fence(__ATOMIC_RELEASE, "agent");
            asm volatile("s_waitcnt vmcnt(0)" ::: "memory");
            const unsigned og = xb_add(&bar[XB_TOP], 1u);
            const unsigned tg = og / nx;
            if (og + 1u == (tg + 1u) * nx) xb_add(&bar[XB_TOPGEN], 1u);
            else XB_SPIN(xb_ld(&bar[XB_TOPGEN]) == tg, bar);
            __builtin_amdgcn_fence(__ATOMIC_ACQUIRE, "agent");
            xb_add(&bar[XB_XGEN(b.x)], 1u);
            asm volatile("s_waitcnt vmcnt(0)" ::: "memory");
        } else {
            XB_SPIN(xb_ld(&bar[XB_XGEN(b.x)]) == gen, bar);
            __builtin_amdgcn_fence(__ATOMIC_ACQUIRE, "agent");
            asm volatile("s_waitcnt vmcnt(0)" ::: "memory");
        }
    }
    __syncthreads();
}

extern "C" __global__ void __launch_bounds__(RTHR, 2) mega_kernel(Params p) {
  extern __shared__ __attribute__((aligned(16))) char smem[];
  __shared__ unsigned xb_words[4];
  cg::grid_group grid = cg::this_grid();
  if (threadIdx.x < 4) xb_words[threadIdx.x] = 0u;
  __syncthreads();
  XcdBarrier xb = xcd_barrier_post((unsigned*)(p.ws + OFF_BAR), (volatile LAS unsigned*)&xb_words);
  for (int s = p.step_lo; s < p.step_hi; ++s) {
    KP* pp = (KP*)__builtin_amdgcn_kernarg_segment_ptr();
    asm volatile("" : "+s"(pp));
    run_step(*pp, s, smem);
    if (s + 1 < p.step_hi) { if (s == p.step_lo) grid.sync(); else xcd_barrier(xb); }
  }
}

extern "C" void kernel_launch(void* const* d_in, const int* in_sizes, int n_in, void* d_out, int out_size, void* d_ws, size_t ws_size,
                              hipStream_t stream) {
  static int grid_blocks = 0;
  if (!grid_blocks) {
    int dev = 0, cus = 0, per_cu = 0;
    hipGetDevice(&dev);
    hipDeviceGetAttribute(&cus, hipDeviceAttributeMultiprocessorCount, dev);
    hipFuncSetAttribute((const void*)mega_kernel, hipFuncAttributeMaxDynamicSharedMemorySize, LDS_BYTES);
    hipOccupancyMaxActiveBlocksPerMultiprocessor(&per_cu, mega_kernel, RTHR, LDS_BYTES);
    if (per_cu != 1) per_cu = 1;
    grid_blocks = cus * per_cu;
  }
  if (ws_size < WS_NEED) { fprintf(stderr, "workspace too small: %zu < %zu\n", ws_size, (size_t)WS_NEED); return; }
  Params p{};
  const float** pf = (const float**)&p;
  for (int i = 0; i < 30; ++i) pf[i] = (const float*)d_in[i];
  p.out = (float*)d_out;
  p.ws = (char*)d_ws;
#if MULTI
  for (int s = 0; s < NSTEPS; ++s) {
    p.step_lo = s; p.step_hi = s + 1;
    hipLaunchKernelGGL(mega_kernel, dim3(grid_blocks), dim3(RTHR), LDS_BYTES, stream, p);
  }
#else
  p.step_lo = 0; p.step_hi = NSTEPS;
  (void)hipMemsetAsync((char*)d_ws + OFF_BAR, 0, 16384, stream);
  void* args[] = {&p};
  hipError_t e = hipLaunchCooperativeKernel((const void*)mega_kernel, dim3(grid_blocks), dim3(RTHR), args, LDS_BYTES, stream);
  if (e != hipSuccess) fprintf(stderr, "cooperative launch failed: %s (grid %d)\n", hipGetErrorString(e), grid_blocks);
#endif
}
```

```cpp
#include <hip/hip_runtime.h>
#include <hip/hip_cooperative_groups.h>
#include <cstdio>
namespace cg = cooperative_groups;

typedef unsigned short bf16_t;
typedef short bf16x8 __attribute__((ext_vector_type(8)));
typedef float f32x4 __attribute__((ext_vector_type(4)));
typedef float f32x16 __attribute__((ext_vector_type(16)));
typedef unsigned u32x4 __attribute__((ext_vector_type(4)));
typedef unsigned u32x2 __attribute__((ext_vector_type(2)));
#define DI __device__ __forceinline__
#ifndef MULTI
#define MULTI 0
#endif

constexpr int NTHR = 256;
constexpr int RTHR = 512;
constexpr int GRP_LDS = 73728;
constexpr int LDS_BYTES = 2 * GRP_LDS;
constexpr int DM = 2048, NTOK = 24576, NCTX = 8192, SLAT = 2560;
constexpr int NPROJ = 5888, NIN = 14080, FF = 5632, PQW = 3328;
constexpr float EPSV = 1e-6f, LOG2E = 1.4426950408889634f;

constexpr size_t SZ_WIN = (size_t)NIN * 2048 * 2, SZ_WBR = (size_t)4 * 2048 * 512 * 2, SZ_WO = (size_t)2048 * 2048 * 2,
                 SZ_WUP = (size_t)11264 * 2048 * 2, SZ_WDN = (size_t)2048 * 5632 * 2, SZ_WUKV = (size_t)1024 * 256 * 2;
constexpr size_t WO_IN = 0, WO_BR = WO_IN + SZ_WIN, WO_O = WO_BR + SZ_WBR, WO_UP = WO_O + SZ_WO, WO_DN = WO_UP + SZ_WUP, WO_UKV = WO_DN + SZ_WDN,
                 SZ_WL = WO_UKV + SZ_WUKV;
constexpr size_t OFF_MODP = 2 * SZ_WL, SZ_MODP = (size_t)16 * 2 * 9 * 12288 * 4;
constexpr size_t OFF_MOD = OFF_MODP + SZ_MODP, SZ_MOD = (size_t)2 * 9 * 12288 * 4;
constexpr size_t OFF_H = OFF_MOD + SZ_MOD, SZ_H = (size_t)NTOK * 2048 * 2;
constexpr size_t OFF_AR = OFF_H + SZ_H;
constexpr size_t OFF_Y = OFF_AR;
constexpr size_t OFF_PQ = OFF_Y + SZ_H, SZ_PQ = (size_t)NTOK * PQW * 2;
constexpr size_t OFF_MCKV = OFF_PQ + SZ_PQ, SZ_MCKV = (size_t)NTOK * 256 * 4;
constexpr size_t OFF_CKVA = OFF_MCKV + SZ_MCKV, SZ_CKVA = (size_t)28672 * 256 * 2;
constexpr size_t OFF_KV = OFF_CKVA + SZ_CKVA;
constexpr size_t NLROW = 8 * SLAT;
constexpr size_t OFF_KMC = OFF_KV, OFF_VMC = OFF_KMC + (size_t)NCTX * 768 * 2, OFF_KML = OFF_VMC + (size_t)NCTX * 512 * 2,
                 OFF_VML = OFF_KML + NLROW * 768 * 2, OFF_KDC = OFF_VML + NLROW * 512 * 2, OFF_VDC = OFF_KDC + (size_t)NCTX * 512 * 2,
                 OFF_KDL = OFF_VDC + (size_t)NCTX * 512 * 2, OFF_VDL = OFF_KDL + NLROW * 512 * 2, OFF_KNC = OFF_VDL + NLROW * 512 * 2,
                 OFF_VNC = OFF_KNC + (size_t)NCTX * 512 * 2, OFF_KNL = OFF_VNC + (size_t)NCTX * 512 * 2, OFF_VNL = OFF_KNL + NLROW * 512 * 2,
                 OFF_KVEND = OFF_VNL + NLROW * 512 * 2;
constexpr size_t OFF_M = OFF_KV;
static_assert(OFF_KVEND - OFF_KV >= SZ_H, "m alias");
constexpr size_t OFF_ACT = OFF_AR, SZ_ACT = (size_t)NTOK * FF * 2;
constexpr size_t OFF_U = OFF_ACT + SZ_ACT, SZ_U = (size_t)NTOK * 4352 * 2;
static_assert(OFF_U + SZ_U <= OFF_KVEND, "ffn alias");
constexpr size_t OFF_BAR = OFF_KVEND;
constexpr size_t WS_NEED = OFF_BAR + 16384;

constexpr size_t OO_Y = 0, OO_CKV = (size_t)NTOK * 2048, OO_KR = OO_CKV + 4194304, OO_DK = OO_KR + 524288, OO_DV = OO_DK + 8388608,
                 OO_NK = OO_DV + 8388608, OO_NV = OO_NK + 8388608, OO_RET = OO_NV + 8388608;

struct Params {
  const float *x_prompt, *x_sample, *c_ckv, *c_kr, *c_dk, *c_dv, *c_nk, *c_nv, *st_ret, *c, *c_ctx, *w_ada, *b_ada, *g_attn, *g_ffn, *w_in,
      *kv_norm, *w_ukv, *diff_lambda, *diff_norm, *na_bias, *ret_decay, *ret_norm, *w_branch, *w_o, *w_up, *conv_w, *conv_b, *w_down, *g_final;
  float* out;
  char* ws;
  int step_lo, step_hi;
};

typedef __attribute__((address_space(4))) const Params KP;
DI unsigned short f2bf(float f) { unsigned u = __float_as_uint(f); u += 0x7fffu + ((u >> 16) & 1u); return (unsigned short)(u >> 16); }
typedef __bf16 bf16v2_t __attribute__((ext_vector_type(2)));
typedef float f32v2_t __attribute__((ext_vector_type(2)));
DI unsigned pack2(float a, float b) { f32v2_t v = {a, b}; return __builtin_bit_cast(unsigned, __builtin_convertvector(v, bf16v2_t)); }
DI float bf2f(unsigned short h) { return __uint_as_float(((unsigned)h) << 16); }
DI float bflo(unsigned u) { return __uint_as_float(u << 16); }
DI float bfhi(unsigned u) { return __uint_as_float(u & 0xffff0000u); }
typedef __attribute__((address_space(1))) const u32x4 g_u32x4;
DI u32x4 gld16(const void* p) { return *(g_u32x4*)p; }
#define SCHED_FENCE() __builtin_amdgcn_sched_barrier(0)
DI int ltid() { int t = threadIdx.x; asm volatile("" : "+v"(t)); return t & 255; }
DI int rtid() { int t = threadIdx.x; asm volatile("" : "+v"(t)); return t; }
DI int vgrp() { return __builtin_amdgcn_readfirstlane((int)(threadIdx.x >> 8)); }
DI int VB() { return (int)blockIdx.x * 2 + vgrp(); }
DI int VG() { return (int)gridDim.x * 2; }
DI float shx(float v, int o) {
  int l = __builtin_amdgcn_mbcnt_hi(~0u, __builtin_amdgcn_mbcnt_lo(~0u, 0u));
  asm volatile("" : "+v"(l));
  return __int_as_float(__builtin_amdgcn_ds_bpermute((l ^ o) << 2, __float_as_int(v)));
}
DI float x32_max(float v) { auto r = __builtin_amdgcn_permlane32_swap(__float_as_uint(v), __float_as_uint(v), false, false); return fmaxf(__uint_as_float(r[0]), __uint_as_float(r[1])); }
DI float x32_sum(float v) { auto r = __builtin_amdgcn_permlane32_swap(__float_as_uint(v), __float_as_uint(v), false, false); return __uint_as_float(r[0]) + __uint_as_float(r[1]); }
DI float wave_sum(float v) {
#pragma unroll
  for (int o = 32; o >= 1; o >>= 1) v += shx(v, o);
  return v;
}
DI float sigmoidf_(float x) { return __builtin_amdgcn_rcpf(1.f + __builtin_amdgcn_exp2f(-1.4426950408889634f * x)); }
DI int grp_of(int r) { return r < NCTX ? 0 : 1 + ((r - NCTX) >> 11); }
DI int kvrow_of(int r) { int rr = r - NCTX; return (rr >> 11) * SLAT + (rr & 2047); }
DI const float* xrow_in(KP& p, int r) { return r < NCTX ? p.x_prompt + (size_t)r * DM : p.x_sample + (size_t)(r - NCTX) * DM; }

template <int WN>
DI void gemm_kloop(f32x4 (&acc)[4][WN], const bf16_t* __restrict__ A, int lda, const bf16_t* __restrict__ B, int ldb, int K, char* smem) {
  const int tid = ltid(), wid = tid >> 6, lane = tid & 63, wr = wid >> 1, wc = wid & 1, fr = lane & 15, fq = lane >> 4;
  const int r0 = tid >> 3, ch = tid & 7;
  const bf16_t* ap = A + (size_t)r0 * lda + ch * 8;
  const bf16_t* bp = B + (size_t)r0 * ldb + ch * 8;
  u32x4 ra0[4], rb0[WN], ra1[4], rb1[WN];
  const int nk = K >> 6;
  const int swz_w = (r0 >> 1) & 7, swz_r = (fr >> 1) & 7;
  char* sa = smem + r0 * 128 + ((ch ^ swz_w) * 16);
  char* sb = smem + 32768 + r0 * 128 + ((ch ^ swz_w) * 16);
  const char* fa = smem + (64 * wr + fr) * 128;
  const char* fb = smem + 32768 + (16 * WN * wc + fr) * 128;
  const int ko0 = ((fq ^ swz_r) * 16), ko1 = (((4 + fq) ^ swz_r) * 16);
  auto gload = [&](u32x4 (&RA)[4], u32x4 (&RB)[WN], int kt) {
#pragma unroll
    for (int i = 0; i < 4; ++i) RA[i] = gld16(ap + (size_t)(32 * i) * lda + kt * 64);
#pragma unroll
    for (int i = 0; i < WN; ++i) RB[i] = gld16(bp + (size_t)(32 * i) * ldb + kt * 64);
  };
  auto sstore = [&](const u32x4 (&RA)[4], const u32x4 (&RB)[WN], int buf) {
#pragma unroll
    for (int i = 0; i < 4; ++i) *(u32x4*)(sa + buf * 16384 + i * 32 * 128) = RA[i];
#pragma unroll
    for (int i = 0; i < WN; ++i) *(u32x4*)(sb + buf * 16384 + i * 32 * 128) = RB[i];
  };
  auto compute = [&](int buf) {
#pragma unroll
    for (int ks = 0; ks < 2; ++ks) {
      bf16x8 af[4], bfr[WN];
#pragma unroll
      for (int mi = 0; mi < 4; ++mi) af[mi] = *(const bf16x8*)(fa + buf * 16384 + mi * 16 * 128 + (ks ? ko1 : ko0));
#pragma unroll
      for (int ni = 0; ni < WN; ++ni) bfr[ni] = *(const bf16x8*)(fb + buf * 16384 + ni * 16 * 128 + (ks ? ko1 : ko0));
#pragma unroll
      for (int mi = 0; mi < 4; ++mi)
#pragma unroll
        for (int ni = 0; ni < WN; ++ni) acc[mi][ni] = __builtin_amdgcn_mfma_f32_16x16x32_bf16(bfr[ni], af[mi], acc[mi][ni], 0, 0, 0);
    }
  };
  auto step = [&](u32x4 (&RA)[4], u32x4 (&RB)[WN], int buf, int kt) {
    compute(buf);
    SCHED_FENCE();
    if (kt + 1 < nk) {
      sstore(RA, RB, buf ^ 1);
      if (kt + 3 < nk) gload(RA, RB, kt + 3);
    }
    SCHED_FENCE();
    __syncthreads();
  };
  gload(ra0, rb0, 0);
  gload(ra1, rb1, 1);
  __syncthreads();
  sstore(ra0, rb0, 0);
  gload(ra0, rb0, 2);
  SCHED_FENCE();
  __syncthreads();
#pragma unroll 1
  for (int kt = 0; kt < nk; kt += 2) {
    step(ra1, rb1, 0, kt);
    step(ra0, rb0, 1, kt + 1);
  }
}

template <int WN, class F>
DI void gemm_epilogue(const f32x4 (&acc)[4][WN], char* smem, int m0, int n0, const F& f) {
  constexpr int BN = 32 * WN, CS = BN + 4;
  const int tid = ltid(), wid = tid >> 6, lane = tid & 63, wr = wid >> 1, wc = wid & 1, fr = lane & 15, fq = lane >> 4;
  float* ct = (float*)smem;
#pragma unroll
  for (int mi = 0; mi < 4; ++mi)
#pragma unroll
    for (int ni = 0; ni < WN; ++ni) *(f32x4*)(ct + (64 * wr + 16 * mi + fr) * CS + 16 * WN * wc + 16 * ni + 4 * fq) = acc[mi][ni];
  __syncthreads();
  constexpr int CPR = BN / 32;
#pragma unroll 1
  for (int u = tid; u < 128 * CPR; u += NTHR) {
    const int row = u / CPR, chn = u % CPR;
    float v[32];
#pragma unroll
    for (int j = 0; j < 8; ++j) {
      f32x4 t = *(const f32x4*)(ct + row * CS + chn * 32 + 4 * j);
      v[4 * j] = t[0]; v[4 * j + 1] = t[1]; v[4 * j + 2] = t[2]; v[4 * j + 3] = t[3];
    }
    f(m0 + row, n0 + chn * 32, v);
  }
  __syncthreads();
}

DI void store_bf16_32(bf16_t* dst, const float (&v)[32]) {
#pragma unroll
  for (int j = 0; j < 4; ++j) {
    u32x4 t;
    t[0] = pack2(v[8 * j], v[8 * j + 1]); t[1] = pack2(v[8 * j + 2], v[8 * j + 3]);
    t[2] = pack2(v[8 * j + 4], v[8 * j + 5]); t[3] = pack2(v[8 * j + 6], v[8 * j + 7]);
    *(u32x4*)(dst + 8 * j) = t;
  }
}
DI void store_f32_32(float* dst, const float (&v)[32]) {
#pragma unroll
  for (int j = 0; j < 8; ++j) { f32x4 t = {v[4 * j], v[4 * j + 1], v[4 * j + 2], v[4 * j + 3]}; *(f32x4*)(dst + 4 * j) = t; }
}


DI bool tile_map(int t, int nM, int nN, int PMS, int& pm, int& pn) {
  if (t >= nM * nN) return false;
  const int per_g = PMS * nN, g = t / per_g, r = t % per_g, j = r / (4 * PMS), q = r - j * 4 * PMS;
  pm = PMS * g + (q % PMS); pn = 4 * j + (q / PMS);
  return true;
}
DI int vtile_slot(int i) { const int b = blockIdx.x; return (i * 8 + (b & 7)) * ((int)(gridDim.x >> 3) * 2) + (b >> 3) * 2 + vgrp(); }
DI int rtile_slot(int i) { const int b = blockIdx.x; return (i * 8 + (b & 7)) * (int)(gridDim.x >> 3) + (b >> 3); }

template <int NI>
DI void gemm256_kloop(f32x4 (&acc)[8][NI], u32x4 (&ra)[4], u32x4 (&rb)[NI], const bf16_t* __restrict__ A, int lda, const bf16_t* __restrict__ B, int ldb, int K,
                      const bf16_t* __restrict__ An, int ldan, const bf16_t* __restrict__ Bn, int ldbn, bool chained, char* smem) {
  const int tid = rtid(), wid = tid >> 6, lane = tid & 63, wr = wid >> 2, wc = wid & 3, fr = lane & 15, fq = lane >> 4;
  const int r0 = tid >> 3, ch = tid & 7;
  const bf16_t* ap = A + (size_t)r0 * lda + ch * 8;
  const bf16_t* bp = B + (size_t)r0 * ldb + ch * 8;
  const bf16_t* apn = An + (size_t)r0 * ldan + ch * 8;
  const bf16_t* bpn = Bn + (size_t)r0 * ldbn + ch * 8;
  const int nk = K >> 6;
  const int swz_w = (r0 >> 1) & 7, swz_r = (fr >> 1) & 7;
  char* sa = smem + r0 * 128 + ((ch ^ swz_w) * 16);
  char* sb = smem + 65536 + r0 * 128 + ((ch ^ swz_w) * 16);
  const char* fa = smem + (128 * wr + fr) * 128;
  const char* fb = smem + 65536 + (16 * NI * wc + fr) * 128;
  const int ko0 = ((fq ^ swz_r) * 16), ko1 = (((4 + fq) ^ swz_r) * 16);
  auto gload = [&](int kt) {
#pragma unroll
    for (int i = 0; i < 4; ++i) ra[i] = gld16(ap + (size_t)(64 * i) * lda + kt * 64);
#pragma unroll
    for (int i = 0; i < NI; ++i) rb[i] = gld16(bp + (size_t)(64 * i) * ldb + kt * 64);
  };
  auto sstore = [&](int buf) {
#pragma unroll
    for (int i = 0; i < 4; ++i) *(u32x4*)(sa + buf * 32768 + i * 64 * 128) = ra[i];
#pragma unroll
    for (int i = 0; i < NI; ++i) *(u32x4*)(sb + buf * 32768 + i * 64 * 128) = rb[i];
  };
  if (!chained) {
    gload(0);
    __syncthreads();
    sstore(0);
    gload(1);
    SCHED_FENCE();
    __syncthreads();
  }
  auto half = [&](int buf, int ks, bool refill, int ktn, bool nxt) {
    const char* pa = fa + buf * 32768 + (ks ? ko1 : ko0);
    const char* pb = fb + buf * 32768 + (ks ? ko1 : ko0);
    constexpr int RD = (NI == 4) ? 2 : 4;
    bf16x8 bfr[NI], ar[RD];
#pragma unroll
    for (int ni = 0; ni < NI; ++ni) bfr[ni] = *(const bf16x8*)(pb + ni * 2048);
#pragma unroll
    for (int d = 0; d < RD; ++d) ar[d] = *(const bf16x8*)(pa + d * 2048);
#pragma unroll
    for (int mi = 0; mi < 8; ++mi) {
#pragma unroll
      for (int ni = 0; ni < NI; ++ni) acc[mi][ni] = __builtin_amdgcn_mfma_f32_16x16x32_bf16(bfr[ni], ar[mi % RD], acc[mi][ni], 0, 0, 0);
      if (mi + RD < 8) ar[mi % RD] = *(const bf16x8*)(pa + (mi + RD) * 2048);
      if ((mi & 1) == 0) {
        const int pc = mi >> 1;
        if (ks == 0) {
          *(u32x4*)(sa + (buf ^ 1) * 32768 + pc * 64 * 128) = ra[pc];
          ra[pc] = gld16(nxt ? apn + (size_t)(64 * pc) * ldan + ktn * 64 : ap + (size_t)(64 * pc) * lda + ktn * 64);
        } else if (pc < NI) {
          *(u32x4*)(sb + (buf ^ 1) * 32768 + pc * 64 * 128) = rb[pc];
          rb[pc] = gld16(nxt ? bpn + (size_t)(64 * pc) * ldbn + ktn * 64 : bp + (size_t)(64 * pc) * ldb + ktn * 64);
        }
      }
    }
    __builtin_amdgcn_sched_group_barrier(0x100, NI + RD, 0);
#pragma unroll
    for (int mi = 0; mi < 8; ++mi) {
      __builtin_amdgcn_sched_group_barrier(0x008, NI, 0);
      if (mi + RD < 8) __builtin_amdgcn_sched_group_barrier(0x100, 1, 0);
      if ((mi & 1) == 0 && (ks == 0 || (mi >> 1) < NI)) { __builtin_amdgcn_sched_group_barrier(0x200, 1, 0); __builtin_amdgcn_sched_group_barrier(0x020, 1, 0); }
    }
  };
#pragma unroll 1
  for (int kt = 0; kt < nk; ++kt) {
    const int buf = kt & 1;
    const bool nxt = kt + 2 >= nk;
    const int ktn = nxt ? kt + 2 - nk : kt + 2;
    half(buf, 0, true, ktn, nxt);
    half(buf, 1, true, ktn, nxt);
    __syncthreads();
  }
}

template <int NI, class F>
DI void gemm256_epilogue(const f32x4 (&acc)[8][NI], char* smem, int m0, int n0, const F& f) {
  constexpr int CSB = NI * 128 + 16, CPR = NI * 2;
  const int tid = rtid(), wid = tid >> 6, lane = tid & 63, wr = wid >> 2, wc = wid & 3, fr = lane & 15, fq = lane >> 4;
#pragma unroll
  for (int mi = 0; mi < 8; ++mi)
#pragma unroll
    for (int ni = 0; ni < NI; ++ni) {
      u32x2 t = {pack2(acc[mi][ni][0], acc[mi][ni][1]), pack2(acc[mi][ni][2], acc[mi][ni][3])};
      *(u32x2*)(smem + (128 * wr + 16 * mi + fr) * CSB + (16 * NI * wc + 16 * ni + 4 * fq) * 2) = t;
    }
  __syncthreads();
#pragma unroll 1
  for (int u = tid; u < 256 * CPR; u += RTHR) {
    const int row = u / CPR, chn = u % CPR;
    float v[32];
#pragma unroll
    for (int j = 0; j < 4; ++j) {
      const u32x4 t = *(const u32x4*)(smem + row * CSB + chn * 64 + 16 * j);
#pragma unroll
      for (int e = 0; e < 4; ++e) { v[8 * j + 2 * e] = bflo(t[e]); v[8 * j + 2 * e + 1] = bfhi(t[e]); }
    }
    f(m0 + row, n0 + chn * 32, v);
  }
  __syncthreads();
}

struct ResidEpi;
template <int NI>
DI void gemm256_epilogue(const f32x4 (&acc)[8][NI], char* smem, int m0, int n0, const ResidEpi& f);

template <class F>
DI void gemm256_phase(const bf16_t* A, int lda, const bf16_t* B, int ldb, int K, int nM, int nN, int pn_base, const F& f, char* smem) {
  for (int it = 0;; ++it) {
    int pm, pn;
    if (!tile_map(rtile_slot(it), nM, nN, 8, pm, pn)) break;
    pn += pn_base;
    f32x4 acc[8][4];
#pragma unroll
    for (int mi = 0; mi < 8; ++mi)
#pragma unroll
      for (int ni = 0; ni < 4; ++ni) acc[mi][ni] = (f32x4){0.f, 0.f, 0.f, 0.f};
    u32x4 ra[4], rb[4];
    const bf16_t* At = A + (size_t)pm * 256 * lda; const bf16_t* Bt = B + (size_t)pn * 256 * ldb;
    gemm256_kloop<4>(acc, ra, rb, At, lda, Bt, ldb, K, At, lda, Bt, ldb, false, smem);
    gemm256_epilogue<4>(acc, smem, pm * 256, pn * 256, f);
  }
}

template <int NF>
DI void rope_seg(float* v, float pos) {
#pragma unroll
  for (int f = 0; f < NF; ++f) {
    const float inv = exp2f(-(float)f / (float)NF * 13.287712379549449f) * 0.15915494309189535f;
    const float rev = pos * inv;
    const float cs = __builtin_amdgcn_cosf(rev), sn = __builtin_amdgcn_sinf(rev);
    const float a = v[f], b = v[NF + f];
    v[f] = a * cs - b * sn;
    v[NF + f] = b * cs + a * sn;
  }
}

struct ProjEpi {
  char* ws; float* out; int l;
  DI void state_out(size_t base, int W, int r, int c, const float (&v)[32]) const {
    const int b = r >> 8, t = r & 255;
    store_f32_32(out + base + ((size_t)((b * 2 + l) * 256 + t)) * W + c, v);
  }
  DI void operator()(int r, int c0, float (&v)[32]) const {
    bf16_t* const pq = (bf16_t*)(ws + OFF_PQ); bf16_t* const kmc = (bf16_t*)(ws + OFF_KMC); bf16_t* const kml = (bf16_t*)(ws + OFF_KML);
    bf16_t* const kdc = (bf16_t*)(ws + OFF_KDC); bf16_t* const vdc = (bf16_t*)(ws + OFF_VDC); bf16_t* const kdl = (bf16_t*)(ws + OFF_KDL);
    bf16_t* const vdl = (bf16_t*)(ws + OFF_VDL); bf16_t* const knc = (bf16_t*)(ws + OFF_KNC); bf16_t* const vnc = (bf16_t*)(ws + OFF_VNC);
    bf16_t* const knl = (bf16_t*)(ws + OFF_KNL); bf16_t* const vnl = (bf16_t*)(ws + OFF_VNL); float* const mckv = (float*)(ws + OFF_MCKV);
    const bool lat = r >= NCTX;
    int prow = 0, pcol = 0;
    if (lat) { const int t = (r - NCTX) & 2047; prow = t >> 6; pcol = t & 63; }
    if (c0 < 768) {
      if (lat && (c0 % 96) == 64) { rope_seg<8>(v, (float)prow); rope_seg<8>(v + 16, (float)pcol); }
      store_bf16_32(pq + (size_t)r * PQW + c0, v);
    } else if (c0 < 1024) {
      store_f32_32(mckv + (size_t)r * 256 + (c0 - 768), v);
    } else if (c0 < 1536) {
      if (lat) rope_seg<16>(v, (float)((((c0 - 1024) >> 5) & 1) ? pcol : prow));
      store_bf16_32(pq + (size_t)r * PQW + 768 + (c0 - 1024), v);
    } else if (c0 < 2048) {
      const int c = c0 - 1536;
      if (lat) { rope_seg<16>(v, (float)(((c >> 5) & 1) ? pcol : prow)); store_bf16_32(kdl + (size_t)kvrow_of(r) * 512 + c, v); }
      else { store_bf16_32(kdc + (size_t)r * 512 + c, v); state_out(OO_DK, 512, r, c, v); }
    } else if (c0 < 2560) {
      const int c = c0 - 2048;
      if (lat) store_bf16_32(vdl + (size_t)kvrow_of(r) * 512 + c, v);
      else { store_bf16_32(vdc + (size_t)r * 512 + c, v); state_out(OO_DV, 512, r, c, v); }
    } else if (c0 < 3072) {
      store_bf16_32(pq + (size_t)r * PQW + 1280 + (c0 - 2560), v);
    } else if (c0 < 3584) {
      const int c = c0 - 3072;
      if (lat) store_bf16_32(knl + (size_t)kvrow_of(r) * 512 + c, v);
      else { store_bf16_32(knc + (size_t)r * 512 + c, v); state_out(OO_NK, 512, r, c, v); }
    } else if (c0 < 4096) {
      const int c = c0 - 3584;
      if (lat) store_bf16_32(vnl + (size_t)kvrow_of(r) * 512 + c, v);
      else { store_bf16_32(vnc + (size_t)r * 512 + c, v); state_out(OO_NV, 512, r, c, v); }
    } else if (c0 < 5632) {
      store_bf16_32(pq + (size_t)r * PQW + 1792 + (c0 - 4096), v);
    } else if (c0 == 5632) {
      bf16_t* dst;
      if (lat) { rope_seg<8>(v, (float)prow); rope_seg<8>(v + 16, (float)pcol); dst = kml + (size_t)kvrow_of(r) * 768; }
      else { state_out(OO_KR, 32, r, 0, v); dst = kmc + (size_t)r * 768; }
#pragma unroll 1
      for (int h = 0; h < 8; ++h) store_bf16_32(dst + h * 96 + 64, v);
    }
  }
};

struct UkvEpi {
  char* ws;
  DI void operator()(int R, int c0, float (&v)[32]) const {
    size_t row, ko, vo;
    if (R < NCTX) { ko = OFF_KMC; vo = OFF_VMC; row = R; }
    else if (R < NTOK) { ko = OFF_KML; vo = OFF_VML; row = kvrow_of(R); }
    else { const int c = R - NTOK; ko = OFF_KML; vo = OFF_VML; row = (size_t)(c >> 9) * SLAT + 2048 + (c & 511); }
    const int hd = c0 >> 7, e = c0 & 127;
    if (e < 64) store_bf16_32((bf16_t*)(ws + ko) + row * 768 + hd * 96 + e, v);
    else store_bf16_32((bf16_t*)(ws + vo) + row * 512 + hd * 64 + (e - 64), v);
  }
};

struct StoreBf16Epi {
  bf16_t* dst; int ld; int coff;
  DI void operator()(int r, int c0, float (&v)[32]) const { store_bf16_32(dst + (size_t)r * ld + (c0 - coff), v); }
};

struct ResidEpi {
  const float* xp; const float* xs; float* out; const float* ga;
  DI void operator()(int r, int c0, float (&v)[32]) const {
    const float* xr = (r < NCTX ? xp + (size_t)r * DM : xs + (size_t)(r - NCTX) * DM) + c0;
    const float* g = ga + (size_t)grp_of(r) * 12288 + c0;
    float* o = out + (size_t)r * DM + c0;
#pragma unroll
    for (int j = 0; j < 8; ++j) {
      const f32x4 xv = *(const f32x4*)(xr + 4 * j), gv = *(const f32x4*)(g + 4 * j);
      f32x4 t = {xv[0] + gv[0] * v[4 * j], xv[1] + gv[1] * v[4 * j + 1], xv[2] + gv[2] * v[4 * j + 2], xv[3] + gv[3] * v[4 * j + 3]};
      *(f32x4*)(o + 4 * j) = t;
    }
  }
};

template <int NI>
DI void gemm256_epilogue(const f32x4 (&acc)[8][NI], char* smem, int m0, int n0, const ResidEpi& f) {
  constexpr int CSB = NI * 128 + 16, CPR = NI * 2, NU = 256 * CPR / RTHR;
  const int tid = rtid(), wid = tid >> 6, lane = tid & 63, wr = wid >> 2, wc = wid & 3, fr = lane & 15, fq = lane >> 4;
#pragma unroll
  for (int mi = 0; mi < 8; ++mi)
#pragma unroll
    for (int ni = 0; ni < NI; ++ni) {
      u32x2 t = {pack2(acc[mi][ni][0], acc[mi][ni][1]), pack2(acc[mi][ni][2], acc[mi][ni][3])};
      *(u32x2*)(smem + (128 * wr + 16 * mi + fr) * CSB + (16 * NI * wc + 16 * ni + 4 * fq) * 2) = t;
    }
  f32x4 xv[NU][8];
#pragma unroll
  for (int ui = 0; ui < NU; ++ui) {
    const int u = tid + ui * RTHR, r = m0 + u / CPR, c0 = n0 + (u % CPR) * 32;
    const float* xr = (r < NCTX ? f.xp + (size_t)r * DM : f.xs + (size_t)(r - NCTX) * DM) + c0;
#pragma unroll
    for (int j = 0; j < 8; ++j) xv[ui][j] = *(const f32x4*)(xr + 4 * j);
  }
  f32x4 gv[8];
  {
    const float* g = f.ga + (size_t)grp_of(m0) * 12288 + n0 + (tid % CPR) * 32;
#pragma unroll
    for (int j = 0; j < 8; ++j) gv[j] = *(const f32x4*)(g + 4 * j);
  }
  __syncthreads();
#pragma unroll
  for (int ui = 0; ui < NU; ++ui) {
    const int u = tid + ui * RTHR, row = u / CPR, chn = u % CPR, r = m0 + row, c0 = n0 + chn * 32;
    float* o = f.out + (size_t)r * DM + c0;
#pragma unroll
    for (int j = 0; j < 4; ++j) {
      const u32x4 t = *(const u32x4*)(smem + row * CSB + chn * 64 + 16 * j);
      const f32x4 g0 = gv[2 * j], g1 = gv[2 * j + 1];
      const f32x4 x0 = xv[ui][2 * j], x1 = xv[ui][2 * j + 1];
      f32x4 o0 = {x0[0] + g0[0] * bflo(t[0]), x0[1] + g0[1] * bfhi(t[0]), x0[2] + g0[2] * bflo(t[1]), x0[3] + g0[3] * bfhi(t[1])};
      f32x4 o1 = {x1[0] + g1[0] * bflo(t[2]), x1[1] + g1[1] * bfhi(t[2]), x1[2] + g1[2] * bflo(t[3]), x1[3] + g1[3] * bfhi(t[3])};
      *(f32x4*)(o + 8 * j) = o0;
      *(f32x4*)(o + 8 * j + 4) = o1;
    }
  }
  __syncthreads();
}

struct AttnArgs {
  const bf16_t *q, *k, *v; int q_ld, k_ld, v_ld; int n_keys; float sl2;
  bf16_t* y; int y_ld;
  int R0; const float* bias;
  int t0, T; float lgf, lgb; const float *s0f, *s0b; const bf16_t* rg; int rg_ld; const float* nw;
  float lam, omli;
};

constexpr int A_VT = 13312, A_BIAS = 30720, A_S0 = 32768;

template <int DQ, int DV, int MODE>
DI void attn_block(char* smem, const AttnArgs& a) {
  constexpr int KSTR = (DQ + 8) * 2, CK = DQ / 8, NKL = 64 * CK / NTHR, NVL = (32 * DV / 8) / NTHR, NKS = DQ / 16, NDB = DV / 32;
  const int tid = ltid(), w = tid >> 6, lane = tid & 63, ql = lane & 31, g = lane >> 5;
  const int qloc = 32 * w + ql;
  f32x16 O[NDB];
  float m_run = -1e30f, l_run = 0.f;
#pragma unroll
  for (int d = 0; d < NDB; ++d)
#pragma unroll
    for (int i = 0; i < 16; ++i) O[d][i] = 0.f;

  int na_r = 0, na_c = 0, na_rs = 0, na_cs = 0, rlo = 0, nloc = 0;
  if (MODE == 1) {
    na_r = a.R0 + (w >> 1); na_c = 32 * (w & 1) + ql;
    na_rs = min(max(na_r - 4, 0), 24); na_cs = min(max(na_c - 8, 0), 48);
    rlo = min(max(a.R0 - 4, 0), 24);
    nloc = 9;
    __syncthreads();
    float* bl = (float*)(smem + A_BIAS);
    for (int i = tid; i < 465; i += NTHR) bl[i] = a.bias[i] * LOG2E;
  }
  const int npass = (MODE == 3) ? 2 : 1;
  const int ntile = (MODE == 1) ? (nloc + 8) : (a.n_keys >> 6);
  const int t_q = a.t0 + qloc;

  bf16x8 qf[NKS];
  u32x4 rk[NKL], rv0[NVL], rv1[NVL];

  auto key0_of = [&](int it) -> int {
    if (MODE == 1) return it < nloc ? (rlo + it) * 64 : 2048 + 64 * (it - nloc);
    return it * 64;
  };
  auto prefetch = [&](int it, int pass) {
    const int key0 = key0_of(it);
    const bf16_t* kp = a.k + (MODE == 3 ? pass * 64 : 0);
#pragma unroll
    for (int i = 0; i < NKL; ++i) { const int idx = tid + NTHR * i, row = idx / CK, c = idx % CK; rk[i] = gld16(kp + (size_t)(key0 + row) * a.k_ld + 8 * c); }
#pragma unroll
    for (int i = 0; i < NVL; ++i) {
      const int idx = tid + NTHR * i, pr = idx & 31, c = idx >> 5;
      rv0[i] = gld16(a.v + (size_t)(key0 + 2 * pr) * a.v_ld + 8 * c);
      rv1[i] = gld16(a.v + (size_t)(key0 + 2 * pr + 1) * a.v_ld + 8 * c);
    }
  };
  auto stage = [&]() {
#pragma unroll
    for (int i = 0; i < NKL; ++i) { const int idx = tid + NTHR * i, row = idx / CK, c = idx % CK; *(u32x4*)(smem + row * KSTR + 16 * c) = rk[i]; }
#pragma unroll
    for (int i = 0; i < NVL; ++i) {
      const int idx = tid + NTHR * i, pr = idx & 31, c = idx >> 5;
      char* base = smem + A_VT + (8 * c) * 136 + 4 * pr;
#pragma unroll
      for (int e = 0; e < 4; ++e) {
        const unsigned x = rv0[i][e], y = rv1[i][e];
        *(unsigned*)(base + (2 * e) * 136) = (x & 0xffffu) | (y << 16);
        *(unsigned*)(base + (2 * e + 1) * 136) = (x >> 16) | (y & 0xffff0000u);
      }
    }
  };

#pragma unroll 1
  for (int pass = 0; pass < npass; ++pass) {
    {
      const bf16_t* qp = a.q + (MODE == 3 ? pass * 64 : 0) + (size_t)qloc * a.q_ld + 8 * g;
#pragma unroll
      for (int ks = 0; ks < NKS; ++ks) qf[ks] = *(const bf16x8*)(qp + 16 * ks);
    }
    prefetch(0, pass);
#pragma unroll 1
    for (int it = 0; it < ntile; ++it) {
      __syncthreads();
      stage();
      __syncthreads();
      if (it + 1 < ntile) prefetch(it + 1, pass);
      SCHED_FENCE();
      const int key0 = key0_of(it);
      bool active = true;
      int kr = 0;
      const bool local = (MODE == 1) && it < nloc;
      if (local) { kr = rlo + it; active = (kr >= na_rs) && (kr < na_rs + 8); }
      if (active) {
#pragma unroll
        for (int kb = 0; kb < 2; ++kb) {
          f32x16 s;
#pragma unroll
          for (int i = 0; i < 16; ++i) s[i] = 0.f;
          bf16x8 kfr[NKS];
#pragma unroll
          for (int ks = 0; ks < NKS; ++ks) kfr[ks] = *(const bf16x8*)(smem + (32 * kb + ql) * KSTR + (16 * ks + 8 * g) * 2);
          u32x4 vfr[NDB][2];
#pragma unroll
          for (int d = 0; d < NDB; ++d)
#pragma unroll
            for (int h2 = 0; h2 < 2; ++h2) {
              const char* vp = smem + A_VT + (32 * d + ql) * 136 + (32 * kb + 16 * h2 + 4 * g) * 2;
              const u32x2 lo = *(const u32x2*)vp, hi = *(const u32x2*)(vp + 16);
              vfr[d][h2] = (u32x4){lo[0], lo[1], hi[0], hi[1]};
            }
          SCHED_FENCE();
#pragma unroll
          for (int ks = 0; ks < NKS; ++ks) s = __builtin_amdgcn_mfma_f32_32x32x16_bf16(kfr[ks], qf[ks], s, 0, 0, 0);
          float p[16];
          if (MODE == 2) {
#pragma unroll
            for (int i = 0; i < 16; ++i) {
              const int j = key0 + 32 * kb + 8 * (i >> 2) + 4 * g + (i & 3);
              const int d = t_q - j;
              const float e = d >= 0 ? (float)d * a.lgf : (float)(-d) * a.lgb;
              p[i] = s[i] * a.sl2 * __builtin_amdgcn_exp2f(e);
            }
          } else {
            if (local) {
              const float* bl = (const float*)(smem + A_BIAS) + (kr - na_r + 7) * 31 + 15;
#pragma unroll
              for (int i = 0; i < 16; ++i) {
                const int kc = 32 * kb + 8 * (i >> 2) + 4 * g + (i & 3);
                const int dc = min(max(kc - na_c, -15), 15);
                const bool ok = (kc >= na_cs) && (kc < na_cs + 16);
                p[i] = ok ? (s[i] * a.sl2 + bl[dc]) : -1e30f;
              }
            }
            float mx;
            if (local) {
              mx = p[0];
#pragma unroll
              for (int i = 1; i < 16; ++i) mx = fmaxf(mx, p[i]);
            } else {
              mx = s[0];
#pragma unroll
              for (int i = 1; i < 16; ++i) mx = fmaxf(mx, s[i]);
              mx *= a.sl2;
            }
            mx = x32_max(mx);
            const float m_new = fmaxf(m_run, mx);
            const float alpha = __builtin_amdgcn_exp2f(m_run - m_new);
            m_run = m_new;
            float ls = 0.f;
            if (local) {
#pragma unroll
              for (int i = 0; i < 16; ++i) { p[i] = __builtin_amdgcn_exp2f(p[i] - m_new); ls += p[i]; }
            } else {
#pragma unroll
              for (int i = 0; i < 16; ++i) { p[i] = __builtin_amdgcn_exp2f(__builtin_fmaf(s[i], a.sl2, -m_new)); ls += p[i]; }
            }
            l_run = l_run * alpha + ls;
            if (__ballot(alpha != 1.f) != 0ull) {
#pragma unroll
              for (int d = 0; d < NDB; ++d)
#pragma unroll
                for (int i = 0; i < 16; ++i) O[d][i] *= alpha;
            }
          }
          bf16x8 pf[2];
#pragma unroll
          for (int h2 = 0; h2 < 2; ++h2) {
            u32x4 t;
#pragma unroll
            for (int e = 0; e < 4; ++e) t[e] = pack2(p[8 * h2 + 2 * e], p[8 * h2 + 2 * e + 1]);
            pf[h2] = __builtin_bit_cast(bf16x8, t);
          }
#pragma unroll
          for (int d = 0; d < NDB; ++d)
#pragma unroll
            for (int h2 = 0; h2 < 2; ++h2) {
              O[d] = __builtin_amdgcn_mfma_f32_32x32x16_bf16(__builtin_bit_cast(bf16x8, vfr[d][h2]), pf[h2], O[d], 0, 0, 0);
            }
        }
      }
    }
    if (MODE == 3 && pass == 0) {
      const float lt = x32_sum(l_run);
      const float inv = 1.f / lt;
#pragma unroll
      for (int d = 0; d < NDB; ++d)
#pragma unroll
        for (int i4 = 0; i4 < 4; ++i4) {
          u32x2 t = {pack2(O[d][4 * i4] * inv, O[d][4 * i4 + 1] * inv), pack2(O[d][4 * i4 + 2] * inv, O[d][4 * i4 + 3] * inv)};
          *(u32x2*)(smem + A_S0 + qloc * 264 + (32 * d + 8 * i4 + 4 * g) * 2) = t;
          O[d][4 * i4] = 0.f; O[d][4 * i4 + 1] = 0.f; O[d][4 * i4 + 2] = 0.f; O[d][4 * i4 + 3] = 0.f;
        }
      m_run = -1e30f; l_run = 0.f;
    }
  }

  if (MODE == 2 && a.s0f != nullptr) {
#pragma unroll 1
    for (int dir = 0; dir < 2; ++dir) {
      const float* s0 = dir ? a.s0b : a.s0f;
      __syncthreads();
      for (int idx = tid; idx < 64 * 32; idx += NTHR) {
        const int dk = idx >> 5, dv4 = (idx & 31) * 4;
        const f32x4 t = *(const f32x4*)(s0 + dk * 128 + dv4);
#pragma unroll
        for (int e = 0; e < 4; ++e) *(bf16_t*)(smem + A_S0 + (dv4 + e) * 144 + dk * 2) = f2bf(t[e]);
      }
      __syncthreads();
      const float sc = dir ? __builtin_amdgcn_exp2f((float)(a.T - t_q) * a.lgb) : __builtin_amdgcn_exp2f((float)(t_q + 1) * a.lgf);
#pragma unroll
      for (int d = 0; d < NDB; ++d) {
        f32x16 tacc;
#pragma unroll
        for (int i = 0; i < 16; ++i) tacc[i] = 0.f;
#pragma unroll
        for (int ks = 0; ks < NKS; ++ks) {
          const bf16x8 sf = *(const bf16x8*)(smem + A_S0 + (32 * d + ql) * 144 + (16 * ks + 8 * g) * 2);
          tacc = __builtin_amdgcn_mfma_f32_32x32x16_bf16(sf, qf[ks], tacc, 0, 0, 0);
        }
#pragma unroll
        for (int i = 0; i < 16; ++i) O[d][i] += sc * tacc[i];
      }
    }
  }

  if (MODE == 0 || MODE == 1) {
    const float lt = x32_sum(l_run);
    const float inv = 1.f / lt;
#pragma unroll
    for (int d = 0; d < NDB; ++d)
#pragma unroll
      for (int i = 0; i < 16; ++i) O[d][i] *= inv;
  } else if (MODE == 3) {
    const float lt = x32_sum(l_run);
    const float inv = a.lam / lt;
    float ss = 0.f;
#pragma unroll
    for (int d = 0; d < NDB; ++d)
#pragma unroll
      for (int i4 = 0; i4 < 4; ++i4) {
        const u32x2 t = *(const u32x2*)(smem + A_S0 + qloc * 264 + (32 * d + 8 * i4 + 4 * g) * 2);
        const float o0[4] = {bflo(t[0]), bfhi(t[0]), bflo(t[1]), bfhi(t[1])};
#pragma unroll
        for (int e = 0; e < 4; ++e) { const float o = o0[e] - O[d][4 * i4 + e] * inv; O[d][4 * i4 + e] = o; ss += o * o; }
      }
    ss = x32_sum(ss);
    const float rstd = rsqrtf(ss * (1.f / DV) + EPSV) * a.omli;
#pragma unroll
    for (int d = 0; d < NDB; ++d)
#pragma unroll
      for (int i4 = 0; i4 < 4; ++i4) {
        const f32x4 wv = *(const f32x4*)(a.nw + 32 * d + 8 * i4 + 4 * g);
#pragma unroll
        for (int e = 0; e < 4; ++e) O[d][4 * i4 + e] *= rstd * wv[e];
      }
  } else {
    float sm = 0.f;
#pragma unroll
    for (int d = 0; d < NDB; ++d)
#pragma unroll
      for (int i = 0; i < 16; ++i) sm += O[d][i];
    sm = x32_sum(sm);
    const float mu = sm * (1.f / DV);
    float ss = 0.f;
#pragma unroll
    for (int d = 0; d < NDB; ++d)
#pragma unroll
      for (int i = 0; i < 16; ++i) { const float o = O[d][i] - mu; O[d][i] = o; ss += o * o; }
    ss = x32_sum(ss);
    const float rstd = rsqrtf(ss * (1.f / DV) + EPSV);
#pragma unroll
    for (int d = 0; d < NDB; ++d)
#pragma unroll
      for (int i4 = 0; i4 < 4; ++i4) {
        const int dv0 = 32 * d + 8 * i4 + 4 * g;
        const f32x4 wv = *(const f32x4*)(a.nw + dv0);
        const u32x2 gq = *(const u32x2*)(a.rg + (size_t)qloc * a.rg_ld + dv0);
        const float gg[4] = {bflo(gq[0]), bfhi(gq[0]), bflo(gq[1]), bfhi(gq[1])};
#pragma unroll
        for (int e = 0; e < 4; ++e) O[d][4 * i4 + e] *= rstd * wv[e] * (gg[e] * sigmoidf_(gg[e]));
      }
  }
#pragma unroll
  for (int d = 0; d < NDB; ++d)
#pragma unroll
    for (int i4 = 0; i4 < 4; ++i4) {
      u32x2 t = {pack2(O[d][4 * i4], O[d][4 * i4 + 1]), pack2(O[d][4 * i4 + 2], O[d][4 * i4 + 3])};
      *(u32x2*)(a.y + (size_t)qloc * a.y_ld + 32 * d + 8 * i4 + 4 * g) = t;
    }
}

DI void ret_state_job(char* smem, const bf16_t* kp, const bf16_t* vp, int ld, float lg, int dir, float* outp) {
  float* kw = (float*)smem;
  const int tid = ltid();
  __syncthreads();
  for (int idx = tid; idx < 256 * 8; idx += NTHR) {
    const int j = idx >> 3, c = idx & 7;
    const u32x4 t = *(const u32x4*)(kp + (size_t)j * ld + 8 * c);
    const float wj = exp2f((float)(dir ? j : 255 - j) * lg) * 0.125f;
#pragma unroll
    for (int e = 0; e < 4; ++e) { kw[j * 64 + 8 * c + 2 * e] = bflo(t[e]) * wj; kw[j * 64 + 8 * c + 2 * e + 1] = bfhi(t[e]) * wj; }
  }
  __syncthreads();
  const int dv = tid & 127, dkh = tid >> 7;
  float acc[32];
#pragma unroll
  for (int e = 0; e < 32; ++e) acc[e] = 0.f;
#pragma unroll 2
  for (int j = 0; j < 256; ++j) {
    const float vj = bf2f(vp[(size_t)j * ld + dv]);
#pragma unroll
    for (int e4 = 0; e4 < 8; ++e4) {
      const f32x4 kk = *(const f32x4*)(kw + j * 64 + 32 * dkh + 4 * e4);
#pragma unroll
      for (int e = 0; e < 4; ++e) acc[4 * e4 + e] += kk[e] * vj;
    }
  }
#pragma unroll
  for (int e = 0; e < 32; ++e) outp[(32 * dkh + e) * 128 + dv] = acc[e];
}

DI float log2_sigmoid(float x) { return -log1pf(__expf(-x)) * LOG2E; }

#ifndef AM
#define AM 0xFFu
#endif
#define AEN(k) ((AM >> (k)) & 1u)
DI void attention_phase(KP& p, int l, char* smem) {
  char* ws = p.ws;
  bf16_t* pq = (bf16_t*)(ws + OFF_PQ);
  bf16_t* Y = (bf16_t*)(ws + OFF_Y);
  const float lam_init = 0.8f - 0.6f * expf(-0.3f * (float)l);
  float lam;
  {
    const float* lp = p.diff_lambda + l * 256;
    float s1 = 0.f, s2 = 0.f;
    for (int i = 0; i < 64; ++i) { s1 += lp[i] * lp[64 + i]; s2 += lp[128 + i] * lp[192 + i]; }
    lam = expf(s1) - expf(s2) + lam_init;
  }
  const int G = VG();
  auto init = [&](AttnArgs& a) {
    a.R0 = 0; a.bias = nullptr; a.t0 = 0; a.T = 0; a.lgf = 0.f; a.lgb = 0.f; a.s0f = nullptr; a.s0b = nullptr; a.rg = nullptr; a.rg_ld = 0; a.nw = nullptr;
    a.lam = lam; a.omli = 1.f - lam_init; a.q_ld = PQW; a.y_ld = DM;
  };
  int rot = 0;
  auto first = [&](int n) { int f = VB() - rot; if (f < 0) f += G; rot = (rot + n) % G; return f; };
  if (AEN(3)) for (int it = first(512); it < 512; it += G) {
    AttnArgs a; init(a);
    const int b = it >> 6, h = (it >> 4) & 3, qb = it & 15;
    const size_t row = NCTX + (size_t)b * 2048 + qb * 128;
    a.q = pq + row * PQW + 768 + h * 128; a.k = (bf16_t*)(ws + OFF_KDL) + (size_t)b * SLAT * 512 + h * 128; a.k_ld = 512;
    a.v = (bf16_t*)(ws + OFF_VDL) + (size_t)b * SLAT * 512 + h * 128; a.v_ld = 512; a.n_keys = SLAT; a.sl2 = 0.125f * LOG2E;
    a.y = Y + row * DM + 512 + h * 128; a.nw = p.diff_norm + l * 512 + h * 128;
    attn_block<64, 128, 3>(smem, a);
  }
  if (AEN(0)) for (int i = first(1024); i < 1024; i += G) {
    AttnArgs a; init(a);
    const int b = i >> 7, h = (i >> 4) & 7, qb = i & 15;
    const size_t row = NCTX + (size_t)b * 2048 + qb * 128;
    a.q = pq + row * PQW + h * 96; a.k = (bf16_t*)(ws + OFF_KML) + (size_t)b * SLAT * 768 + h * 96; a.k_ld = 768;
    a.v = (bf16_t*)(ws + OFF_VML) + (size_t)b * SLAT * 512 + h * 64; a.v_ld = 512; a.n_keys = SLAT; a.sl2 = 0.10206207261596577f * LOG2E;
    a.y = Y + row * DM + h * 64;
    attn_block<96, 64, 0>(smem, a);
  }
  if (AEN(2)) for (int i = first(512); i < 512; i += G) {
    AttnArgs a; init(a);
    const int b = i >> 6, h = (i >> 4) & 3, qb = i & 15;
    const size_t row0 = NCTX + (size_t)b * 2048, row = row0 + qb * 128;
    a.q = pq + row * PQW + 1792 + h * 64; a.k = pq + row0 * PQW + 2048 + h * 64; a.k_ld = PQW; a.v = pq + row0 * PQW + 2304 + h * 128; a.v_ld = PQW;
    a.n_keys = 2048; a.sl2 = 0.125f; a.y = Y + row * DM + 1536 + h * 128; a.t0 = qb * 128; a.T = 2048;
    a.lgf = log2_sigmoid(p.ret_decay[l * 8 + h]); a.lgb = log2_sigmoid(p.ret_decay[l * 8 + 4 + h]);
    a.s0f = p.st_ret + ((size_t)((b * 2 + l) * 2 + 0) * 4 + h) * 8192; a.s0b = p.st_ret + ((size_t)((b * 2 + l) * 2 + 1) * 4 + h) * 8192;
    a.rg = pq + row * PQW + 2816 + h * 128; a.rg_ld = PQW; a.nw = p.ret_norm + l * 512 + h * 128;
    attn_block<64, 128, 2>(smem, a);
  }
  if (AEN(1)) for (int i = first(1024); i < 1024; i += G) {
    AttnArgs a; init(a);
    const int b = i >> 7, h = (i >> 4) & 7, qb = i & 15;
    const size_t row = NCTX + (size_t)b * 2048 + qb * 128;
    a.q = pq + row * PQW + 1280 + h * 64; a.k = (bf16_t*)(ws + OFF_KNL) + (size_t)b * SLAT * 512 + h * 64; a.k_ld = 512;
    a.v = (bf16_t*)(ws + OFF_VNL) + (size_t)b * SLAT * 512 + h * 64; a.v_ld = 512; a.n_keys = SLAT; a.sl2 = 0.125f * LOG2E;
    a.y = Y + row * DM + 1024 + h * 64; a.R0 = 2 * qb; a.bias = p.na_bias + (size_t)(l * 8 + h) * 465;
    attn_block<64, 64, 1>(smem, a);
  }
  if (AEN(3)) for (int i = first(256); i < 256; i += G) {
    AttnArgs a; init(a);
    const int b = i >> 3, h = (i >> 1) & 3, qb = i & 1;
    const size_t row0 = (size_t)b * 256, row = row0 + qb * 128;
    a.q = pq + row * PQW + 768 + h * 128; a.k = (bf16_t*)(ws + OFF_KDC) + row0 * 512 + h * 128; a.k_ld = 512;
    a.v = (bf16_t*)(ws + OFF_VDC) + row0 * 512 + h * 128; a.v_ld = 512; a.n_keys = 256; a.sl2 = 0.125f * LOG2E;
    a.y = Y + row * DM + 512 + h * 128; a.nw = p.diff_norm + l * 512 + h * 128;
    attn_block<64, 128, 3>(smem, a);
  }
  if (AEN(0)) for (int i = first(512); i < 512; i += G) {
    AttnArgs a; init(a);
    const int b = i >> 4, h = (i >> 1) & 7, qb = i & 1;
    const size_t row0 = (size_t)b * 256, row = row0 + qb * 128;
    a.q = pq + row * PQW + h * 96; a.k = (bf16_t*)(ws + OFF_KMC) + row0 * 768 + h * 96; a.k_ld = 768;
    a.v = (bf16_t*)(ws + OFF_VMC) + row0 * 512 + h * 64; a.v_ld = 512; a.n_keys = 256; a.sl2 = 0.10206207261596577f * LOG2E;
    a.y = Y + row * DM + h * 64;
    attn_block<96, 64, 0>(smem, a);
  }
  if (AEN(4)) for (int i = first(512); i < 512; i += G) {
    AttnArgs a; init(a);
    const int b = i >> 4, h = (i >> 1) & 7, qb = i & 1;
    const size_t row0 = (size_t)b * 256, row = row0 + qb * 128;
    a.q = pq + row * PQW + 1280 + h * 64; a.k = (bf16_t*)(ws + OFF_KNC) + row0 * 512 + h * 64; a.k_ld = 512;
    a.v = (bf16_t*)(ws + OFF_VNC) + row0 * 512 + h * 64; a.v_ld = 512; a.n_keys = 256; a.sl2 = 0.125f * LOG2E;
    a.y = Y + row * DM + 1024 + h * 64;
    attn_block<64, 64, 0>(smem, a);
  }
  if (AEN(2)) for (int i = first(256); i < 256; i += G) {
    AttnArgs a; init(a);
    const int b = i >> 3, h = (i >> 1) & 3, qb = i & 1;
    const size_t row0 = (size_t)b * 256, row = row0 + qb * 128;
    a.q = pq + row * PQW + 1792 + h * 64; a.k = pq + row0 * PQW + 2048 + h * 64; a.k_ld = PQW; a.v = pq + row0 * PQW + 2304 + h * 128; a.v_ld = PQW;
    a.n_keys = 256; a.sl2 = 0.125f; a.y = Y + row * DM + 1536 + h * 128; a.t0 = qb * 128; a.T = 256;
    a.lgf = log2_sigmoid(p.ret_decay[l * 8 + h]); a.lgb = log2_sigmoid(p.ret_decay[l * 8 + 4 + h]);
    a.rg = pq + row * PQW + 2816 + h * 128; a.rg_ld = PQW; a.nw = p.ret_norm + l * 512 + h * 128;
    attn_block<64, 128, 2>(smem, a);
  }
  if (AEN(5)) for (int i = first(256); i < 256; i += G) {
    const int b = i >> 3, h = (i >> 1) & 3, dir = i & 1;
    const size_t row0 = (size_t)b * 256;
    const float lg = log2_sigmoid(p.ret_decay[l * 8 + dir * 4 + h]);
    ret_state_job(smem, pq + row0 * PQW + 2048 + h * 64, pq + row0 * PQW + 2304 + h * 128, PQW, lg, dir,
                  p.out + OO_RET + ((size_t)((b * 2 + l) * 2 + dir) * 4 + h) * 8192);
  }
}

DI void convT_unit(char* smem, const float* src, int ld, int srccol, int k0, bf16_t* dst  , int K) {
  float* T = (float*)smem;
  const int tid = ltid();
  __syncthreads();
  {
    const int n4 = tid & 7, kr = tid >> 3;
#pragma unroll
    for (int i = 0; i < 8; ++i) {
      const int k = kr + 32 * i;
      f32x4 v = {0.f, 0.f, 0.f, 0.f};
      if (srccol >= 0) v = *(const f32x4*)(src + (size_t)(k0 + k) * ld + srccol + 4 * n4);
      T[k * 33 + 4 * n4] = v[0]; T[k * 33 + 4 * n4 + 1] = v[1]; T[k * 33 + 4 * n4 + 2] = v[2]; T[k * 33 + 4 * n4 + 3] = v[3];
    }
  }
  __syncthreads();
  {
    const int k2 = tid & 127, nh = tid >> 7;
#pragma unroll
    for (int i = 0; i < 16; ++i) {
      const int n = nh + 2 * i;
      *(unsigned*)(dst + (size_t)n * K + 2 * k2) = pack2(T[(2 * k2) * 33 + n], T[(2 * k2 + 1) * 33 + n]);
    }
  }
}

DI void prep_phase(KP& p, char* smem) {
  constexpr int NADA = 2 * 16 * 12;
  constexpr int U_IN = 440 * 8, U_BR = 512, U_O = 512, U_UP = 352 * 8, U_DN = 64 * 22, U_UKV = 32, U_L = U_IN + U_BR + U_O + U_UP + U_DN + U_UKV;
  const int tid = ltid();
  const int n_units = NADA + 2 * U_L, trips = (n_units + VG() - 1) / VG();
  for (int tr = 0; tr < trips; ++tr) {
    const int u = VB() + tr * VG();
    if (u >= n_units) { __syncthreads(); __syncthreads(); continue; }
    if (u < NADA) {
      const int l = u / 192, kc = (u % 192) / 12, nc = u % 12;
      float* cs = (float*)smem;
      __syncthreads();
      for (int i = tid; i < 9 * 128; i += NTHR) {
        const int g = i >> 7, k = kc * 128 + (i & 127);
        const float cv = g == 0 ? p.c_ctx[k] : p.c[(g - 1) * DM + k];
        cs[i] = cv * sigmoidf_(cv);
      }
      __syncthreads();
      f32x4 acc[9];
#pragma unroll
      for (int g = 0; g < 9; ++g) acc[g] = (f32x4){0.f, 0.f, 0.f, 0.f};
      const float* wp = p.w_ada + ((size_t)l * DM + kc * 128) * 12288 + nc * 1024 + 4 * tid;
#pragma unroll 4
      for (int k = 0; k < 128; ++k) {
        const f32x4 wv = *(const f32x4*)(wp + (size_t)k * 12288);
#pragma unroll
        for (int g = 0; g < 9; ++g) { const float s = cs[g * 128 + k]; acc[g] += wv * s; }
      }
      float* pp = (float*)(p.ws + OFF_MODP) + ((size_t)(kc * 2 + l) * 9) * 12288 + nc * 1024 + 4 * tid;
#pragma unroll
      for (int g = 0; g < 9; ++g) *(f32x4*)(pp + (size_t)g * 12288) = acc[g];
    } else {
      const int uu = u - NADA, l = uu / U_L;
      int r = uu % U_L;
      char* wl = p.ws + l * SZ_WL;
      if (r < U_IN) {
        const int cn = r >> 3, kt = r & 7, n = cn * 32;
        int sc;
        if (n < 1024) sc = n; else if (n < 5632) sc = n + 32; else if (n < 5664) sc = n - 5632 + 1024; else if (n < NPROJ) sc = -1; else sc = n - 224;
        convT_unit(smem, p.w_in + (size_t)l * DM * 13856, 13856, sc, kt * 256, (bf16_t*)(wl + WO_IN) + (size_t)n * 2048 + kt * 256, 2048);
      } else if ((r -= U_IN) < U_BR) {
        const int cn = r >> 1, kt = r & 1, i = cn >> 6, n = (cn & 63) * 32;
        convT_unit(smem, p.w_branch + ((size_t)(l * 4 + i) * 512) * 2048, 2048, n, kt * 256, (bf16_t*)(wl + WO_BR) + ((size_t)i * 2048 + n) * 512 + kt * 256, 512);
      } else if ((r -= U_BR) < U_O) {
        const int cn = r >> 3, kt = r & 7, n = cn * 32;
        convT_unit(smem, p.w_o + (size_t)l * DM * DM, 2048, n, kt * 256, (bf16_t*)(wl + WO_O) + (size_t)n * 2048 + kt * 256, 2048);
      } else if ((r -= U_O) < U_UP) {
        const int cn = r >> 3, kt = r & 7, n = cn * 32, J = n >> 7, w = n & 127, chn = 64 * J + (w & 63), sc = (w < 64) ? chn : FF + chn;
        convT_unit(smem, p.w_up + (size_t)l * DM * 11264, 11264, sc, kt * 256, (bf16_t*)(wl + WO_UP) + (size_t)n * 2048 + kt * 256, 2048);
      } else if ((r -= U_UP) < U_DN) {
        const int cn = r / 22, kt = r % 22, n = cn * 32;
        convT_unit(smem, p.w_down + (size_t)l * FF * DM, 2048, n, kt * 256, (bf16_t*)(wl + WO_DN) + (size_t)n * FF + kt * 256, FF);
      } else {
        r -= U_DN;
        const int n = r * 32;
        convT_unit(smem, p.w_ukv + (size_t)l * 256 * 1024, 1024, n, 0, (bf16_t*)(wl + WO_UKV) + (size_t)n * 256, 256);
      }
    }
  }
}

DI void ada_reduce_phase(KP& p) {
  const float* pp = (const float*)(p.ws + OFF_MODP);
  float* mod = (float*)(p.ws + OFF_MOD);
  constexpr int NE = 2 * 9 * 12288;
  for (int e = VB() * NTHR + ltid(); e < NE; e += VG() * NTHR) {
    const int l = e / (9 * 12288), n = e % 12288;
    float s = p.b_ada[l * 12288 + n];
    for (int kc = 0; kc < 16; ++kc) s += pp[(size_t)kc * NE + e];
    mod[e] = s;
  }
}

DI void modulate_phase(KP& p, int l, int which  , bool x_from_input) {
  const int vt_ = ltid(), lane = vt_ & 63, wv = vt_ >> 6;
  const float* gvec = (which ? p.g_ffn : p.g_attn) + l * DM;
  const float* mod = (const float*)(p.ws + OFF_MOD) + (size_t)l * 9 * 12288;
  bf16_t* h = (bf16_t*)(p.ws + OFF_H);
  const int nwv = VG() * 4, per = (NTOK + nwv - 1) / nwv, r0 = (VB() * 4 + wv) * per, r1 = min(r0 + per, NTOK);
  f32x4 av[8], bv[8], xn[8];
  int curg = -1;
  auto ldrow = [&](int r) {
    const float* xr = x_from_input ? xrow_in(p, r) : p.out + (size_t)r * DM;
#pragma unroll
    for (int i = 0; i < 8; ++i) xn[i] = *(const f32x4*)(xr + 4 * (lane + 64 * i));
  };
  if (r0 < r1) ldrow(r0);
  for (int r = r0; r < r1; ++r) {
    f32x4 xv[8];
    float ss = 0.f;
#pragma unroll
    for (int i = 0; i < 8; ++i) { xv[i] = xn[i]; ss += xv[i][0] * xv[i][0] + xv[i][1] * xv[i][1] + xv[i][2] * xv[i][2] + xv[i][3] * xv[i][3]; }
    if (r + 1 < r1) ldrow(r + 1);
    const int g = grp_of(r);
    if (g != curg) {
      curg = g;
      const float* sh = mod + (size_t)g * 12288 + (which ? 3 : 0) * DM;
      const float* sc = sh + DM;
#pragma unroll
      for (int i = 0; i < 8; ++i) {
        const int c = 4 * (lane + 64 * i);
        const f32x4 gv = *(const f32x4*)(gvec + c), sv = *(const f32x4*)(sc + c);
        bv[i] = *(const f32x4*)(sh + c);
#pragma unroll
        for (int e = 0; e < 4; ++e) av[i][e] = gv[e] * (1.f + sv[e]);
      }
    }
    ss = wave_sum(ss);
    const float rstd = rsqrtf(ss * (1.f / DM) + EPSV);
#pragma unroll
    for (int i = 0; i < 8; ++i) {
      const int c = 4 * (lane + 64 * i);
      float o[4];
#pragma unroll
      for (int e = 0; e < 4; ++e) o[e] = xv[i][e] * rstd * av[i][e] + bv[i][e];
      u32x2 t = {pack2(o[0], o[1]), pack2(o[2], o[3])};
      *(u32x2*)(h + (size_t)r * DM + c) = t;
    }
  }
}

DI void cache_prep(KP& p, int l) {
  char* ws = p.ws;
  const int total = 4096 * 292;
  for (int u = VB() * NTHR + ltid(); u < total; u += VG() * NTHR) {
    const int cr = u / 292, w = u % 292, b = cr >> 9, j = cr & 511;
    const size_t srow = (size_t)(b * 2 + l) * 512 + j;
    const size_t drow = (size_t)b * SLAT + 2048 + j;
    const float* src; bf16_t* dst; bool rep = false;
    if (w < 32) { src = p.c_ckv + srow * 256 + 8 * w; dst = (bf16_t*)(ws + OFF_CKVA) + ((size_t)NTOK + cr) * 256 + 8 * w; }
    else if (w < 36) { src = p.c_kr + srow * 32 + 8 * (w - 32); dst = (bf16_t*)(ws + OFF_KML) + drow * 768 + 64 + 8 * (w - 32); rep = true; }
    else {
      const int ww = w - 36, which = ww >> 6, c = 8 * (ww & 63);
      const float* sb = which == 0 ? p.c_dk : which == 1 ? p.c_dv : which == 2 ? p.c_nk : p.c_nv;
      const size_t off = which == 0 ? OFF_KDL : which == 1 ? OFF_VDL : which == 2 ? OFF_KNL : OFF_VNL;
      src = sb + srow * 512 + c; dst = (bf16_t*)(ws + off) + drow * 512 + c;
    }
    const f32x4 a = *(const f32x4*)src, bq = *(const f32x4*)(src + 4);
    u32x4 t = {pack2(a[0], a[1]), pack2(a[2], a[3]), pack2(bq[0], bq[1]), pack2(bq[2], bq[3])};
    if (rep) { for (int h = 0; h < 8; ++h) *(u32x4*)(dst + h * 96) = t; }
    else *(u32x4*)dst = t;
  }
}

DI void ckv_phase(KP& p, int l) {
  const int vt_ = ltid(), lane = vt_ & 63, wv = vt_ >> 6;
  const float* mck = (const float*)(p.ws + OFF_MCKV);
  bf16_t* ca = (bf16_t*)(p.ws + OFF_CKVA);
  const f32x4 wn = *(const f32x4*)(p.kv_norm + l * 256 + 4 * lane);
  for (int r = VB() * 4 + wv; r < NTOK; r += VG() * 4) {
    const f32x4 v = *(const f32x4*)(mck + (size_t)r * 256 + 4 * lane);
    float ss = wave_sum(v[0] * v[0] + v[1] * v[1] + v[2] * v[2] + v[3] * v[3]);
    const float rstd = rsqrtf(ss * (1.f / 256.f) + EPSV);
    f32x4 o = {v[0] * rstd * wn[0], v[1] * rstd * wn[1], v[2] * rstd * wn[2], v[3] * rstd * wn[3]};
    u32x2 t = {pack2(o[0], o[1]), pack2(o[2], o[3])};
    *(u32x2*)(ca + (size_t)r * 256 + 4 * lane) = t;
    if (r < NCTX) { const int b = r >> 8, tt = r & 255; *(f32x4*)(p.out + OO_CKV + ((size_t)((b * 2 + l) * 256 + tt)) * 256 + 4 * lane) = o; }
  }
}

DI void merge_phase(KP& p, int l, char* smem) {
  char* wl = p.ws + l * SZ_WL;
  const bf16_t* h = (const bf16_t*)(p.ws + OFF_H);
  const bf16_t* Y = (const bf16_t*)(p.ws + OFF_Y);
  const bf16_t* wg = (const bf16_t*)(wl + WO_IN) + (size_t)NPROJ * 2048;
  const bf16_t* wb = (const bf16_t*)(wl + WO_BR);
  StoreBf16Epi epi{(bf16_t*)(p.ws + OFF_M), DM, 0};
  constexpr int nM = 96, nN = 16;
  for (int it = 0;; ++it) {
    int pm, pn;
    if (!tile_map(rtile_slot(it), nM, nN, 8, pm, pn)) break;
    f32x4 tot[8][2];
#pragma unroll
    for (int mi = 0; mi < 8; ++mi)
#pragma unroll
      for (int ni = 0; ni < 2; ++ni) tot[mi][ni] = (f32x4){0.f, 0.f, 0.f, 0.f};
 u32x4 ra[4], rb[2];
#pragma unroll 1
    for (int i = 0; i < 4; ++i) {
      const bf16_t* Ag = h + (size_t)pm * 256 * DM; const bf16_t* Bg = wg + ((size_t)i * 2048 + pn * 128) * 2048;
      const bf16_t* Ab = Y + (size_t)pm * 256 * DM + 512 * i; const bf16_t* Bb = wb + ((size_t)i * 2048 + pn * 128) * 512;
      const bf16_t* Bg2 = wg + ((size_t)(i < 3 ? i + 1 : i) * 2048 + pn * 128) * 2048;
      unsigned gp[4][2][2];
      char* park = smem + 114688 + rtid() * 64;
      {
        f32x4 ga[8][2];
#pragma unroll
        for (int mi = 0; mi < 8; ++mi)
#pragma unroll
          for (int ni = 0; ni < 2; ++ni) ga[mi][ni] = (f32x4){0.f, 0.f, 0.f, 0.f};
        gemm256_kloop<2>(ga, ra, rb, Ag, DM, Bg, 2048, 2048, Ab, DM, Bb, 512, i > 0, smem);
#pragma unroll
        for (int mi = 0; mi < 8; ++mi)
#pragma unroll
          for (int ni = 0; ni < 2; ++ni) {
            const unsigned g0 = pack2(sigmoidf_(ga[mi][ni][0]), sigmoidf_(ga[mi][ni][1]));
            const unsigned g1 = pack2(sigmoidf_(ga[mi][ni][2]), sigmoidf_(ga[mi][ni][3]));
            if (mi < 4) { u32x2 t = {g0, g1}; *(u32x2*)(park + (mi * 2 + ni) * 8) = t; }
            else { gp[mi - 4][ni][0] = g0; gp[mi - 4][ni][1] = g1; }
          }
      }
      f32x4 ba[8][2];
#pragma unroll
      for (int mi = 0; mi < 8; ++mi)
#pragma unroll
        for (int ni = 0; ni < 2; ++ni) ba[mi][ni] = (f32x4){0.f, 0.f, 0.f, 0.f};
      gemm256_kloop<2>(ba, ra, rb, Ab, DM, Bb, 512, 512, Ag, DM, Bg2, 2048, true, smem);
#pragma unroll
      for (int mi = 0; mi < 8; ++mi)
#pragma unroll
        for (int ni = 0; ni < 2; ++ni) {
          unsigned g0, g1;
          if (mi < 4) { const u32x2 t = *(const u32x2*)(park + (mi * 2 + ni) * 8); g0 = t[0]; g1 = t[1]; }
          else { g0 = gp[mi - 4][ni][0]; g1 = gp[mi - 4][ni][1]; }
          tot[mi][ni][0] += bflo(g0) * ba[mi][ni][0]; tot[mi][ni][1] += bfhi(g0) * ba[mi][ni][1];
          tot[mi][ni][2] += bflo(g1) * ba[mi][ni][2]; tot[mi][ni][3] += bfhi(g1) * ba[mi][ni][3];
        }
    }
    gemm256_epilogue<2>(tot, smem, pm * 256, pn * 128, epi);
  }
}

struct ConvW { float wa[3][8], wb[3][8], ba[8], bb[8]; };
DI void load_convw(ConvW& c, const float* cw, const float* cb, int chn) {
#pragma unroll
  for (int j = 0; j < 3; ++j)
#pragma unroll
    for (int e4 = 0; e4 < 2; ++e4) {
      const f32x4 x = *(const f32x4*)(cw + j * 11264 + chn + 4 * e4), y = *(const f32x4*)(cw + j * 11264 + FF + chn + 4 * e4);
#pragma unroll
      for (int e = 0; e < 4; ++e) { c.wa[j][4 * e4 + e] = x[e]; c.wb[j][4 * e4 + e] = y[e]; }
    }
#pragma unroll
  for (int e4 = 0; e4 < 2; ++e4) {
    const f32x4 x = *(const f32x4*)(cb + chn + 4 * e4), y = *(const f32x4*)(cb + FF + chn + 4 * e4);
#pragma unroll
    for (int e = 0; e < 4; ++e) { c.ba[4 * e4 + e] = x[e]; c.bb[4 * e4 + e] = y[e]; }
  }
}
DI void unpack8(const u32x4& v, float (&x)[8]) {
#pragma unroll
  for (int e = 0; e < 4; ++e) { x[2 * e] = bflo(v[e]); x[2 * e + 1] = bfhi(v[e]); }
}
DI u32x4 conv_out(const ConvW& c, const float (&pa)[8], const float (&pb)[8], const float (&ca)[8], const float (&cb_)[8],
                  const float (&na)[8], const float (&nb)[8]) {
  u32x4 o;
#pragma unroll
  for (int e = 0; e < 4; ++e) {
    float s[2];
#pragma unroll
    for (int q = 0; q < 2; ++q) {
      const int k = 2 * e + q;
      const float sa = c.ba[k] + c.wa[0][k] * pa[k] + c.wa[1][k] * ca[k] + c.wa[2][k] * na[k];
      const float sb = c.bb[k] + c.wb[0][k] * pb[k] + c.wb[1][k] * cb_[k] + c.wb[2][k] * nb[k];
      s[q] = sa * sigmoidf_(sa) * sb;
    }
    o[e] = pack2(s[0], s[1]);
  }
  return o;
}

constexpr size_t OFF_HALO = OFF_ACT + SZ_ACT;
static_assert(OFF_HALO + (size_t)96 * 4 * 11264 * 2 <= OFF_KVEND, "halo alias");

DI void up_phase(KP& p, int l, char* smem) {
  char* wl = p.ws + l * SZ_WL;
  const bf16_t* h = (const bf16_t*)(p.ws + OFF_H);
  const bf16_t* W = (const bf16_t*)(wl + WO_UP);
  bf16_t* act = (bf16_t*)(p.ws + OFF_ACT);
  bf16_t* halo = (bf16_t*)(p.ws + OFF_HALO);
  const float* cw = p.conv_w + (size_t)l * 3 * 11264;
  const float* cb = p.conv_b + (size_t)l * 11264;
  constexpr int CSB = 528;
  for (int it = 0;; ++it) {
    int pm, pn;
    if (!tile_map(rtile_slot(it), 96, 44, 8, pm, pn)) break;
    ConvW cwv;
    {
      f32x4 acc[8][4];
#pragma unroll
      for (int mi = 0; mi < 8; ++mi)
#pragma unroll
        for (int ni = 0; ni < 4; ++ni) acc[mi][ni] = (f32x4){0.f, 0.f, 0.f, 0.f};
      u32x4 ra[4], rb[4];
      const bf16_t* At = h + (size_t)pm * 256 * DM; const bf16_t* Bt = W + (size_t)pn * 256 * 2048;
      gemm256_kloop<4>(acc, ra, rb, At, DM, Bt, 2048, 2048, At, DM, Bt, 2048, false, smem);
      const int tid = rtid(), wid = tid >> 6, lane = tid & 63, wr = wid >> 2, wc = wid & 3, fr = lane & 15, fq = lane >> 4;
      load_convw(cwv, cw, cb, 64 * (2 * pn + ((tid & 15) >> 3)) + (tid & 7) * 8);
#pragma unroll
      for (int mi = 0; mi < 8; ++mi)
#pragma unroll
        for (int ni = 0; ni < 4; ++ni) {
          u32x2 t = {pack2(acc[mi][ni][0], acc[mi][ni][1]), pack2(acc[mi][ni][2], acc[mi][ni][3])};
          *(u32x2*)(smem + (128 * wr + 16 * mi + fr) * CSB + (64 * wc + 16 * ni + 4 * fq) * 2) = t;
        }
    }
    __syncthreads();
    const int tid = rtid();
    const bool top_edge = (pm < 32) || (((pm - 32) & 7) == 0), bot_edge = (pm < 32) || (((pm - 32) & 7) == 7);
    if (tid < 128) {
      const int hr = tid >> 5, c16 = tid & 31, row = hr < 2 ? hr : 252 + hr;
      *(u32x4*)(halo + ((size_t)(pm * 4 + hr)) * 11264 + pn * 256 + c16 * 8) = *(const u32x4*)(smem + row * CSB + c16 * 16);
    }
    {
      const int cu = tid & 15, rb = tid >> 4, g2 = cu >> 3, c8 = (cu & 7) * 8;
      const int chn = 64 * (2 * pn + g2) + c8;
      const ConvW& c = cwv;
      const char* col = smem + (128 * g2 + c8) * 2;
      float pa[8], pb[8], ca[8], cb_[8], na[8], nb[8];
      auto ldrow = [&](int r, float (&xa)[8], float (&xb)[8]) {
        if (r < 0 || r > 255) {
#pragma unroll
          for (int e = 0; e < 8; ++e) { xa[e] = 0.f; xb[e] = 0.f; }
        } else {
          unpack8(*(const u32x4*)(col + r * CSB), xa);
          unpack8(*(const u32x4*)(col + r * CSB + 128), xb);
        }
      };
      const int r0 = rb * 8;
      ldrow(r0 - 1, pa, pb);
      ldrow(r0, ca, cb_);
#pragma unroll
      for (int i = 0; i < 8; ++i) {
        const int r = r0 + i;
        ldrow(r + 1, na, nb);
        const bool defer = (r == 0 && !top_edge) || (r == 255 && !bot_edge);
        if (!defer) *(u32x4*)(act + ((size_t)pm * 256 + r) * FF + chn) = conv_out(c, pa, pb, ca, cb_, na, nb);
#pragma unroll
        for (int e = 0; e < 8; ++e) { pa[e] = ca[e]; pb[e] = cb_[e]; ca[e] = na[e]; cb_[e] = nb[e]; }
      }
    }
    __syncthreads();
  }
}

DI void fixup_phase(KP& p, int l) {
  const bf16_t* halo = (const bf16_t*)(p.ws + OFF_HALO);
  bf16_t* act = (bf16_t*)(p.ws + OFF_ACT);
  const float* cw = p.conv_w + (size_t)l * 3 * 11264;
  const float* cb = p.conv_b + (size_t)l * 11264;
  const int total = 56 * 2 * 704;
  for (int u = VB() * NTHR + ltid(); u < total; u += VG() * NTHR) {
    const int cu = u % 704, br = u / 704, which = br & 1, bd = br >> 1, seq = bd / 7, ti = bd % 7;
    const int pm = 32 + seq * 8 + ti;
    const int chn = cu * 8, g = chn >> 6, c = chn & 63;
    ConvW cwv; load_convw(cwv, cw, cb, chn);
    const bf16_t* rp = halo + ((size_t)(pm * 4 + (which ? 3 : 2))) * 11264 + 128 * g + c;
    const bf16_t* rc = halo + ((size_t)(which ? (pm + 1) * 4 + 0 : pm * 4 + 3)) * 11264 + 128 * g + c;
    const bf16_t* rn = halo + ((size_t)((pm + 1) * 4 + (which ? 1 : 0))) * 11264 + 128 * g + c;
    float pa[8], pb[8], ca[8], cb_[8], na[8], nb[8];
    unpack8(*(const u32x4*)rp, pa); unpack8(*(const u32x4*)(rp + 64), pb);
    unpack8(*(const u32x4*)rc, ca); unpack8(*(const u32x4*)(rc + 64), cb_);
    unpack8(*(const u32x4*)rn, na); unpack8(*(const u32x4*)(rn + 64), nb);
    const size_t row = which ? (size_t)(pm + 1) * 256 : (size_t)pm * 256 + 255;
    *(u32x4*)(act + row * FF + chn) = conv_out(cwv, pa, pb, ca, cb_, na, nb);
  }
}

DI void conv_phase(KP& p, int l, int g0, int ng) {
  const bf16_t* U = (const bf16_t*)(p.ws + OFF_U);
  bf16_t* act = (bf16_t*)(p.ws + OFF_ACT);
  const float* cw = p.conv_w + (size_t)l * 3 * 11264;
  const float* cb = p.conv_b + (size_t)l * 11264;
  const int upr = ng * 8, uw = ng * 128;
  const int total = (NTOK / 8) * upr;
  for (int u = VB() * NTHR + ltid(); u < total; u += VG() * NTHR) {
    const int rb = u / upr, w = u % upr, J = w >> 3, c8 = (w & 7) * 8;
    const int chn = 64 * (g0 + J) + c8, r0 = rb * 8;
    int t0, T;
    if (r0 < NCTX) { t0 = r0 & 255; T = 256; } else { t0 = (r0 - NCTX) & 2047; T = 2048; }
    float wa[3][8], wb[3][8], ba[8], bb[8];
#pragma unroll
    for (int j = 0; j < 3; ++j)
#pragma unroll
      for (int e4 = 0; e4 < 2; ++e4) {
        const f32x4 x = *(const f32x4*)(cw + j * 11264 + chn + 4 * e4), y = *(const f32x4*)(cw + j * 11264 + FF + chn + 4 * e4);
#pragma unroll
        for (int e = 0; e < 4; ++e) { wa[j][4 * e4 + e] = x[e]; wb[j][4 * e4 + e] = y[e]; }
      }
#pragma unroll
    for (int e4 = 0; e4 < 2; ++e4) {
      const f32x4 x = *(const f32x4*)(cb + chn + 4 * e4), y = *(const f32x4*)(cb + FF + chn + 4 * e4);
#pragma unroll
      for (int e = 0; e < 4; ++e) { ba[4 * e4 + e] = x[e]; bb[4 * e4 + e] = y[e]; }
    }
    const bf16_t* ua = U + (size_t)r0 * uw + 128 * J + c8;
    float pa[8], pb[8], ca[8], cb_[8], na[8], nb[8];
    auto ldrow = [&](int i, float (&xa)[8], float (&xb)[8]) {
      const int tt = t0 + i;
      if (tt < 0 || tt >= T) {
#pragma unroll
        for (int e = 0; e < 8; ++e) { xa[e] = 0.f; xb[e] = 0.f; }
      } else {
        const u32x4 av = *(const u32x4*)(ua + (ptrdiff_t)i * uw), bv = *(const u32x4*)(ua + (ptrdiff_t)i * uw + 64);
#pragma unroll
        for (int e = 0; e < 4; ++e) { xa[2 * e] = bflo(av[e]); xa[2 * e + 1] = bfhi(av[e]); xb[2 * e] = bflo(bv[e]); xb[2 * e + 1] = bfhi(bv[e]); }
      }
    };
    ldrow(-1, pa, pb);
    ldrow(0, ca, cb_);
#pragma unroll
    for (int i = 0; i < 8; ++i) {
      ldrow(i + 1, na, nb);
      u32x4 o;
#pragma unroll
      for (int e = 0; e < 4; ++e) {
        float s[2];
#pragma unroll
        for (int q = 0; q < 2; ++q) {
          const int c = 2 * e + q;
          const float sa = ba[c] + wa[0][c] * pa[c] + wa[1][c] * ca[c] + wa[2][c] * na[c];
          const float sb = bb[c] + wb[0][c] * pb[c] + wb[1][c] * cb_[c] + wb[2][c] * nb[c];
          s[q] = sa * sigmoidf_(sa) * sb;
        }
        o[e] = pack2(s[0], s[1]);
      }
      *(u32x4*)(act + (size_t)(r0 + i) * FF + chn) = o;
#pragma unroll
      for (int e = 0; e < 8; ++e) { pa[e] = ca[e]; pb[e] = cb_[e]; ca[e] = na[e]; cb_[e] = nb[e]; }
    }
  }
}

DI void final_phase(KP& p) {
  const int vt_ = ltid(), lane = vt_ & 63, wv = vt_ >> 6;
  for (int r = VB() * 4 + wv; r < NTOK; r += VG() * 4) {
    float* xr = p.out + (size_t)r * DM;
    f32x4 xv[8];
    float ss = 0.f;
#pragma unroll
    for (int i = 0; i < 8; ++i) { xv[i] = *(const f32x4*)(xr + 4 * (lane + 64 * i)); ss += xv[i][0] * xv[i][0] + xv[i][1] * xv[i][1] + xv[i][2] * xv[i][2] + xv[i][3] * xv[i][3]; }
    ss = wave_sum(ss);
    const float rstd = rsqrtf(ss * (1.f / DM) + EPSV);
#pragma unroll
    for (int i = 0; i < 8; ++i) {
      const int c = 4 * (lane + 64 * i);
      const f32x4 gv = *(const f32x4*)(p.g_final + c);
      f32x4 o = {xv[i][0] * rstd * gv[0], xv[i][1] * rstd * gv[1], xv[i][2] * rstd * gv[2], xv[i][3] * rstd * gv[3]};
      *(f32x4*)(xr + c) = o;
    }
  }
}

constexpr int LSTEPS = 11, NSTEPS = 2 + 2 * LSTEPS + 1;

DI void run_step(KP& p, int step, char* smem) {
  char* ws = p.ws;
  asm volatile("" : "+s"(ws));
  char* gsm = smem + vgrp() * GRP_LDS;
  if (step == 0) { prep_phase(p, gsm); return; }
  if (step == 1) { ada_reduce_phase(p); return; }
  if (step == NSTEPS - 1) { final_phase(p); return; }
  const int l = (step - 2) / LSTEPS, s = (step - 2) % LSTEPS;
  char* wl = ws + l * SZ_WL;
  const float* mod = (const float*)(ws + OFF_MOD) + (size_t)l * 9 * 12288;
  const bf16_t* h = (const bf16_t*)(ws + OFF_H);
  switch (s) {
    case 0: modulate_phase(p, l, 0, l == 0); cache_prep(p, l); break;
    case 1: {
      ProjEpi e; e.ws = ws; e.out = p.out; e.l = l;
      gemm256_phase(h, DM, (const bf16_t*)(wl + WO_IN), 2048, 2048, 96, 23, 0, e, smem);
    } break;
    case 2: ckv_phase(p, l); break;
    case 3: {
      UkvEpi e{ws};
      gemm256_phase((const bf16_t*)(ws + OFF_CKVA), 256, (const bf16_t*)(wl + WO_UKV), 256, 256, 112, 4, 0, e, smem);
    } break;
    case 4: attention_phase(p, l, gsm); break;
    case 5: merge_phase(p, l, smem); break;
    case 6: {
      ResidEpi e{l == 0 ? p.x_prompt : p.out, l == 0 ? p.x_sample : p.out + (size_t)NCTX * DM, p.out, mod + 2 * DM};
      gemm256_phase((const bf16_t*)(ws + OFF_M), DM, (const bf16_t*)(wl + WO_O), 2048, 2048, 96, 8, 0, e, smem);
    } break;
    case 7: modulate_phase(p, l, 1, false); break;
    case 8: up_phase(p, l, smem); break;
    case 9: fixup_phase(p, l); break;
    case 10: {
      ResidEpi e{p.out, p.out + (size_t)NCTX * DM, p.out, mod + 5 * DM};
      gemm256_phase((const bf16_t*)(ws + OFF_ACT), FF, (const bf16_t*)(wl + WO_DN), FF, FF, 96, 8, 0, e, smem);
    } break;
  }
}

#define XB_TMO      128
#define XB_XCNT(j)  (256  + 64 * (j))
#define XB_XSUB(j)  (1280 + 64 * (j))
#define XB_XGEN(j)  (2304 + 64 * (j))
#define XB_TOP      3328
#define XB_TOPGEN   3392
#define XCD_BAR_WORDS 3456
#define XB_SPIN_CAP (1u << 18)
#define LAS __attribute__((address_space(3)))

__device__ __forceinline__ unsigned xb_ld(unsigned* p)              { return __hip_atomic_load(p, __ATOMIC_RELAXED, __HIP_MEMORY_SCOPE_AGENT); }
__device__ __forceinline__ unsigned xb_add(unsigned* p, unsigned v) { return __hip_atomic_fetch_add(p, v, __ATOMIC_RELAXED, __HIP_MEMORY_SCOPE_AGENT); }
__device__ __forceinline__ unsigned xb_xcc_id() { return (unsigned)__builtin_amdgcn_s_getreg((3 << 11) | 20) & 0xFu; }
#define XB_SPIN(cond, bar) do { unsigned _sp = 0; while (cond) { __builtin_amdgcn_s_sleep(1); \
    if ((++_sp & 255u) == 0u) { if (xb_ld(&(bar)[XB_TMO])) break; if (_sp > XB_SPIN_CAP) { atomicAdd(&(bar)[XB_TMO], 1u); break; } } } } while (0)

struct XcdBarrier {
    unsigned* bar; unsigned x;
    volatile LAS unsigned* st;
};

__device__ __forceinline__ XcdBarrier xcd_barrier_post(unsigned* bar, volatile LAS unsigned* st) {
    XcdBarrier b; b.bar = bar; b.x = xb_xcc_id(); b.st = st;
    if (threadIdx.x == 0) (void)xb_add(&bar[XB_XCNT(b.x)], 1u);
    return b;
}
__device__ __forceinline__ void xcd_barrier_complete(unsigned* bar, unsigned x, unsigned& nloc, unsigned& nx) {
    const unsigned G = gridDim.x * gridDim.y * gridDim.z;
    unsigned sum, cnt, mine, sp = 0u;
    for (;;) {
        sum = 0u; cnt = 0u; mine = 0u;
#pragma unroll
        for (unsigned j = 0; j < 16; ++j) { const unsigned c = xb_ld(&bar[XB_XCNT(j)]); sum += c; cnt += (c > 0u) ? 1u : 0u; mine = (j == x) ? c : mine; }
        if (sum == G) break;
        __builtin_amdgcn_s_sleep(1);
        if ((++sp & 255u) == 0u) { if (xb_ld(&bar[XB_TMO])) break; if (sp > XB_SPIN_CAP) { atomicAdd(&bar[XB_TMO], 1u); break; } }
    }
    nloc = mine > 0u ? mine : 1u; nx = cnt > 0u ? cnt : 1u;
}

__device__ __forceinline__ void xcd_barrier(const XcdBarrier& b) {
    asm volatile("s_waitcnt vmcnt(0)" ::: "memory");
    __syncthreads();
    if (threadIdx.x == 0) {
        unsigned* bar = b.bar;
        __builtin_amdgcn_s_waitcnt(0);
        unsigned nloc = b.st[0], nx = b.st[1];
        if (nloc == 0u) { xcd_barrier_complete(bar, b.x, nloc, nx); b.st[0] = nloc; b.st[1] = nx; }
        const unsigned old = xb_add(&bar[XB_XSUB(b.x)], 1u);
        const unsigned gen = old / nloc;
        if (old + 1u == (gen + 1u) * nloc) {
            __builtin_amdgcn_fence(__ATOMIC_RELEASE, "agent");
            asm volatile("s_waitcnt vmcnt(0)" ::: "memory");
            const unsigned og = xb_add(&bar[XB_TOP], 1u);
            const unsigned tg = og / nx;
            if (og + 1u == (tg + 1u) * nx) xb_add(&bar[XB_TOPGEN], 1u);
            else XB_SPIN(xb_ld(&bar[XB_TOPGEN]) == tg, bar);
            __builtin_amdgcn_fence(__ATOMIC_ACQUIRE, "agent");
            xb_add(&bar[XB_XGEN(b.x)], 1u);
            asm volatile("s_waitcnt vmcnt(0)" ::: "memory");
        } else {
            XB_SPIN(xb_ld(&bar[XB_XGEN(b.x)]) == gen, bar);
            __builtin_amdgcn_fence(__ATOMIC_ACQUIRE, "agent");
            asm volatile("s_waitcnt vmcnt(0)" ::: "memory");
        }
    }
    __syncthreads();
}

extern "C" __global__ void __launch_bounds__(RTHR, 2) mega_kernel(Params p) {
  extern __shared__ __attribute__((aligned(16))) char smem[];
  __shared__ unsigned xb_words[4];
  cg::grid_group grid = cg::this_grid();
  if (threadIdx.x < 4) xb_words[threadIdx.x] = 0u;
  __syncthreads();
  XcdBarrier xb = xcd_barrier_post((unsigned*)(p.ws + OFF_BAR), (volatile LAS unsigned*)&xb_words);
  for (int s = p.step_lo; s < p.step_hi; ++s) {
    KP* pp = (KP*)__builtin_amdgcn_kernarg_segment_ptr();
    asm volatile("" : "+s"(pp));
    run_step(*pp, s, smem);
    if (s + 1 < p.step_hi) { if (s == p.step_lo) grid.sync(); else xcd_barrier(xb); }
  }
}

extern "C" void kernel_launch(void* const* d_in, const int* in_sizes, int n_in, void* d_out, int out_size, void* d_ws, size_t ws_size,
                              hipStream_t stream) {
  static int grid_blocks = 0;
  if (!grid_blocks) {
    int dev = 0, cus = 0, per_cu = 0;
    hipGetDevice(&dev);
    hipDeviceGetAttribute(&cus, hipDeviceAttributeMultiprocessorCount, dev);
    hipFuncSetAttribute((const void*)mega_kernel, hipFuncAttributeMaxDynamicSharedMemorySize, LDS_BYTES);
    hipOccupancyMaxActiveBlocksPerMultiprocessor(&per_cu, mega_kernel, RTHR, LDS_BYTES);
    if (per_cu != 1) per_cu = 1;
    grid_blocks = cus * per_cu;
  }
  if (ws_size < WS_NEED) { fprintf(stderr, "workspace too small: %zu < %zu\n", ws_size, (size_t)WS_NEED); return; }
  Params p{};
  const float** pf = (const float**)&p;
  for (int i = 0; i < 30; ++i) pf[i] = (const float*)d_in[i];
  p.out = (float*)d_out;
  p.ws = (char*)d_ws;
#if MULTI
  for (int s = 0; s < NSTEPS; ++s) {
    p.step_lo = s; p.step_hi = s + 1;
    hipLaunchKernelGGL(mega_kernel, dim3(grid_blocks), dim3(RTHR), LDS_BYTES, stream, p);
  }
#else
  p.step_lo = 0; p.step_hi = NSTEPS;
  (void)hipMemsetAsync((char*)d_ws + OFF_BAR, 0, 16384, stream);
  void* args[] = {&p};
  hipError_t e = hipLaunchCooperativeKernel((const void*)mega_kernel, dim3(grid_blocks), dim3(RTHR), args, LDS_BYTES, stream);
  if (e != hipSuccess) fprintf(stderr, "cooperative launch failed: %s (grid %d)\n", hipGetErrorString(e), grid_blocks);
#endif
}
```
